# Optimizing an MI355X kernel written in HIP

```python
import jax, jax.numpy as jnp
from jax import lax
import numpy as np

D_MODEL = 1024
BATCH = 8
SEQ = 2048
DEPTH = 2
DEC_BATCH = 8
DEC_SEQ = 16
PAST_LEN = 2048

CHUNK = 64
N_EVEN = (DEPTH + 1) // 2
N_ODD = DEPTH // 2
D_A = D_MODEL // 2
SCONV_W = 3
H_B = 8
HD_B = D_MODEL // 2 // H_B
D_B = H_B * HD_B
Q_BLOCK = 128
D_C = D_MODEL // 2
C_GROUPS = 8
C_GW = D_C // C_GROUPS
C_CHUNK = 128
D_D = D_MODEL // 2
CCONV_W = 31
D_FF = 2816
FORGET_BIAS = 3.0
EPS = 1e-6
E_SPLITS = (D_A, 2 * D_A, 3 * D_A, 3 * D_A + D_B, 3 * D_A + 2 * D_B, 3 * D_A + 3 * D_B)
E_COLS = 3 * D_A + 3 * D_B + H_B
O_SPLITS = (D_C, 2 * D_C, 2 * D_C + D_D)
O_COLS = 2 * D_C + 2 * D_D

kernel_name = 'hybrid_streaming_encoder_step'


def rmsnorm(x, g):
    xf = x.astype(jnp.float32)
    y = xf * lax.rsqrt(jnp.mean(xf * xf, axis=-1, keepdims=True) + EPS)
    return y.astype(x.dtype) * g


def layernorm(x, g, b):
    xf = x.astype(jnp.float32)
    mu = jnp.mean(xf, axis=-1, keepdims=True)
    xc = xf - mu
    y = xc * lax.rsqrt(jnp.mean(xc * xc, axis=-1, keepdims=True) + EPS)
    return y.astype(x.dtype) * g + b


def swiglu(h, wg, wu, wd):
    return (jax.nn.silu(h @ wg) * (h @ wu)) @ wd


def causal_dwconv(x, ctx, w):
    xp = jnp.concatenate([ctx.astype(x.dtype), x], axis=1)
    y = lax.conv_general_dilated(xp, w[:, None, :].astype(x.dtype), (1,), 'VALID',
                                 dimension_numbers=('NWC', 'WIO', 'NWC'),
                                 feature_group_count=x.shape[-1])
    return y, xp[:, xp.shape[1] - (w.shape[0] - 1):]


def fox_block(q, c_q, q_pos, k, v, c_k):
    s = jnp.einsum('bqhd,bkhd->bhqk', q, k, preferred_element_type=jnp.float32) * (HD_B ** -0.5)
    s = s + jnp.transpose(c_q, (0, 2, 1))[:, :, :, None] - jnp.transpose(c_k, (0, 2, 1))[:, :, None, :]
    mask = jnp.arange(k.shape[1])[None, :] <= q_pos[:, None]
    s = jnp.where(mask[None, None], s, -jnp.inf)
    p = jax.nn.softmax(s, axis=-1).astype(v.dtype)
    return jnp.einsum('bhqk,bkhd->bqhd', p, v)


def even_mixer(h, w_in, b_f, conv_w, w_out, sconv_ctx, past):
    bsz, t, _ = h.shape
    z = h @ w_in
    xa, gb, gc, q, k, v, fl = jnp.split(z, E_SPLITS, axis=-1)
    ca, new_sconv = causal_dwconv(gc * xa, sconv_ctx, conv_w)
    ya = gb * ca
    q = q.reshape(bsz, t, H_B, HD_B)
    k = k.reshape(bsz, t, H_B, HD_B)
    v = v.reshape(bsz, t, H_B, HD_B)
    logf = jax.nn.log_sigmoid(fl.astype(jnp.float32) + b_f.astype(jnp.float32))
    if past is None:
        c = jnp.cumsum(logf, axis=1)
        nb = t // Q_BLOCK
        qb = jnp.transpose(q.reshape(bsz, nb, Q_BLOCK, H_B, HD_B), (1, 0, 2, 3, 4))
        cb = jnp.transpose(c.reshape(bsz, nb, Q_BLOCK, H_B), (1, 0, 2, 3))
        pos = jnp.arange(t).reshape(nb, Q_BLOCK)
        yb = lax.map(lambda a: fox_block(a[0], a[1], a[2], k, v, c), (qb, cb, pos))
        yb = jnp.transpose(yb, (1, 0, 2, 3, 4)).reshape(bsz, t, D_B)
    else:
        pk, pv, plf = past
        p_len = pk.shape[1]
        k_all = jnp.concatenate([pk.astype(k.dtype), k], axis=1)
        v_all = jnp.concatenate([pv.astype(v.dtype), v], axis=1)
        c_all = jnp.cumsum(jnp.concatenate([plf.astype(jnp.float32), logf], axis=1), axis=1)
        yb = fox_block(q, c_all[:, p_len:], p_len + jnp.arange(t), k_all, v_all, c_all)
        yb = yb.reshape(bsz, t, D_B)
    y = jnp.concatenate([ya, yb], axis=-1) @ w_out
    return y, k, v, logf, new_sconv


def spatial_gate(v, ws, bs):
    bsz, t, _ = v.shape
    L = min(t, C_CHUNK)
    n = t // L
    vr = v.reshape(bsz, n, L, C_GROUPS, C_GW)
    w = jnp.where(jnp.tril(jnp.ones((L, L), dtype=bool))[None], ws[:, :L, :L], 0).astype(v.dtype)
    s = jnp.einsum('gts,bnsgc->bntgc', w, vr) + jnp.transpose(bs[:, :L])[None, None, :, :, None].astype(v.dtype)
    return s.reshape(bsz, t, D_C)


def odd_mixer(h, w_in, ln_g, ln_b, ws, bs, dw, dw_b, cn_g, cn_b, w_out, cconv_ctx):
    z = h @ w_in
    u, vv, ga, gb = jnp.split(z, O_SPLITS, axis=-1)
    u = jax.nn.gelu(u)
    vv = layernorm(jax.nn.gelu(vv), ln_g, ln_b)
    yc = u * spatial_gate(vv, ws, bs)
    g = ga * jax.nn.sigmoid(gb)
    cd, new_cconv = causal_dwconv(g, cconv_ctx, dw)
    yd = jax.nn.silu(layernorm(cd + dw_b, cn_g, cn_b))
    y = jnp.concatenate([yc, yd], axis=-1) @ w_out
    return y, vv, new_cconv


def run_trunk(x, prm, sconv_ctx, cconv_ctx, past):
    ks, vs, lfs, scs, ccs, gvs = [], [], [], [], [], []
    for l in range(DEPTH):
        i = l // 2
        x = x + 0.5 * swiglu(rmsnorm(x, prm['ffn1_g'][l]), prm['ffn1_wg'][l], prm['ffn1_wu'][l], prm['ffn1_wd'][l])
        h = rmsnorm(x, prm['mix_g'][l])
        if l % 2 == 0:
            layer_past = None if past is None else (past[0][i], past[1][i], past[2][i])
            y, k, v, lf, sc = even_mixer(h, prm['e_w_in'][i], prm['e_b_f'][i], prm['e_conv_w'][i],
                                         prm['e_w_out'][i], sconv_ctx[i], layer_past)
            ks.append(k); vs.append(v); lfs.append(lf); scs.append(sc)
        else:
            y, gv, cc = odd_mixer(h, prm['o_w_in'][i], prm['o_ln_g'][i], prm['o_ln_b'][i], prm['o_ws'][i],
                                  prm['o_bs'][i], prm['o_dw'][i], prm['o_dw_b'][i], prm['o_cn_g'][i],
                                  prm['o_cn_b'][i], prm['o_w_out'][i], cconv_ctx[i])
            gvs.append(gv); ccs.append(cc)
        x = x + y
        x = x + 0.5 * swiglu(rmsnorm(x, prm['ffn2_g'][l]), prm['ffn2_wg'][l], prm['ffn2_wu'][l], prm['ffn2_wd'][l])
    return (rmsnorm(x, prm['final_g']), jnp.stack(ks), jnp.stack(vs), jnp.stack(lfs),
            jnp.stack(scs), jnp.stack(ccs), jnp.stack(gvs))


def setup_inputs(seed: int = 0) -> dict:
    key = jax.random.key(seed)
    ks = jax.random.split(key, 40)
    f32 = jnp.float32

    def nrm(k, shape, scale):
        return jax.random.normal(k, shape, f32) * scale

    D = D_MODEL
    return {
        'x_prompt': nrm(ks[0], (BATCH, SEQ, D), 1.0),
        'x_sample': nrm(ks[1], (DEC_BATCH, DEC_SEQ, D), 1.0),
        'cache_fox_k': nrm(ks[2], (N_EVEN, DEC_BATCH, PAST_LEN, H_B, HD_B), 1.0),
        'cache_fox_v': nrm(ks[3], (N_EVEN, DEC_BATCH, PAST_LEN, H_B, HD_B), 1.0),
        'cache_fox_logf': jax.nn.log_sigmoid(FORGET_BIAS + nrm(ks[4], (N_EVEN, DEC_BATCH, PAST_LEN, H_B), 1.0)),
        'state_sconv': nrm(ks[5], (N_EVEN, DEC_BATCH, SCONV_W - 1, D_A), 1.0),
        'state_cconv': nrm(ks[6], (N_ODD, DEC_BATCH, CCONV_W - 1, D_D), 0.5),
        'ffn1_g': 1.0 + nrm(ks[7], (DEPTH, D), 0.02),
        'ffn1_wg': nrm(ks[8], (DEPTH, D, D_FF), D ** -0.5),
        'ffn1_wu': nrm(ks[9], (DEPTH, D, D_FF), D ** -0.5),
        'ffn1_wd': nrm(ks[10], (DEPTH, D_FF, D), D_FF ** -0.5),
        'mix_g': 1.0 + nrm(ks[11], (DEPTH, D), 0.02),
        'ffn2_g': 1.0 + nrm(ks[12], (DEPTH, D), 0.02),
        'ffn2_wg': nrm(ks[13], (DEPTH, D, D_FF), D ** -0.5),
        'ffn2_wu': nrm(ks[14], (DEPTH, D, D_FF), D ** -0.5),
        'ffn2_wd': nrm(ks[15], (DEPTH, D_FF, D), D_FF ** -0.5),
        'e_w_in': nrm(ks[16], (N_EVEN, D, E_COLS), D ** -0.5),
        'e_b_f': FORGET_BIAS + nrm(ks[17], (N_EVEN, H_B), 0.1),
        'e_conv_w': nrm(ks[18], (N_EVEN, SCONV_W, D_A), SCONV_W ** -0.5),
        'e_w_out': nrm(ks[19], (N_EVEN, D_A + D_B, D), (D_A + D_B) ** -0.5),
        'o_w_in': nrm(ks[20], (N_ODD, D, O_COLS), D ** -0.5),
        'o_ln_g': 1.0 + nrm(ks[21], (N_ODD, D_C), 0.02),
        'o_ln_b': nrm(ks[22], (N_ODD, D_C), 0.02),
        'o_ws': nrm(ks[23], (N_ODD, C_GROUPS, C_CHUNK, C_CHUNK), 0.5 * C_CHUNK ** -0.5),
        'o_bs': 1.0 + nrm(ks[24], (N_ODD, C_GROUPS, C_CHUNK), 0.02),
        'o_dw': nrm(ks[25], (N_ODD, CCONV_W, D_D), CCONV_W ** -0.5),
        'o_dw_b': nrm(ks[26], (N_ODD, D_D), 0.02),
        'o_cn_g': 1.0 + nrm(ks[27], (N_ODD, D_D), 0.02),
        'o_cn_b': nrm(ks[28], (N_ODD, D_D), 0.02),
        'o_w_out': nrm(ks[29], (N_ODD, D_C + D_D, D), (D_C + D_D) ** -0.5),
        'final_g': 1.0 + nrm(ks[30], (D,), 0.02),
    }


def reference(x_prompt, x_sample, cache_fox_k, cache_fox_v, cache_fox_logf, state_sconv, state_cconv,
              ffn1_g, ffn1_wg, ffn1_wu, ffn1_wd, mix_g, ffn2_g, ffn2_wg, ffn2_wu, ffn2_wd,
              e_w_in, e_b_f, e_conv_w, e_w_out, o_w_in, o_ln_g, o_ln_b, o_ws, o_bs,
              o_dw, o_dw_b, o_cn_g, o_cn_b, o_w_out, final_g):
    prm = dict(ffn1_g=ffn1_g, ffn1_wg=ffn1_wg, ffn1_wu=ffn1_wu, ffn1_wd=ffn1_wd, mix_g=mix_g,
               ffn2_g=ffn2_g, ffn2_wg=ffn2_wg, ffn2_wu=ffn2_wu, ffn2_wd=ffn2_wd,
               e_w_in=e_w_in, e_b_f=e_b_f, e_conv_w=e_conv_w, e_w_out=e_w_out,
               o_w_in=o_w_in, o_ln_g=o_ln_g, o_ln_b=o_ln_b, o_ws=o_ws, o_bs=o_bs,
               o_dw=o_dw, o_dw_b=o_dw_b, o_cn_g=o_cn_g, o_cn_b=o_cn_b, o_w_out=o_w_out,
               final_g=final_g)
    bp = x_prompt.shape[0]
    zero_sconv = jnp.zeros((N_EVEN, bp, SCONV_W - 1, D_A), x_prompt.dtype)
    zero_cconv = jnp.zeros((N_ODD, bp, CCONV_W - 1, D_D), x_prompt.dtype)
    y_prompt, p_fox_k, p_fox_v, p_fox_logf, p_sconv, p_cconv, _p_gv = run_trunk(
        x_prompt, prm, zero_sconv, zero_cconv, None)
    y_sample, s_fox_k, s_fox_v, s_fox_logf, s_sconv, s_cconv, s_gmlp_v = run_trunk(
        x_sample, prm, state_sconv, state_cconv, (cache_fox_k, cache_fox_v, cache_fox_logf))
    return (y_prompt, y_sample, p_fox_k, p_fox_v, p_fox_logf, p_sconv, p_cconv,
            s_fox_k, s_fox_v, s_fox_logf, s_sconv, s_cconv, s_gmlp_v)
```

```cpp
#include <hip/hip_runtime.h>
#include <hip/hip_cooperative_groups.h>
#include <cstdio>
#include <cstdint>
namespace cg = cooperative_groups;
__device__ __forceinline__ int opaque_tid() { int t = threadIdx.x; asm volatile("" : "+v"(t)); return t; }
namespace pg8 {
#define PG8_LAS __attribute__((address_space(3)))
typedef unsigned short bf16_t;
typedef short bf16x8 __attribute__((ext_vector_type(8)));
typedef float f32x4 __attribute__((ext_vector_type(4)));
typedef unsigned u32x4 __attribute__((ext_vector_type(4)));
constexpr int BM = 256, BK = 64, HALF = 128, HTB = HALF * BK * 2  , STAGE_BYTES = 8 * HTB, NXCD = 8, WGM = 8;

__host__ __device__ __forceinline__ int lds_byte(int r, int c) { const int st = (r >> 4) * 2 + (c >> 5), rr = r & 15, cc = c & 31, ob = rr * 64 + cc * 2; return st * 1024 + (ob ^ (((ob >> 9) & 1) << 5)); }
__host__ __device__ __forceinline__ void stage_rc(int b, int& R, int& C) { const int st = b / 1024, sb = b % 1024, swz = sb ^ (((sb >> 9) & 1) << 5); R = (st >> 1) * 16 + swz / 64; C = (st & 1) * 32 + (swz % 64) / 2; }
__host__ __device__ __forceinline__ int perm32(int rho) { const int n = rho >> 4, i = rho & 15; return 8 * (i >> 2) + 4 * n + (i & 3); }

struct Unit { int pm, pn; };
struct Gemm { const bf16_t* A; const bf16_t* Bt; int M, N, K; };

struct StaticOrder {
    int nM, nN, nwg, G, c;
    __host__ __device__ void init(int M, int N, int G_, int c_) { nM = M / BM; nN = N / BM; nwg = nM * nN; G = G_; c = c_; }
    __host__ __device__ bool next(int i, Unit& u) const {
        const long L = (long)i * G + c; if (L >= nwg) return false;
        int wgid = (int)L; { const int q = nwg / NXCD, r = nwg % NXCD, xcd = wgid % NXCD, off = wgid / NXCD; wgid = (xcd < r ? xcd * (q + 1) : r * (q + 1) + (xcd - r) * q) + off; }
        const int nig = WGM * nN, gid = wgid / nig, fm = gid * WGM, gsz = (nM - fm) < WGM ? (nM - fm) : WGM;
        u.pm = fm + ((wgid % nig) % gsz); u.pn = (wgid % nig) / gsz; return true;
    }
    __device__ __forceinline__ void a_ready(const Unit&) const {}
    __device__ __forceinline__ void done(const Unit&) const {}
};

typedef float f32x2 __attribute__((ext_vector_type(2)));
typedef __bf16 bf16x2_t __attribute__((ext_vector_type(2)));
__device__ __forceinline__ unsigned pk2(float lo, float hi) { f32x2 v = {lo, hi}; bf16x2_t b = __builtin_convertvector(v, bf16x2_t); return __builtin_bit_cast(unsigned, b); }
__device__ __forceinline__ u32x4 pk8(f32x4 a, f32x4 b) { u32x4 w; w.x = pk2(a[0], a[1]); w.y = pk2(a[2], a[3]); w.z = pk2(b[0], b[1]); w.w = pk2(b[2], b[3]); return w; }
__device__ __forceinline__ float fast_exp(float x) { return __builtin_amdgcn_exp2f(x * 1.4426950408889634f); }
__device__ __forceinline__ float sigmoidf_(float x) { return __builtin_amdgcn_rcpf(1.0f + fast_exp(-x)); }
__device__ __forceinline__ float siluf_(float x) { return x * sigmoidf_(x); }
__device__ __forceinline__ float gelu_tanh(float x) { const float u = 1.5957691216057308f * (x + 0.044715f * x * x * x); return x * sigmoidf_(u); }
constexpr int MROWS = 16512;
constexpr float RMS_EPS = 1e-6f;

struct EpiSwiglu {
    static constexpr bool PERM = true, AFTER_DRAIN = false;
    const float* ssq; bf16_t* O;
    __device__ __forceinline__ void operator()(const f32x4 (&acc)[2][2][4][2], const Unit& u, int wr, int wc, int fr, int fq) const {
        const int row0 = u.pm * BM + wr * 64 + fr, col0 = u.pn * 128 + wc * 32 + 8 * fq;
#pragma unroll
        for (int ai = 0; ai < 2; ++ai)
#pragma unroll
            for (int m = 0; m < 4; ++m) { const int row = row0 + ai * HALF + m * 16; const float rs = __builtin_amdgcn_rsqf(ssq[row] * (1.0f / 1024.0f) + RMS_EPS);
                f32x4 o0, o1;
#pragma unroll
                for (int e = 0; e < 4; ++e) { o0[e] = siluf_(acc[ai][0][m][0][e] * rs) * (acc[ai][1][m][0][e] * rs); o1[e] = siluf_(acc[ai][0][m][1][e] * rs) * (acc[ai][1][m][1][e] * rs); }
                *(u32x4*)(O + (size_t)row * 2816 + col0) = pk8(o0, o1); }
    }
};
struct EpiResid {
    static constexpr bool PERM = true, AFTER_DRAIN = false;
    float* X; bf16_t* XB; float* ssq_out; float scale;
    __device__ __forceinline__ void operator()(const f32x4 (&acc)[2][2][4][2], const Unit& u, int wr, int wc, int fr, int fq) const {
        const int row0 = u.pm * BM + wr * 64 + fr, col0 = u.pn * BM + wc * 32 + 8 * fq;
#pragma unroll
        for (int ai = 0; ai < 2; ++ai)
#pragma unroll
            for (int m = 0; m < 4; ++m) { const int row = row0 + ai * HALF + m * 16; const bool valid = row < MROWS; float ss = 0.f;
#pragma unroll
                for (int bj = 0; bj < 2; ++bj) { float* xp = X + (size_t)row * 1024 + col0 + bj * HALF;
                    f32x4 x0 = {0.f, 0.f, 0.f, 0.f}, x1 = {0.f, 0.f, 0.f, 0.f};
                    if (valid) { x0 = *(const f32x4*)xp; x1 = *(const f32x4*)(xp + 4); }
                    x0 += acc[ai][bj][m][0] * scale; x1 += acc[ai][bj][m][1] * scale;
                    if (valid) { *(f32x4*)xp = x0; *(f32x4*)(xp + 4) = x1; }
                    *(u32x4*)(XB + (size_t)row * 1024 + col0 + bj * HALF) = pk8(x0, x1);
                    ss += (x0[0] * x0[0] + x0[1] * x0[1]) + (x0[2] * x0[2] + x0[3] * x0[3]) + (x1[0] * x1[0] + x1[1] * x1[1]) + (x1[2] * x1[2] + x1[3] * x1[3]); }
                ss += __shfl_xor(ss, 16); ss += __shfl_xor(ss, 32);
                if (fq == 0) atomicAdd(ssq_out + row, ss); }
    }
};
constexpr float QSCALE = 0.125f * 1.4426950408889634f;
struct EpiEvenIn {
    static constexpr bool PERM = true, AFTER_DRAIN = false;
    const float* ssq; bf16_t* ZB; float* pk_; float* pv_; float* plf; float* sk_; float* sv_; float* slf; const float* b_f;
    __device__ __forceinline__ void operator()(const f32x4 (&acc)[2][2][4][2], const Unit& u, int wr, int wc, int fr, int fq) const {
        const int row0 = u.pm * BM + wr * 64 + fr, pn = u.pn, lc = wc * 32 + 8 * fq;
#pragma unroll
        for (int ai = 0; ai < 2; ++ai)
#pragma unroll
            for (int m = 0; m < 4; ++m) { const int row = row0 + ai * HALF + m * 16; const float rs = __builtin_amdgcn_rsqf(ssq[row] * (1.0f / 1024.0f) + RMS_EPS);
                if (pn < 12) {
                    const float sc = (pn == 6 || pn == 7) ? rs * QSCALE : rs;
#pragma unroll
                    for (int bj = 0; bj < 2; ++bj) { const int col = pn * BM + bj * HALF + lc; const f32x4 v0 = acc[ai][bj][m][0] * sc, v1 = acc[ai][bj][m][1] * sc;
                        *(u32x4*)(ZB + (size_t)row * 3072 + col) = pk8(v0, v1);
                        if (pn >= 8 && row < MROWS) { const int cc = (pn >= 10) ? col - 2560 : col - 2048;
                            float* dst = (row < 16384) ? ((pn >= 10 ? pv_ : pk_) + (size_t)row * 512 + cc) : ((pn >= 10 ? sv_ : sk_) + (size_t)(row - 16384) * 512 + cc);
                            *(f32x4*)dst = v0; *(f32x4*)(dst + 4) = v1; } }
                } else if (wc == 0 && fq == 0 && row < MROWS) {
                    float* dst = (row < 16384) ? plf + (size_t)row * 8 : slf + (size_t)(row - 16384) * 8; f32x4 o0, o1;
#pragma unroll
                    for (int e = 0; e < 4; ++e) { const float a = acc[ai][0][m][0][e] * rs + b_f[e], b = acc[ai][0][m][1][e] * rs + b_f[4 + e];
                        o0[e] = fminf(a, 0.f) - log1pf(__expf(-fabsf(a))); o1[e] = fminf(b, 0.f) - log1pf(__expf(-fabsf(b))); }
                    *(f32x4*)dst = o0; *(f32x4*)(dst + 4) = o1; }
            }
    }
};
struct EpiOddIn {
    static constexpr bool PERM = true, AFTER_DRAIN = false;
    const float* ssq; bf16_t* ZO;
    __device__ __forceinline__ void operator()(const f32x4 (&acc)[2][2][4][2], const Unit& u, int wr, int wc, int fr, int fq) const {
        const int row0 = u.pm * BM + wr * 64 + fr, pn = u.pn, lc = wc * 32 + 8 * fq;
#pragma unroll
        for (int ai = 0; ai < 2; ++ai)
#pragma unroll
            for (int m = 0; m < 4; ++m) { const int row = row0 + ai * HALF + m * 16; const float rs = __builtin_amdgcn_rsqf(ssq[row] * (1.0f / 1024.0f) + RMS_EPS);
                if (pn < 4) {
#pragma unroll
                    for (int bj = 0; bj < 2; ++bj) { f32x4 v0, v1;
#pragma unroll
                        for (int e = 0; e < 4; ++e) { v0[e] = gelu_tanh(acc[ai][bj][m][0][e] * rs); v1[e] = gelu_tanh(acc[ai][bj][m][1][e] * rs); }
                        *(u32x4*)(ZO + (size_t)row * 1536 + pn * BM + bj * HALF + lc) = pk8(v0, v1); }
                } else { f32x4 v0, v1;
#pragma unroll
                    for (int e = 0; e < 4; ++e) { v0[e] = acc[ai][0][m][0][e] * rs * sigmoidf_(acc[ai][1][m][0][e] * rs); v1[e] = acc[ai][0][m][1][e] * rs * sigmoidf_(acc[ai][1][m][1][e] * rs); }
                    *(u32x4*)(ZO + (size_t)row * 1536 + 1024 + (pn - 4) * HALF + lc) = pk8(v0, v1); }
            }
    }
};
template <class Epi, class Sched, bool ALIGN_EPI = false, bool SP2 = false>
__device__ __forceinline__ void gemm_phase(PG8_LAS unsigned char* lds, const Gemm g, const Sched& S, const Epi& E) {
    const int tid = opaque_tid(), wid = __builtin_amdgcn_readfirstlane(tid >> 6), lane = tid & 63, wr = wid >> 2, wc = wid & 3, fr = lane & 15, fq = lane >> 4;
    const int K = g.K, nt = K / BK;
    unsigned voffA[2], voffB[2];
#pragma unroll
    for (int i = 0; i < 2; ++i) { int R, C; stage_rc(tid * 16 + i * 8192, R, C); const int Rb = Epi::PERM ? ((R & ~31) + perm32(R & 31)) : R;
        voffA[i] = (unsigned)(R * K + C) * 2u; voffB[i] = (unsigned)(Rb * K + C) * 2u; }
    const size_t kstep = (size_t)(BK * 2);
    const size_t hstep = (size_t)HALF * K * 2;
    const size_t tstep = 2 * hstep;
    const unsigned ldsw = (unsigned)wid * 1024u;
    const int aoff = lds_byte(wr * 64 + fr, fq * 8), boff = lds_byte(wc * 32 + fr, fq * 8);
#define PG8_SA(b, h) (((b) * 2 + (h)) * HTB)
#define PG8_SB(b, h) ((4 + (b) * 2 + (h)) * HTB)
#define PG8_STAGE(bufoff, gbase, voff) do { _Pragma("unroll") for (int _i = 0; _i < 2; ++_i) \
        __builtin_amdgcn_global_load_lds((const unsigned*)((const char*)(gbase) + (voff)[_i]), (PG8_LAS unsigned*)(lds + (bufoff) + ldsw + _i * 8192), 16, 0, 0); } while (0)
#define PG8_LDA(dst, b, h) do { _Pragma("unroll") for (int m = 0; m < 4; ++m) _Pragma("unroll") for (int k = 0; k < 2; ++k) dst[m][k] = *(const PG8_LAS bf16x8*)(lds + PG8_SA(b, h) + aoff + m * 2048 + k * 1024); } while (0)
#define PG8_LDB(dst, b, h) do { _Pragma("unroll") for (int n = 0; n < 2; ++n) _Pragma("unroll") for (int k = 0; k < 2; ++k) dst[n][k] = *(const PG8_LAS bf16x8*)(lds + PG8_SB(b, h) + boff + n * 2048 + k * 1024); } while (0)
#define PG8_MMA(ai, bj, At, Bt) do { __builtin_amdgcn_s_setprio(1); _Pragma("unroll") for (int m = 0; m < 4; ++m) _Pragma("unroll") for (int n = 0; n < 2; ++n) _Pragma("unroll") for (int k = 0; k < 2; ++k) \
        acc[ai][bj][m][n] = __builtin_amdgcn_mfma_f32_16x16x32_bf16(Bt[n][k], At[m][k], acc[ai][bj][m][n], 0, 0, 0); __builtin_amdgcn_s_setprio(0); } while (0)
#define PG8_WAIT_V(n) asm volatile("s_waitcnt vmcnt(" #n ")" ::: "memory")
#define PG8_WAIT_L(n) asm volatile("s_waitcnt lgkmcnt(" #n ")" ::: "memory")
#define PG8_BAR __builtin_amdgcn_s_barrier()
#define PG8_SCHED __builtin_amdgcn_sched_barrier(0)
    Unit cur, nxt; int ui = 0;
    if (!S.next(0, cur)) return;
    f32x4 acc[2][2][4][2];
#pragma unroll
    for (int a = 0; a < 2; ++a)
#pragma unroll
        for (int b = 0; b < 2; ++b)
#pragma unroll
            for (int m = 0; m < 4; ++m)
#pragma unroll
                for (int n = 0; n < 2; ++n) acc[a][b][m][n] = (f32x4){0.f, 0.f, 0.f, 0.f};
    bf16x8 At[4][2], B0[2][2], B1[2][2];
    const char* cA = (const char*)g.A + (size_t)cur.pm * tstep; const char* cB = (const char*)g.Bt + (size_t)cur.pn * tstep;
    S.a_ready(cur);
    if constexpr (SP2) {
        PG8_STAGE(PG8_SB(0, 0), cB, voffB); PG8_STAGE(PG8_SB(0, 1), cB + hstep, voffB); PG8_STAGE(PG8_SA(0, 0), cA, voffA); PG8_STAGE(PG8_SA(0, 1), cA + hstep, voffA);
        if (wr == 1) PG8_BAR;
        PG8_WAIT_V(2); PG8_BAR;
        PG8_STAGE(PG8_SB(1, 0), cB + kstep, voffB); PG8_STAGE(PG8_SA(1, 0), cA + kstep, voffA); PG8_STAGE(PG8_SB(1, 1), cB + hstep + kstep, voffB);
        PG8_WAIT_V(6); PG8_BAR;
    } else {
        PG8_STAGE(PG8_SB(0, 0), cB, voffB); PG8_STAGE(PG8_SA(0, 0), cA, voffA); PG8_STAGE(PG8_SB(0, 1), cB + hstep, voffB); PG8_STAGE(PG8_SA(0, 1), cA + hstep, voffA);
        if (wr == 1) PG8_BAR;
        PG8_WAIT_V(4); PG8_BAR;
        PG8_STAGE(PG8_SB(1, 0), cB + kstep, voffB); PG8_STAGE(PG8_SA(1, 0), cA + kstep, voffA); PG8_STAGE(PG8_SB(1, 1), cB + hstep + kstep, voffB);
        PG8_WAIT_V(6); PG8_BAR;
    }
    for (;;) {
        const bool has_next = S.next(ui + 1, nxt);
        const char* nA = has_next ? (const char*)g.A + (size_t)nxt.pm * tstep : cA; const char* nB = has_next ? (const char*)g.Bt + (size_t)nxt.pn * tstep : cB;
        for (int t = 0; t < nt; t += 2) {
            const bool last = (t == nt - 2);
            const char* a1 = cA + (size_t)(t + 1) * kstep;
            const char* a2 = last ? nA : cA + (size_t)(t + 2) * kstep; const char* b2 = last ? nB : cB + (size_t)(t + 2) * kstep;
            const char* a3 = a2 + kstep; const char* b3 = b2 + kstep;
            if (last && has_next) S.a_ready(nxt);
            if constexpr (SP2) {
            PG8_LDB(B0, 0, 0); PG8_LDB(B1, 0, 1); PG8_SCHED; PG8_LDA(At, 0, 0); PG8_STAGE(PG8_SA(1, 1), a1 + hstep, voffA);
            PG8_WAIT_V(8); PG8_WAIT_L(0); PG8_BAR; PG8_MMA(0, 0, At, B0); PG8_MMA(0, 1, At, B1); PG8_BAR; PG8_SCHED;
            PG8_LDA(At, 0, 1); PG8_STAGE(PG8_SB(0, 0), b2, voffB); PG8_STAGE(PG8_SB(0, 1), b2 + hstep, voffB); PG8_STAGE(PG8_SA(0, 0), a2, voffA);
            PG8_WAIT_V(8); PG8_WAIT_L(0); PG8_BAR; PG8_MMA(1, 0, At, B0); PG8_MMA(1, 1, At, B1); PG8_BAR; PG8_SCHED;
            PG8_LDB(B0, 1, 0); PG8_LDB(B1, 1, 1); PG8_SCHED; PG8_LDA(At, 1, 0); PG8_STAGE(PG8_SA(0, 1), a2 + hstep, voffA);
            PG8_WAIT_V(8); PG8_WAIT_L(0); PG8_BAR; PG8_MMA(0, 0, At, B0); PG8_MMA(0, 1, At, B1); PG8_BAR; PG8_SCHED;
            PG8_LDA(At, 1, 1); PG8_STAGE(PG8_SB(1, 0), b3, voffB); PG8_STAGE(PG8_SB(1, 1), b3 + hstep, voffB); PG8_STAGE(PG8_SA(1, 0), a3, voffA);
            PG8_WAIT_V(8); PG8_WAIT_L(0); PG8_BAR; PG8_MMA(1, 0, At, B0); PG8_MMA(1, 1, At, B1); PG8_BAR; PG8_SCHED;
            } else {
            PG8_LDB(B0, 0, 0); PG8_SCHED; PG8_LDA(At, 0, 0); PG8_STAGE(PG8_SA(1, 1), a1 + hstep, voffA);
            PG8_WAIT_L(8); PG8_BAR; PG8_WAIT_L(0); PG8_MMA(0, 0, At, B0); PG8_BAR; PG8_SCHED;
            PG8_LDB(B1, 0, 1); PG8_STAGE(PG8_SB(0, 0), b2, voffB);
            PG8_BAR; PG8_WAIT_L(0); PG8_MMA(0, 1, At, B1); PG8_BAR;
            PG8_LDA(At, 0, 1); PG8_STAGE(PG8_SA(0, 0), a2, voffA);
            PG8_BAR; PG8_WAIT_L(0); PG8_MMA(1, 0, At, B0); PG8_BAR; PG8_SCHED;
            PG8_STAGE(PG8_SB(0, 1), b2 + hstep, voffB);
            PG8_WAIT_V(6); PG8_BAR; PG8_MMA(1, 1, At, B1); PG8_BAR;
            PG8_LDB(B0, 1, 0); PG8_SCHED; PG8_LDA(At, 1, 0); PG8_STAGE(PG8_SA(0, 1), a2 + hstep, voffA);
            PG8_WAIT_L(8); PG8_BAR; PG8_WAIT_L(0); PG8_MMA(0, 0, At, B0); PG8_BAR; PG8_SCHED;
            PG8_LDB(B1, 1, 1); PG8_STAGE(PG8_SB(1, 0), b3, voffB);
            PG8_BAR; PG8_WAIT_L(0); PG8_MMA(0, 1, At, B1); PG8_BAR;
            PG8_LDA(At, 1, 1); PG8_STAGE(PG8_SA(1, 0), a3, voffA);
            PG8_BAR; PG8_WAIT_L(0); PG8_MMA(1, 0, At, B0); PG8_BAR; PG8_SCHED;
            PG8_STAGE(PG8_SB(1, 1), b3 + hstep, voffB);
            PG8_WAIT_V(6); PG8_BAR; PG8_MMA(1, 1, At, B1); PG8_BAR;
            }
        }
        if constexpr (ALIGN_EPI) { if (wr == 0) PG8_BAR; }
        if constexpr (!Epi::AFTER_DRAIN) { E(acc, cur, wr, wc, fr, fq); S.done(cur); }
        if (!has_next) break;
#pragma unroll
        for (int a = 0; a < 2; ++a)
#pragma unroll
            for (int b = 0; b < 2; ++b)
#pragma unroll
                for (int m = 0; m < 4; ++m)
#pragma unroll
                    for (int n = 0; n < 2; ++n) acc[a][b][m][n] = (f32x4){0.f, 0.f, 0.f, 0.f};
        cur = nxt; cA = nA; cB = nB; ++ui;
        if constexpr (ALIGN_EPI) { if (wr == 1) PG8_BAR; }
    }
    PG8_WAIT_V(0);
    if constexpr (!ALIGN_EPI) { if (wr == 0) PG8_BAR; }
    PG8_BAR;
    if constexpr (Epi::AFTER_DRAIN) { E.fused(acc, cur, wr, wc, fr, fq, lds, wid, lane); S.done(cur); }
#undef PG8_SA
#undef PG8_SB
#undef PG8_STAGE
#undef PG8_LDA
#undef PG8_LDB
#undef PG8_MMA
#undef PG8_WAIT_V
#undef PG8_WAIT_L
#undef PG8_BAR
#undef PG8_SCHED
}
}
typedef unsigned short bf16_t;
typedef short bf16x8 __attribute__((ext_vector_type(8)));
typedef float f32x4 __attribute__((ext_vector_type(4)));
typedef float f32x16 __attribute__((ext_vector_type(16)));
typedef unsigned u32x4 __attribute__((ext_vector_type(4)));
typedef unsigned u32x2 __attribute__((ext_vector_type(2)));
using pg8::pk2; using pg8::pk8; using pg8::MROWS; using pg8::RMS_EPS;
constexpr int NTHR = 512, NWAVES = 8;
constexpr int MP = 16384, MT = 16640, DM = 1024, DFF = 2816;
constexpr size_t MiB = 1u << 20;
constexpr size_t WS_SSQ = 1 * MiB, WS_WSB = 2 * MiB, WS_W1 = 3 * MiB, WS_W2 = 47 * MiB, WS_EIN = 69 * MiB, WS_EOUT = 76 * MiB, WS_OIN = 78 * MiB, WS_OOUT = 82 * MiB,
                 WS_XB = 84 * MiB, WS_CAT = 117 * MiB, WS_BIG = 150 * MiB, WS_END = 248 * MiB;
constexpr size_t W1_BYTES = 11 * MiB, W2_BYTES = 5767168;
constexpr int LDS_BYTES = 147456;
constexpr size_t O_YP = 0, O_YS = 16777216, O_PK = O_YS + 131072, O_PV = O_PK + 8388608, O_PLF = O_PV + 8388608, O_PSC = O_PLF + 131072, O_PCC = O_PSC + 8192,
                 O_SK = O_PCC + 122880, O_SV = O_SK + 65536, O_SLF = O_SV + 65536, O_SSC = O_SLF + 1024, O_SCC = O_SSC + 8192, O_SGV = O_SCC + 122880, O_END = O_SGV + 65536;
constexpr float LOG2E = 1.4426950408889634f;

struct Params { const float* in[31]; float* out; unsigned char* ws; };

__device__ __forceinline__ float wave_sum(float v) {
#pragma unroll
    for (int o = 1; o < 64; o <<= 1) v += __shfl_xor(v, o);
    return v;
}
__device__ __forceinline__ float bf2f(unsigned short b) { return __uint_as_float((unsigned)b << 16); }
__device__ __forceinline__ float bflo(unsigned w) { return __uint_as_float(w << 16); }
__device__ __forceinline__ float bfhi(unsigned w) { return __uint_as_float(w & 0xffff0000u); }

__device__ __forceinline__ int map_row(int mode, int n0) {
    if (mode == 0) return n0;
    if (mode == 1) return (n0 >> 7) * 256 + (n0 & 127);
    if (mode == 2) return (n0 >> 7) * 256 + 128 + (n0 & 127);
    if (n0 < 1024) return n0;
    if (n0 < 1536) { const int j = n0 - 1024; return 1024 + (j >> 7) * 256 + (j & 127); }
    { const int j = n0 - 1536; return 1024 + (j >> 7) * 256 + 128 + (j & 127); }
}
__device__ __forceinline__ void tr_item(const float* __restrict__ W, const float* __restrict__ gain, int K, int Nsrc, int nblk, bf16_t* WT, int mode, float* scr, int item, int lane) {
    const int kb = item / nblk, nb = item - kb * nblk, k0 = 64 * kb, n0 = 32 * nb;
    const int n = n0 + (lane & 31); const bool nv = n < Nsrc;
#pragma unroll 8
    for (int i = 0; i < 32; ++i) { const int kk = 2 * i + (lane >> 5); float v = nv ? W[(size_t)(k0 + kk) * Nsrc + n] : 0.f; if (gain) v *= gain[k0 + kk]; scr[kk * 33 + (lane & 31)] = v; }
    asm volatile("s_waitcnt lgkmcnt(0)" ::: "memory");
    const int c = lane & 7, rb = map_row(mode, n0);
#pragma unroll
    for (int j = 0; j < 4; ++j) { const int nn = (lane >> 3) + 8 * j; const float* s = scr + (8 * c) * 33 + nn;
        u32x4 o; o.x = pk2(s[0 * 33], s[1 * 33]); o.y = pk2(s[2 * 33], s[3 * 33]); o.z = pk2(s[4 * 33], s[5 * 33]); o.w = pk2(s[6 * 33], s[7 * 33]);
        *(u32x4*)(WT + (size_t)(rb + nn) * K + k0 + 8 * c) = o; }
    asm volatile("s_waitcnt lgkmcnt(0)" ::: "memory");
}

__device__ __forceinline__ int crow(int r, int hi) { return (r & 3) + 8 * (r >> 2) + 4 * hi; }
struct AttnState { float m, l; f32x16 o[2]; };
__device__ __forceinline__ void attn_tile(AttnState& st, const bf16x8 (&kf)[2][4], const bf16x8 (&vf)[2][4], const bf16x8 (&qr)[4], const float* clt, int hi, int kv_limit) {
    f32x16 p[2];
#pragma unroll
    for (int kvb = 0; kvb < 2; ++kvb) { p[kvb] = f32x16{};
#pragma unroll
        for (int d0 = 0; d0 < 4; ++d0) p[kvb] = __builtin_amdgcn_mfma_f32_32x32x16_bf16(kf[kvb][d0], qr[d0], p[kvb], 0, 0, 0); }
    float mx = -1e30f;
#pragma unroll
    for (int kvb = 0; kvb < 2; ++kvb)
#pragma unroll
        for (int r4 = 0; r4 < 4; ++r4) { const f32x4 bv = *(const f32x4*)(clt + 32 * kvb + 8 * r4 + 4 * hi);
#pragma unroll
            for (int e = 0; e < 4; ++e) { const int kvl = 32 * kvb + 8 * r4 + 4 * hi + e; float s = p[kvb][4 * r4 + e] + bv[e]; s = (kvl > kv_limit) ? -1e30f : s; p[kvb][4 * r4 + e] = s; mx = fmaxf(mx, s); } }
    mx = fmaxf(mx, __shfl_xor(mx, 32));
    const float mn = fmaxf(st.m, mx), alpha = __builtin_amdgcn_exp2f(st.m - mn); st.m = mn;
    float ls = 0.f;
#pragma unroll
    for (int kvb = 0; kvb < 2; ++kvb)
#pragma unroll
        for (int r = 0; r < 16; ++r) { const float e = __builtin_amdgcn_exp2f(p[kvb][r] - mn); p[kvb][r] = e; ls += e; }
    st.l = st.l * alpha + ls;
#pragma unroll
    for (int db = 0; db < 2; ++db)
#pragma unroll
        for (int r = 0; r < 16; ++r) st.o[db][r] *= alpha;
    bf16x8 pb[4];
#pragma unroll
    for (int s = 0; s < 4; ++s) { const int kvb = s >> 1, b0 = 8 * (s & 1);
        u32x4 w; w.x = pk2(p[kvb][b0 + 0], p[kvb][b0 + 1]); w.y = pk2(p[kvb][b0 + 2], p[kvb][b0 + 3]); w.z = pk2(p[kvb][b0 + 4], p[kvb][b0 + 5]); w.w = pk2(p[kvb][b0 + 6], p[kvb][b0 + 7]);
        pb[s] = __builtin_bit_cast(bf16x8, w); }
#pragma unroll
    for (int db = 0; db < 2; ++db)
#pragma unroll
        for (int s = 0; s < 4; ++s) st.o[db] = __builtin_amdgcn_mfma_f32_32x32x16_bf16(vf[db][s], pb[s], st.o[db], 0, 0, 0);
}
template <int NV, class F> __device__ __forceinline__ void block_cumsum(float* cl, float* tmp, F getv, int tid, int lane, int wid) {
    float v[NV];
#pragma unroll
    for (int e = 0; e < NV; ++e) v[e] = getv(NV * tid + e);
#pragma unroll
    for (int e = 1; e < NV; ++e) v[e] += v[e - 1];
    const float tot = v[NV - 1]; float sc = tot;
#pragma unroll
    for (int off = 1; off < 64; off <<= 1) { const float t = __shfl_up(sc, off); if (lane >= off) sc += t; }
    if (lane == 63) tmp[wid] = sc;
    __syncthreads();
    float base = 0.f;
#pragma unroll
    for (int w = 0; w < 8; ++w) base += (w < wid) ? tmp[w] : 0.f;
    const float excl = base + sc - tot;
#pragma unroll
    for (int e = 0; e < NV; ++e) cl[NV * tid + e] = -(excl + v[e]) * LOG2E;
}
constexpr int AL_KS = 0, AL_VT = 18432, AL_CL = 35840, AL_TMP = 35840 + 10240, AL_OW = 49152, AL_ML = 49152 + 65536;

__device__ __forceinline__ void attn_prompt_unit(unsigned char* lds, int b, int h, int qb, const bf16_t* __restrict__ ZB, const float* __restrict__ logf, bf16_t* CAT) {
    const int tid = opaque_tid(), lane = tid & 63, wid = __builtin_amdgcn_readfirstlane(tid >> 6), r32 = lane & 31, hi = lane >> 5;
    float* cl = (float*)(lds + AL_CL); float* tmp = (float*)(lds + AL_TMP);
    const int rowbase = b * 2048, q0 = qb * 256, NT = 4 * (qb + 1), nk = NT * 64;
    block_cumsum<4>(cl, tmp, [&](int k) { return (k < nk) ? logf[(size_t)(rowbase + k) * 8 + h] : 0.f; }, tid, lane, wid);
    const bf16_t* Qp = ZB + (size_t)(rowbase + q0 + 32 * wid + r32) * 3072 + 1536 + h * 64;
    bf16x8 qr[4];
#pragma unroll
    for (int d0 = 0; d0 < 4; ++d0) qr[d0] = *(const bf16x8*)(Qp + 16 * d0 + 8 * hi);
    const int lkv = tid >> 3, lch = tid & 7;
    const bf16_t* Kg = ZB + (size_t)(rowbase + lkv) * 3072 + 2048 + h * 64 + 8 * lch; const bf16_t* Vg = Kg + 512;
    u32x4 kreg = *(const u32x4*)Kg, vreg = *(const u32x4*)Vg;
    auto stage = [&](int buf) {
        *(u32x4*)(lds + AL_KS + buf * 9216 + lkv * 144 + lch * 16) = kreg;
        unsigned short* vt = (unsigned short*)(lds + AL_VT + buf * 8704) + (8 * lch) * 68 + lkv;
        vt[0 * 68] = (unsigned short)(vreg.x & 0xffff); vt[1 * 68] = (unsigned short)(vreg.x >> 16); vt[2 * 68] = (unsigned short)(vreg.y & 0xffff); vt[3 * 68] = (unsigned short)(vreg.y >> 16);
        vt[4 * 68] = (unsigned short)(vreg.z & 0xffff); vt[5 * 68] = (unsigned short)(vreg.z >> 16); vt[6 * 68] = (unsigned short)(vreg.w & 0xffff); vt[7 * 68] = (unsigned short)(vreg.w >> 16); };
    stage(0);
    __syncthreads();
    AttnState st; st.m = -1e30f; st.l = 0.f; st.o[0] = f32x16{}; st.o[1] = f32x16{};
    const int qg = q0 + 32 * wid + r32;
    for (int t = 0; t < NT; ++t) {
        if (t + 1 < NT) { kreg = *(const u32x4*)(Kg + (size_t)(t + 1) * 64 * 3072); vreg = *(const u32x4*)(Vg + (size_t)(t + 1) * 64 * 3072); }
        if (64 * t <= q0 + 32 * wid + 31) {
            const unsigned char* ks = lds + AL_KS + (t & 1) * 9216; const unsigned char* vt = lds + AL_VT + (t & 1) * 8704;
            bf16x8 kf[2][4], vf[2][4];
#pragma unroll
            for (int kvb = 0; kvb < 2; ++kvb)
#pragma unroll
                for (int d0 = 0; d0 < 4; ++d0) kf[kvb][d0] = *(const bf16x8*)(ks + (32 * kvb + r32) * 144 + (16 * d0 + 8 * hi) * 2);
#pragma unroll
            for (int db = 0; db < 2; ++db)
#pragma unroll
                for (int s = 0; s < 4; ++s) { const unsigned char* p = vt + (32 * db + r32) * 136 + (16 * s + 4 * hi) * 2; const u32x2 lo = *(const u32x2*)p, hv = *(const u32x2*)(p + 16);
                    vf[db][s] = __builtin_bit_cast(bf16x8, (u32x4){lo.x, lo.y, hv.x, hv.y}); }
            attn_tile(st, kf, vf, qr, cl + 64 * t, hi, qg - 64 * t);
        }
        if (t + 1 < NT) stage((t + 1) & 1);
        __syncthreads();
    }
    const float lt = st.l + __shfl_xor(st.l, 32), inv = 1.0f / lt;
    bf16_t* Op = CAT + (size_t)(rowbase + qg) * 1024 + 512 + h * 64 + 4 * hi;
#pragma unroll
    for (int db = 0; db < 2; ++db)
#pragma unroll
        for (int r4 = 0; r4 < 4; ++r4) { u32x2 w; w.x = pk2(st.o[db][4 * r4] * inv, st.o[db][4 * r4 + 1] * inv); w.y = pk2(st.o[db][4 * r4 + 2] * inv, st.o[db][4 * r4 + 3] * inv);
            *(u32x2*)(Op + 32 * db + 8 * r4) = w; }
}

__device__ __forceinline__ void attn_sample_unit(unsigned char* lds, int b, int h, const bf16_t* __restrict__ ZB, const float* __restrict__ cK, const float* __restrict__ cV, const float* __restrict__ cLF,
                                                 const float* __restrict__ nK, const float* __restrict__ nV, const float* __restrict__ nLF, bf16_t* CAT) {
    const int tid = opaque_tid(), lane = tid & 63, wid = __builtin_amdgcn_readfirstlane(tid >> 6), r32 = lane & 31, hi = lane >> 5;
    float* cl = (float*)(lds + AL_CL); float* tmp = (float*)(lds + AL_TMP);
    block_cumsum<5>(cl, tmp, [&](int k) { return (k < 2048) ? cLF[(size_t)(b * 2048 + k) * 8 + h] : ((k < 2064) ? nLF[(size_t)(b * 16 + k - 2048) * 8 + h] : 0.f); }, tid, lane, wid);
    __syncthreads();
    const bf16_t* Qp = ZB + (size_t)(MP + 16 * b + r32) * 3072 + 1536 + h * 64;
    bf16x8 qr[4];
#pragma unroll
    for (int d0 = 0; d0 < 4; ++d0) qr[d0] = *(const bf16x8*)(Qp + 16 * d0 + 8 * hi);
    AttnState st; st.m = -1e30f; st.l = 0.f; st.o[0] = f32x16{}; st.o[1] = f32x16{};
    auto rowp = [&](const float* c, const float* n, int kv) -> const float* {
        return (kv < 2048) ? c + ((size_t)(b * 2048 + kv) * 8 + h) * 64 : n + ((size_t)(b * 16 + min(kv - 2048, 15)) * 8 + h) * 64; };
    for (int t = wid; t < 33; t += 8) {
        bf16x8 kf[2][4], vf[2][4];
#pragma unroll
        for (int kvb = 0; kvb < 2; ++kvb) { const float* kp = rowp(cK, nK, 64 * t + 32 * kvb + r32) + 8 * hi;
#pragma unroll
            for (int d0 = 0; d0 < 4; ++d0) { const f32x4 a = *(const f32x4*)(kp + 16 * d0), c = *(const f32x4*)(kp + 16 * d0 + 4); kf[kvb][d0] = __builtin_bit_cast(bf16x8, pk8(a, c)); } }
#pragma unroll
        for (int s = 0; s < 4; ++s) { float v0[8], v1[8];
#pragma unroll
            for (int j = 0; j < 8; ++j) { const float* vp = rowp(cV, nV, 64 * t + 16 * s + 4 * hi + (j & 3) + 8 * (j >> 2)); v0[j] = vp[r32]; v1[j] = vp[32 + r32]; }
            vf[0][s] = __builtin_bit_cast(bf16x8, pk8((f32x4){v0[0], v0[1], v0[2], v0[3]}, (f32x4){v0[4], v0[5], v0[6], v0[7]}));
            vf[1][s] = __builtin_bit_cast(bf16x8, pk8((f32x4){v1[0], v1[1], v1[2], v1[3]}, (f32x4){v1[4], v1[5], v1[6], v1[7]})); }
        attn_tile(st, kf, vf, qr, cl + 64 * t, hi, 2048 + r32 - 64 * t);
    }
    const float lt = st.l + __shfl_xor(st.l, 32);
    float* ow = (float*)(lds + AL_OW) + wid * 2048; float* ml = (float*)(lds + AL_ML) + wid * 64;
    if (hi == 0) { ml[r32] = st.m; ml[32 + r32] = lt; }
#pragma unroll
    for (int db = 0; db < 2; ++db)
#pragma unroll
        for (int r = 0; r < 16; ++r) ow[(32 * db + crow(r, hi)) * 32 + r32] = st.o[db][r];
    __syncthreads();
#pragma unroll
    for (int e = 0; e < 2; ++e) { const int oi = tid + 512 * e, q = oi >> 6, d = oi & 63; const float* mlb = (const float*)(lds + AL_ML); const float* owb = (const float*)(lds + AL_OW);
        float M = -1e30f;
#pragma unroll
        for (int w = 0; w < 8; ++w) M = fmaxf(M, mlb[w * 64 + q]);
        float L = 0.f, O = 0.f;
#pragma unroll
        for (int w = 0; w < 8; ++w) { const float f = __builtin_amdgcn_exp2f(mlb[w * 64 + q] - M); L += mlb[w * 64 + 32 + q] * f; O += owb[w * 2048 + d * 32 + q] * f; }
        CAT[(size_t)(MP + 16 * b + q) * 1024 + 512 + h * 64 + d] = (bf16_t)(pk2(O / L, 0.f) & 0xffff); }
    __syncthreads();
}

__device__ __forceinline__ void conva_item(int item, const bf16_t* __restrict__ ZB, const float* __restrict__ cw, const float* __restrict__ st_sc, bf16_t* CAT, float* out) {
    const int tid = opaque_tid(), rb = tid >> 6, ch = (tid & 63) * 8, R0 = item * 64 + rb * 8;
    if (R0 >= MROWS) return;
    float w0[8], w1[8], w2[8], p2[8], p1[8];
#pragma unroll
    for (int e = 0; e < 8; ++e) { w0[e] = cw[ch + e]; w1[e] = cw[512 + ch + e]; w2[e] = cw[1024 + ch + e]; }
    const bool samp = R0 >= MP; const bool start = samp ? (((R0 - MP) & 15) == 0) : ((R0 & 2047) == 0);
    auto prod = [&](int row, float* pr) { const u32x4 a = *(const u32x4*)(ZB + (size_t)row * 3072 + ch), c = *(const u32x4*)(ZB + (size_t)row * 3072 + 1024 + ch);
        pr[0] = bflo(a.x) * bflo(c.x); pr[1] = bfhi(a.x) * bfhi(c.x); pr[2] = bflo(a.y) * bflo(c.y); pr[3] = bfhi(a.y) * bfhi(c.y);
        pr[4] = bflo(a.z) * bflo(c.z); pr[5] = bfhi(a.z) * bfhi(c.z); pr[6] = bflo(a.w) * bflo(c.w); pr[7] = bfhi(a.w) * bfhi(c.w); };
    if (start) {
        if (samp) { const int b = (R0 - MP) >> 4;
#pragma unroll
            for (int e = 0; e < 8; ++e) { p2[e] = st_sc[(size_t)(b * 2 + 0) * 512 + ch + e]; p1[e] = st_sc[(size_t)(b * 2 + 1) * 512 + ch + e]; } }
        else {
#pragma unroll
            for (int e = 0; e < 8; ++e) { p2[e] = 0.f; p1[e] = 0.f; } }
    } else { prod(R0 - 2, p2); prod(R0 - 1, p1); }
#pragma unroll
    for (int i = 0; i < 8; ++i) { const int row = R0 + i; float p0[8]; prod(row, p0);
        const u32x4 g = *(const u32x4*)(ZB + (size_t)row * 3072 + 512 + ch);
        const float gbv[8] = {bflo(g.x), bfhi(g.x), bflo(g.y), bfhi(g.y), bflo(g.z), bfhi(g.z), bflo(g.w), bfhi(g.w)};
        float y[8];
#pragma unroll
        for (int e = 0; e < 8; ++e) y[e] = gbv[e] * (w0[e] * p2[e] + w1[e] * p1[e] + w2[e] * p0[e]);
        *(u32x4*)(CAT + (size_t)row * 1024 + ch) = pk8((f32x4){y[0], y[1], y[2], y[3]}, (f32x4){y[4], y[5], y[6], y[7]});
        int orow = -1; float* ob = nullptr;
        if (!samp) { const int tt = row & 2047; if (tt >= 2046) { orow = (row >> 11) * 2 + (tt - 2046); ob = out + O_PSC; } }
        else { const int ii = (row - MP) & 15; if (ii >= 14) { orow = ((row - MP) >> 4) * 2 + (ii - 14); ob = out + O_SSC; } }
        if (orow >= 0) { *(f32x4*)(ob + (size_t)orow * 512 + ch) = (f32x4){p0[0], p0[1], p0[2], p0[3]}; *(f32x4*)(ob + (size_t)orow * 512 + ch + 4) = (f32x4){p0[4], p0[5], p0[6], p0[7]}; }
#pragma unroll
        for (int e = 0; e < 8; ++e) { p2[e] = p1[e]; p1[e] = p0[e]; } }
}
constexpr int CL_STAT = 0, CL_VNT = 2048;
__device__ __forceinline__ void gmlp_unit(unsigned char* lds, int R0, int gh, bool samp, int sb, const bf16_t* __restrict__ ZO, const bf16_t* __restrict__ WSB, const float* __restrict__ lng, const float* __restrict__ lnb,
                                          const float* __restrict__ bs, bf16_t* CAT, float* out) {
    const int tid = opaque_tid(), lane = tid & 63, wid = __builtin_amdgcn_readfirstlane(tid >> 6), r32 = lane & 31, hi = lane >> 5;
    float* stat = (float*)(lds + CL_STAT);
    for (int i = 0; i < 16; ++i) { const int s = wid * 16 + i; const u32x4 a = *(const u32x4*)(ZO + (size_t)(R0 + s) * 1536 + 512 + 8 * lane);
        const float v[8] = {bflo(a.x), bfhi(a.x), bflo(a.y), bfhi(a.y), bflo(a.z), bfhi(a.z), bflo(a.w), bfhi(a.w)};
        float sm = 0.f;
#pragma unroll
        for (int e = 0; e < 8; ++e) sm += v[e];
        const float mean = wave_sum(sm) * (1.0f / 512.0f); float q = 0.f;
#pragma unroll
        for (int e = 0; e < 8; ++e) q += (v[e] - mean) * (v[e] - mean);
        const float rstd = __builtin_amdgcn_rsqf(wave_sum(q) * (1.0f / 512.0f) + RMS_EPS);
        if (lane == 0) { stat[2 * s] = mean; stat[2 * s + 1] = rstd; }
        if (samp && gh == 0 && s < 16) { float* o = out + O_SGV + (size_t)(sb * 16 + s) * 512 + 8 * lane;
#pragma unroll
            for (int e = 0; e < 8; ++e) o[e] = (v[e] - mean) * rstd * lng[8 * lane + e] + lnb[8 * lane + e]; } }
    __syncthreads();
    for (int gi = 0; gi < 4; ++gi) { const int g = gh * 4 + gi;
        { const int s = tid >> 2, c0 = 16 * (tid & 3); const float mean = stat[2 * s], rstd = stat[2 * s + 1];
            const bf16_t* src = ZO + (size_t)(R0 + s) * 1536 + 512 + g * 64 + c0; unsigned short* vt = (unsigned short*)(lds + CL_VNT) + c0 * 136 + s;
#pragma unroll
            for (int hh = 0; hh < 2; ++hh) { const u32x4 a = *(const u32x4*)(src + 8 * hh); const float v[8] = {bflo(a.x), bfhi(a.x), bflo(a.y), bfhi(a.y), bflo(a.z), bfhi(a.z), bflo(a.w), bfhi(a.w)};
#pragma unroll
                for (int e = 0; e < 8; ++e) { const int c = g * 64 + c0 + 8 * hh + e; const float y = (v[e] - mean) * rstd * lng[c] + lnb[c]; vt[(8 * hh + e) * 136] = (unsigned short)(pk2(y, 0.f) & 0xffff); } } }
        __syncthreads();
        { const int cb = wid & 1, tb = wid >> 1;
          if (!samp || tb == 0) {
            f32x16 acc = f32x16{};
            const unsigned char* ap = lds + CL_VNT + (32 * cb + r32) * 272 + 16 * hi; const bf16_t* bp = WSB + (size_t)(g * 128 + 32 * tb + r32) * 128 + 8 * hi;
            for (int ks = 0; ks < 2 * (tb + 1); ++ks) { const bf16x8 A = *(const bf16x8*)(ap + 32 * ks), B = *(const bf16x8*)(bp + 16 * ks); acc = __builtin_amdgcn_mfma_f32_32x32x16_bf16(A, B, acc, 0, 0, 0); }
            const int t = 32 * tb + r32; const float bst = bs[g * 128 + t];
            if (!samp || t < 16) {
#pragma unroll
                for (int r4 = 0; r4 < 4; ++r4) { const int c = g * 64 + 32 * cb + 8 * r4 + 4 * hi; const u32x2 uu = *(const u32x2*)(ZO + (size_t)(R0 + t) * 1536 + c);
                    u32x2 w; w.x = pk2(bflo(uu.x) * (acc[4 * r4] + bst), bfhi(uu.x) * (acc[4 * r4 + 1] + bst)); w.y = pk2(bflo(uu.y) * (acc[4 * r4 + 2] + bst), bfhi(uu.y) * (acc[4 * r4 + 3] + bst));
                    *(u32x2*)(CAT + (size_t)(R0 + t) * 1024 + c) = w; } }
          } }
        __syncthreads();
    }
}
__device__ __forceinline__ void cconv_unit(unsigned char* lds, int R0, int nsub, bool samp, int sb, const bf16_t* __restrict__ ZO, const float* __restrict__ dw, const float* __restrict__ dwb, const float* __restrict__ cng,
                                           const float* __restrict__ cnb, const float* __restrict__ st_cc, bf16_t* CAT) {
    const int tid = opaque_tid(), lane = tid & 63, wid = __builtin_amdgcn_readfirstlane(tid >> 6), c = tid;
    float* cd = (float*)lds;
    float w[31];
#pragma unroll
    for (int j = 0; j < 31; ++j) w[j] = dw[j * 512 + c];
    const float bias = dwb[c];
    for (int sub = 0; sub < nsub; ++sub) { const int Rs = R0 + 16 * sub;
        float x[46];
        if (samp) {
#pragma unroll
            for (int i = 0; i < 46; ++i) x[i] = (i < 30) ? st_cc[(size_t)(sb * 30 + i) * 512 + c] : bf2f(ZO[(size_t)(Rs + i - 30) * 1536 + 1024 + c]);
        } else { const int ts = (Rs & 2047) - 30;
#pragma unroll
            for (int i = 0; i < 46; ++i) x[i] = (ts + i >= 0) ? bf2f(ZO[(size_t)(Rs - 30 + i) * 1536 + 1024 + c]) : 0.f; }
#pragma unroll
        for (int i = 0; i < 16; ++i) { float a = bias;
#pragma unroll
            for (int j = 0; j < 31; ++j) a += w[j] * x[i + j];
            cd[i * 512 + c] = a; }
        __syncthreads();
#pragma unroll
        for (int rr = 0; rr < 2; ++rr) { const int i = 2 * wid + rr; const f32x4 a = *(const f32x4*)(cd + i * 512 + 4 * lane), b2 = *(const f32x4*)(cd + i * 512 + 256 + 4 * lane);
            const float mean = wave_sum((a[0] + a[1]) + (a[2] + a[3]) + (b2[0] + b2[1]) + (b2[2] + b2[3])) * (1.0f / 512.0f);
            const f32x4 da = a - mean, db = b2 - mean;
            const float rstd = __builtin_amdgcn_rsqf(wave_sum((da[0] * da[0] + da[1] * da[1]) + (da[2] * da[2] + da[3] * da[3]) + (db[0] * db[0] + db[1] * db[1]) + (db[2] * db[2] + db[3] * db[3])) * (1.0f / 512.0f) + RMS_EPS);
            const f32x4 g0 = *(const f32x4*)(cng + 4 * lane), g1 = *(const f32x4*)(cng + 256 + 4 * lane), c0 = *(const f32x4*)(cnb + 4 * lane), c1 = *(const f32x4*)(cnb + 256 + 4 * lane);
            f32x4 y0 = da * rstd * g0 + c0, y1 = db * rstd * g1 + c1;
#pragma unroll
            for (int e = 0; e < 4; ++e) { y0[e] = pg8::siluf_(y0[e]); y1[e] = pg8::siluf_(y1[e]); }
            bf16_t* op = CAT + (size_t)(Rs + i) * 1024 + 512 + 4 * lane;
            u32x2 w0; w0.x = pk2(y0[0], y0[1]); w0.y = pk2(y0[2], y0[3]); *(u32x2*)op = w0;
            u32x2 w1; w1.x = pk2(y1[0], y1[1]); w1.y = pk2(y1[2], y1[3]); *(u32x2*)(op + 256) = w1; }
        __syncthreads();
    }
}

__global__ void __launch_bounds__(NTHR, 2) mega_fwd(Params P) {
    extern __shared__ __attribute__((aligned(16))) unsigned char lds[];
    cg::grid_group grid = cg::this_grid();
    const int G = gridDim.x, bid = blockIdx.x;
    unsigned char* const ws = P.ws; float* const out = P.out;
#define SSQ ((float*)(ws + WS_SSQ))
#define WSB ((bf16_t*)(ws + WS_WSB))
#define XB ((bf16_t*)(ws + WS_XB))
#define CAT ((bf16_t*)(ws + WS_CAT))
#define BIG ((bf16_t*)(ws + WS_BIG))
#define EIN ((bf16_t*)(ws + WS_EIN))
#define EOUT ((bf16_t*)(ws + WS_EOUT))
#define OIN ((bf16_t*)(ws + WS_OIN))
#define OOUT ((bf16_t*)(ws + WS_OOUT))
#define ldsa ((PG8_LAS unsigned char*)lds)
#define x_prompt P.in[0]
#define x_sample P.in[1]
#define cache_k P.in[2]
#define cache_v P.in[3]
#define cache_lf P.in[4]
#define st_sconv P.in[5]
#define st_cconv P.in[6]
#define ffn1_g P.in[7]
#define ffn1_wg P.in[8]
#define ffn1_wu P.in[9]
#define ffn1_wd P.in[10]
#define mix_g P.in[11]
#define ffn2_g P.in[12]
#define ffn2_wg P.in[13]
#define ffn2_wu P.in[14]
#define ffn2_wd P.in[15]
#define e_w_in P.in[16]
#define e_b_f P.in[17]
#define e_conv_w P.in[18]
#define e_w_out P.in[19]
#define o_w_in P.in[20]
#define o_ln_g P.in[21]
#define o_ln_b P.in[22]
#define o_ws P.in[23]
#define o_bs P.in[24]
#define o_dw P.in[25]
#define o_dw_b P.in[26]
#define o_cn_g P.in[27]
#define o_cn_b P.in[28]
#define o_w_out P.in[29]
#define final_g P.in[30]

    {
        const int tid = opaque_tid(), lane = tid & 63, wid = __builtin_amdgcn_readfirstlane(tid >> 6);
        const int gw = bid * NWAVES + wid, NGW = G * NWAVES, gt = bid * NTHR + tid, NGT = G * NTHR;
        float* scr = (float*)(lds + wid * 16384);
        int base = 0;
#define TR_JOB(SRC, GAIN, KK, NSRC, NBLK, DST, MODE) do { const int n_ = ((KK) / 64) * (NBLK); int first_ = (gw - base) % NGW; if (first_ < 0) first_ += NGW; \
        for (int it_ = first_; it_ < n_; it_ += NGW) tr_item((SRC), (GAIN), (KK), (NSRC), (NBLK), (DST), (MODE), scr, it_, lane); base += n_; } while (0)
        for (int f = 0; f < 4; ++f) { const int l = f >> 1, second = f & 1;
            const float* wg = (second ? ffn2_wg : ffn1_wg) + (size_t)l * DM * DFF; const float* wu = (second ? ffn2_wu : ffn1_wu) + (size_t)l * DM * DFF; const float* wd = (second ? ffn2_wd : ffn1_wd) + (size_t)l * DFF * DM;
            const float* gn = (second ? ffn2_g : ffn1_g) + l * DM;
            bf16_t* w1 = (bf16_t*)(ws + WS_W1 + f * W1_BYTES); bf16_t* w2 = (bf16_t*)(ws + WS_W2 + f * W2_BYTES);
            TR_JOB(wg, gn, DM, DFF, DFF / 32, w1, 1); TR_JOB(wu, gn, DM, DFF, DFF / 32, w1, 2); TR_JOB(wd, (const float*)nullptr, DFF, DM, DM / 32, w2, 0); }
        TR_JOB(e_w_in, mix_g, DM, 3080, 3328 / 32, EIN, 0);
        TR_JOB(e_w_out, (const float*)nullptr, DM, DM, DM / 32, EOUT, 0);
        TR_JOB(o_w_in, mix_g + DM, DM, 2048, 2048 / 32, OIN, 3);
        TR_JOB(o_w_out, (const float*)nullptr, DM, DM, DM / 32, OOUT, 0);
#undef TR_JOB
        for (int r = gw; r < MT; r += NGW) {
            u32x2* xb = (u32x2*)(XB + (size_t)r * DM) + lane;
            if (r < MROWS) { const f32x4* src = (const f32x4*)((r < MP) ? x_prompt + (size_t)r * DM : x_sample + (size_t)(r - MP) * DM) + lane; f32x4* dst = (f32x4*)(out + (size_t)r * DM) + lane; float ss = 0.f;
#pragma unroll
                for (int j = 0; j < 4; ++j) { const f32x4 v = src[64 * j]; dst[64 * j] = v; u32x2 w; w.x = pk2(v[0], v[1]); w.y = pk2(v[2], v[3]); xb[64 * j] = w; ss += (v[0] * v[0] + v[1] * v[1]) + (v[2] * v[2] + v[3] * v[3]); }
                ss = wave_sum(ss); if (lane == 0) SSQ[r] = ss;
            } else {
#pragma unroll
                for (int j = 0; j < 4; ++j) xb[64 * j] = (u32x2){0u, 0u};
                if (lane == 0) SSQ[r] = 1024.f; }
        }
        for (int i = gt; i < 6 * MT; i += NGT) SSQ[MT + i] = 0.f;
        for (int i = gt; i < 8 * 128 * 128; i += NGT) { const int s = i & 127, t = (i >> 7) & 127; WSB[i] = (bf16_t)(pk2((s <= t) ? o_ws[i] : 0.f, 0.f) & 0xffff); }
    }
    grid.sync();

    for (int layer = 0; layer < 2; ++layer) {
        for (int f = 0; f < 2; ++f) {
            const int wi = layer * 2 + f, si = layer * 3 + (f ? 2 : 0);
            { pg8::Gemm g{XB, (const bf16_t*)(ws + WS_W1 + wi * W1_BYTES), MT, 2 * DFF, DM}; pg8::StaticOrder S; S.init(MT, 2 * DFF, G, bid);
              pg8::EpiSwiglu E{SSQ + si * MT, BIG};
              pg8::gemm_phase<pg8::EpiSwiglu, pg8::StaticOrder, true, true>(ldsa, g, S, E); }
            grid.sync();
            { pg8::Gemm g{BIG, (const bf16_t*)(ws + WS_W2 + wi * W2_BYTES), MT, DM, DFF}; pg8::StaticOrder S; S.init(MT, DM, G, bid);
              pg8::EpiResid E{out, XB, SSQ + (si + 1) * MT, 0.5f};
              pg8::gemm_phase<pg8::EpiResid, pg8::StaticOrder, true, true>(ldsa, g, S, E); }
            grid.sync();
            if (f == 1) break;
            if (layer == 0) {
                { pg8::Gemm g{XB, EIN, MT, 3328, DM}; pg8::StaticOrder S; S.init(MT, 3328, G, bid);
                  pg8::EpiEvenIn E{SSQ + 1 * MT, BIG, out + O_PK, out + O_PV, out + O_PLF, out + O_SK, out + O_SV, out + O_SLF, e_b_f};
                  pg8::gemm_phase<pg8::EpiEvenIn, pg8::StaticOrder, true, true>(ldsa, g, S, E); }
                grid.sync();
                #ifndef NO_CONVA
                for (int it = bid; it < 258; it += G) conva_item(it, BIG, e_conv_w, st_sconv, CAT, out);
#endif
#ifndef NO_PATTN
                for (int u = bid; u < 256; u += G) { const int bh = u >> 2, s = u & 3;
                    attn_prompt_unit(lds, bh >> 3, bh & 7, s, BIG, out + O_PLF, CAT);
                    attn_prompt_unit(lds, bh >> 3, bh & 7, 7 - s, BIG, out + O_PLF, CAT); }
#endif
#ifndef NO_SATTN
                for (int u = bid; u < 64; u += G) attn_sample_unit(lds, u >> 3, u & 7, BIG, cache_k, cache_v, cache_lf, out + O_SK, out + O_SV, out + O_SLF, CAT);
#endif
                grid.sync();
                { pg8::Gemm g{CAT, EOUT, MT, DM, DM}; pg8::StaticOrder S; S.init(MT, DM, G, bid);
                  pg8::EpiResid E{out, XB, SSQ + 2 * MT, 1.0f};
                  pg8::gemm_phase<pg8::EpiResid, pg8::StaticOrder, true, true>(ldsa, g, S, E); }
                grid.sync();
            } else {
                { pg8::Gemm g{XB, OIN, MT, 2048, DM}; pg8::StaticOrder S; S.init(MT, 2048, G, bid);
                  pg8::EpiOddIn E{SSQ + 4 * MT, BIG};
                  pg8::gemm_phase<pg8::EpiOddIn, pg8::StaticOrder, true, true>(ldsa, g, S, E); }
                grid.sync();
#ifndef NO_CCONV
                for (int u = bid; u < 256; u += G) cconv_unit(lds, 64 * u, 4, false, 0, BIG, o_dw, o_dw_b, o_cn_g, o_cn_b, st_cconv, CAT);
                for (int u = bid; u < 8; u += G) cconv_unit(lds, MP + 16 * u, 1, true, u, BIG, o_dw, o_dw_b, o_cn_g, o_cn_b, st_cconv, CAT);
#endif
#ifndef NO_GMLP
                for (int u = bid; u < 256; u += G) gmlp_unit(lds, 128 * (u >> 1), u & 1, false, 0, BIG, WSB, o_ln_g, o_ln_b, o_bs, CAT, out);
                for (int u = bid - 8; u < 16; u += G) if (u >= 0) gmlp_unit(lds, MP + 16 * (u >> 1), u & 1, true, u >> 1, BIG, WSB, o_ln_g, o_ln_b, o_bs, CAT, out);
#endif
                for (int i = bid * NTHR + opaque_tid(); i < 8 * 30 * 512; i += G * NTHR) { const int c = i & 511, j = (i >> 9) % 30, b = i / (30 * 512);
                    out[O_PCC + i] = bf2f(BIG[(size_t)(b * 2048 + 2018 + j) * 1536 + 1024 + c]);
                    out[O_SCC + i] = (j < 14) ? st_cconv[(size_t)(b * 30 + 16 + j) * 512 + c] : bf2f(BIG[(size_t)(MP + 16 * b + j - 14) * 1536 + 1024 + c]); }
                grid.sync();
                { pg8::Gemm g{CAT, OOUT, MT, DM, DM}; pg8::StaticOrder S; S.init(MT, DM, G, bid);
                  pg8::EpiResid E{out, XB, SSQ + 5 * MT, 1.0f};
                  pg8::gemm_phase<pg8::EpiResid, pg8::StaticOrder, true, true>(ldsa, g, S, E); }
                grid.sync();
            }
        }
    }
    const int ftid = opaque_tid(), lane = ftid & 63;
    for (int r = bid * NWAVES + (ftid >> 6); r < MROWS; r += G * NWAVES) { const float rs = __builtin_amdgcn_rsqf(SSQ[6 * MT + r] * (1.0f / 1024.0f) + RMS_EPS); f32x4* xp = (f32x4*)(out + (size_t)r * DM) + lane; const f32x4* gp = (const f32x4*)final_g + lane;
#pragma unroll
        for (int j = 0; j < 4; ++j) xp[64 * j] = xp[64 * j] * rs * gp[64 * j]; }
}

extern "C" void kernel_launch(void* const* d_in, const int* in_sizes, int n_in, void* d_out, int out_size, void* d_ws, size_t ws_size, hipStream_t stream) {
    static int grid = 0;
    if (grid == 0) {
        if (n_in != 31 || (size_t)out_size != O_END || ws_size < WS_END) { fprintf(stderr, "kernel_launch: unexpected sizes n_in %d out %d ws %zu\n", n_in, out_size, ws_size); grid = -1; return; }
        int dev = 0, cus = 0, per_cu = 0;
        hipGetDevice(&dev); hipDeviceGetAttribute(&cus, hipDeviceAttributeMultiprocessorCount, dev);
        if (hipFuncSetAttribute((const void*)mega_fwd, hipFuncAttributeMaxDynamicSharedMemorySize, LDS_BYTES) != hipSuccess) { fprintf(stderr, "hipFuncSetAttribute failed\n"); grid = -1; return; }
        hipOccupancyMaxActiveBlocksPerMultiprocessor(&per_cu, (const void*)mega_fwd, NTHR, LDS_BYTES);
        if (per_cu < 1) { fprintf(stderr, "occupancy query says %d blocks/CU\n", per_cu); per_cu = 1; }
        (void)hipGetLastError();
        grid = cus;
    }
    if (grid < 0) return;
    Params p{};
    for (int i = 0; i < 31; ++i) p.in[i] = (const float*)d_in[i];
    p.out = (float*)d_out; p.ws = (unsigned char*)d_ws;
    void* args[] = {&p};
    hipError_t e = hipLaunchCooperativeKernel((const void*)mega_fwd, dim3(grid), dim3(NTHR), args, LDS_BYTES, stream);
    if (e != hipSuccess) fprintf(stderr, "cooperative launch failed: %s (grid %d)\n", hipGetErrorString(e), grid);
}
```

```cpp
#include <hip/hip_runtime.h>
#include <hip/hip_cooperative_groups.h>
#include <cstdio>
#include <cstdint>
namespace cg = cooperative_groups;
__device__ __forceinline__ int opaque_tid() { int t = threadIdx.x; asm volatile("" : "+v"(t)); return t; }
__device__ __forceinline__ float sum_xor32(float v) { const auto rr = __builtin_amdgcn_permlane32_swap(__float_as_uint(v), __float_as_uint(v), false, false); return __uint_as_float(rr[0]) + __uint_as_float(rr[1]); }
__device__ __forceinline__ float max_xor32(float v) { const auto rr = __builtin_amdgcn_permlane32_swap(__float_as_uint(v), __float_as_uint(v), false, false); return fmaxf(__uint_as_float(rr[0]), __uint_as_float(rr[1])); }
__device__ __forceinline__ float sum_xor16(float v) { const auto rr = __builtin_amdgcn_permlane16_swap(__float_as_uint(v), __float_as_uint(v), false, false); return __uint_as_float(rr[0]) + __uint_as_float(rr[1]); }
namespace pg8 {
#define PG8_LAS __attribute__((address_space(3)))
typedef unsigned short bf16_t;
typedef short bf16x8 __attribute__((ext_vector_type(8)));
typedef float f32x4 __attribute__((ext_vector_type(4)));
typedef unsigned u32x4 __attribute__((ext_vector_type(4)));
constexpr int BM = 256, BK = 64, HALF = 128, HTB = HALF * BK * 2  , STAGE_BYTES = 8 * HTB, NXCD = 8, WGM = 8;

__host__ __device__ __forceinline__ int lds_byte(int r, int c) { const int st = (r >> 4) * 2 + (c >> 5), rr = r & 15, cc = c & 31, ob = rr * 64 + cc * 2; return st * 1024 + (ob ^ (((ob >> 9) & 1) << 5)); }
__host__ __device__ __forceinline__ void stage_rc(int b, int& R, int& C) { const int st = b / 1024, sb = b % 1024, swz = sb ^ (((sb >> 9) & 1) << 5); R = (st >> 1) * 16 + swz / 64; C = (st & 1) * 32 + (swz % 64) / 2; }
__host__ __device__ __forceinline__ int perm32(int rho) { const int n = rho >> 4, i = rho & 15; return 8 * (i >> 2) + 4 * n + (i & 3); }

struct Unit { int pm, pn; int koff = 0; };
struct Gemm { const bf16_t* A; const bf16_t* Bt; int M, N, K; int KL; };

struct StaticOrder {
    int nM, nN, nwg, G, c;
    __host__ __device__ void init(int M, int N, int G_, int c_) { nM = M / BM; nN = N / BM; nwg = nM * nN; G = G_; c = c_; }
    __host__ __device__ bool next(int i, Unit& u) const {
        const long L = (long)i * G + c; if (L >= nwg) return false;
        int wgid = (int)L; { const int q = nwg / NXCD, r = nwg % NXCD, xcd = wgid % NXCD, off = wgid / NXCD; wgid = (xcd < r ? xcd * (q + 1) : r * (q + 1) + (xcd - r) * q) + off; }
        const int nig = WGM * nN, gid = wgid / nig, fm = gid * WGM, gsz = (nM - fm) < WGM ? (nM - fm) : WGM;
        u.pm = fm + ((wgid % nig) % gsz); u.pn = (wgid % nig) / gsz; u.koff = 0; return true;
    }
    __device__ __forceinline__ void a_ready(const Unit&) const {}
    __device__ __forceinline__ void done(const Unit&) const {}
};

typedef float f32x2 __attribute__((ext_vector_type(2)));
typedef __bf16 bf16x2_t __attribute__((ext_vector_type(2)));
__device__ __forceinline__ unsigned pk2(float lo, float hi) { f32x2 v = {lo, hi}; bf16x2_t b = __builtin_convertvector(v, bf16x2_t); return __builtin_bit_cast(unsigned, b); }
__device__ __forceinline__ u32x4 pk8(f32x4 a, f32x4 b) { u32x4 w; w.x = pk2(a[0], a[1]); w.y = pk2(a[2], a[3]); w.z = pk2(b[0], b[1]); w.w = pk2(b[2], b[3]); return w; }
__device__ __forceinline__ float fast_exp(float x) { return __builtin_amdgcn_exp2f(x * 1.4426950408889634f); }
__device__ __forceinline__ float sigmoidf_(float x) { return __builtin_amdgcn_rcpf(1.0f + fast_exp(-x)); }
__device__ __forceinline__ float siluf_(float x) { return x * sigmoidf_(x); }
__device__ __forceinline__ float gelu_tanh(float x) { const float u = 1.5957691216057308f * (x + 0.044715f * x * x * x); return x * sigmoidf_(u); }
constexpr int MROWS = 16512;
constexpr float RMS_EPS = 1e-6f;

struct EpiSwiglu {
    static constexpr bool PERM = true, AFTER_DRAIN = false;
    const float* ssq; bf16_t* O;
    __device__ __forceinline__ void operator()(const f32x4 (&acc)[2][2][4][2], const Unit& u, int wr, int wc, int fr, int fq) const {
        const int row0 = u.pm * BM + wr * 64 + fr, col0 = u.pn * 128 + wc * 32 + 8 * fq;
        float rsv[8];
#pragma unroll
        for (int i = 0; i < 8; ++i) rsv[i] = ssq[row0 + (i >> 2) * HALF + (i & 3) * 16];
#pragma unroll
        for (int i = 0; i < 8; ++i) rsv[i] = __builtin_amdgcn_rsqf(rsv[i] * (1.0f / 1024.0f) + RMS_EPS);
#pragma unroll
        for (int ai = 0; ai < 2; ++ai)
#pragma unroll
            for (int m = 0; m < 4; ++m) { const int row = row0 + ai * HALF + m * 16; const float rs = rsv[ai * 4 + m];
                f32x4 o0, o1;
#pragma unroll
                for (int e = 0; e < 4; ++e) { o0[e] = siluf_(acc[ai][0][m][0][e] * rs) * (acc[ai][1][m][0][e] * rs); o1[e] = siluf_(acc[ai][0][m][1][e] * rs) * (acc[ai][1][m][1][e] * rs); }
                *(u32x4*)(O + (size_t)row * 2816 + col0) = pk8(o0, o1); }
    }
};
struct EpiResid {
    static constexpr bool PERM = true, AFTER_DRAIN = false;
    const float* Xin; float* X; bf16_t* XB; float* ssq_out; float scale;
    __device__ __forceinline__ void operator()(const f32x4 (&acc)[2][2][4][2], const Unit& u, int wr, int wc, int fr, int fq) const {
        const int row0 = u.pm * BM + wr * 64 + fr, col0 = u.pn * BM + wc * 32 + 8 * fq;
#pragma unroll
        for (int ai = 0; ai < 2; ++ai) {
            f32x4 xv[4][2][2];
#pragma unroll
            for (int m = 0; m < 4; ++m) { const int row = row0 + ai * HALF + m * 16; const bool valid = row < MROWS;
#pragma unroll
                for (int bj = 0; bj < 2; ++bj) { const float* xi = Xin + (size_t)row * 1024 + col0 + bj * HALF;
                    xv[m][bj][0] = valid ? *(const f32x4*)xi : (f32x4){0.f, 0.f, 0.f, 0.f}; xv[m][bj][1] = valid ? *(const f32x4*)(xi + 4) : (f32x4){0.f, 0.f, 0.f, 0.f}; } }
            asm volatile("" ::: "memory");
#pragma unroll
            for (int m = 0; m < 4; ++m) { const int row = row0 + ai * HALF + m * 16; const bool valid = row < MROWS; float ss = 0.f;
#pragma unroll
                for (int bj = 0; bj < 2; ++bj) { float* xp = X + (size_t)row * 1024 + col0 + bj * HALF;
                    const f32x4 x0 = xv[m][bj][0] + acc[ai][bj][m][0] * scale, x1 = xv[m][bj][1] + acc[ai][bj][m][1] * scale;
                    if (valid) { *(f32x4*)xp = x0; *(f32x4*)(xp + 4) = x1; }
                    *(u32x4*)(XB + (size_t)row * 1024 + col0 + bj * HALF) = pk8(x0, x1);
                    ss += (x0[0] * x0[0] + x0[1] * x0[1]) + (x0[2] * x0[2] + x0[3] * x0[3]) + (x1[0] * x1[0] + x1[1] * x1[1]) + (x1[2] * x1[2] + x1[3] * x1[3]); }
                ss = sum_xor16(ss); ss = sum_xor32(ss);
                if (fq == 0) unsafeAtomicAdd(ssq_out + row, ss); }
            asm volatile("" ::: "memory");
        }
    }
};
constexpr float QSCALE = 0.125f * 1.4426950408889634f;
struct EpiEvenIn {
    static constexpr bool PERM = true, AFTER_DRAIN = false;
    const float* ssq; bf16_t* ZB; float* pk_; float* pv_; float* plf; float* sk_; float* sv_; float* slf; const float* b_f;
    __device__ __forceinline__ void operator()(const f32x4 (&acc)[2][2][4][2], const Unit& u, int wr, int wc, int fr, int fq) const {
        const int row0 = u.pm * BM + wr * 64 + fr, pn = u.pn, lc = wc * 32 + 8 * fq;
        float rsv[8];
#pragma unroll
        for (int i = 0; i < 8; ++i) rsv[i] = ssq[row0 + (i >> 2) * HALF + (i & 3) * 16];
#pragma unroll
        for (int i = 0; i < 8; ++i) rsv[i] = __builtin_amdgcn_rsqf(rsv[i] * (1.0f / 1024.0f) + RMS_EPS);
#pragma unroll
        for (int ai = 0; ai < 2; ++ai)
#pragma unroll
            for (int m = 0; m < 4; ++m) { const int row = row0 + ai * HALF + m * 16; const float rs = rsv[ai * 4 + m];
                if (pn < 12) {
                    const float sc = (pn == 6 || pn == 7) ? rs * QSCALE : rs;
#pragma unroll
                    for (int bj = 0; bj < 2; ++bj) { const int col = pn * BM + bj * HALF + lc; const f32x4 v0 = acc[ai][bj][m][0] * sc, v1 = acc[ai][bj][m][1] * sc;
                        *(u32x4*)(ZB + (size_t)row * 3072 + col) = pk8(v0, v1);
                        if (pn >= 8 && row < MROWS) { const int cc = (pn >= 10) ? col - 2560 : col - 2048;
                            float* dst = (row < 16384) ? ((pn >= 10 ? pv_ : pk_) + (size_t)row * 512 + cc) : ((pn >= 10 ? sv_ : sk_) + (size_t)(row - 16384) * 512 + cc);
                            *(f32x4*)dst = v0; *(f32x4*)(dst + 4) = v1; } }
                } else if (wc == 0 && fq == 0 && row < MROWS) {
                    float* dst = (row < 16384) ? plf + (size_t)row * 8 : slf + (size_t)(row - 16384) * 8; f32x4 o0, o1;
#pragma unroll
                    for (int e = 0; e < 4; ++e) { const float a = acc[ai][0][m][0][e] * rs + b_f[e], b = acc[ai][0][m][1][e] * rs + b_f[4 + e];
                        o0[e] = fminf(a, 0.f) - log1pf(__expf(-fabsf(a))); o1[e] = fminf(b, 0.f) - log1pf(__expf(-fabsf(b))); }
                    *(f32x4*)dst = o0; *(f32x4*)(dst + 4) = o1; }
            }
    }
};
struct EpiOddIn {
    static constexpr bool PERM = true, AFTER_DRAIN = false;
    const float* ssq; bf16_t* ZO;
    __device__ __forceinline__ void operator()(const f32x4 (&acc)[2][2][4][2], const Unit& u, int wr, int wc, int fr, int fq) const {
        const int row0 = u.pm * BM + wr * 64 + fr, pn = u.pn, lc = wc * 32 + 8 * fq;
        float rsv[8];
#pragma unroll
        for (int i = 0; i < 8; ++i) rsv[i] = ssq[row0 + (i >> 2) * HALF + (i & 3) * 16];
#pragma unroll
        for (int i = 0; i < 8; ++i) rsv[i] = __builtin_amdgcn_rsqf(rsv[i] * (1.0f / 1024.0f) + RMS_EPS);
#pragma unroll
        for (int ai = 0; ai < 2; ++ai)
#pragma unroll
            for (int m = 0; m < 4; ++m) { const int row = row0 + ai * HALF + m * 16; const float rs = rsv[ai * 4 + m];
                if (pn < 4) {
#pragma unroll
                    for (int bj = 0; bj < 2; ++bj) { f32x4 v0, v1;
#pragma unroll
                        for (int e = 0; e < 4; ++e) { v0[e] = gelu_tanh(acc[ai][bj][m][0][e] * rs); v1[e] = gelu_tanh(acc[ai][bj][m][1][e] * rs); }
                        *(u32x4*)(ZO + (size_t)row * 1536 + pn * BM + bj * HALF + lc) = pk8(v0, v1); }
                } else { f32x4 v0, v1;
#pragma unroll
                    for (int e = 0; e < 4; ++e) { v0[e] = acc[ai][0][m][0][e] * rs * sigmoidf_(acc[ai][1][m][0][e] * rs); v1[e] = acc[ai][0][m][1][e] * rs * sigmoidf_(acc[ai][1][m][1][e] * rs); }
                    *(u32x4*)(ZO + (size_t)row * 1536 + 1024 + (pn - 4) * HALF + lc) = pk8(v0, v1); }
            }
    }
};

struct ChunkOrder {
    int c, nchunk;
    __device__ __forceinline__ bool next(int i, Unit& u) const { if (i > 0 || c >= nchunk) return false; u.pm = 64; u.pn = c & 3; u.koff = (c >> 2) * 512; return true; }
    __device__ __forceinline__ void a_ready(const Unit&) const {}
    __device__ __forceinline__ void done(const Unit&) const {}
};
struct EpiAtomX {
    static constexpr bool PERM = true, AFTER_DRAIN = false;
    float* X; float scale;
    __device__ __forceinline__ void operator()(const f32x4 (&acc)[2][2][4][2], const Unit& u, int wr, int wc, int fr, int fq) const {
        const int row0 = u.pm * BM + wr * 64 + fr, col0 = u.pn * BM + wc * 32 + 8 * fq;
#pragma unroll
        for (int m = 0; m < 4; ++m) { const int row = row0 + m * 16;
#pragma unroll
            for (int bj = 0; bj < 2; ++bj) { float* xp = X + (size_t)row * 1024 + col0 + bj * HALF;
#pragma unroll
                for (int e = 0; e < 4; ++e) { unsafeAtomicAdd(xp + e, acc[0][bj][m][0][e] * scale); unsafeAtomicAdd(xp + 4 + e, acc[0][bj][m][1][e] * scale); } } }
    }
};
template <class Epi, class Sched, bool ALIGN_EPI = false, bool SP2 = false>
__device__ __forceinline__ void gemm_phase(PG8_LAS unsigned char* lds, const Gemm g, const Sched& S, const Epi& E) {
    const int tid = opaque_tid(), wid = __builtin_amdgcn_readfirstlane(tid >> 6), lane = tid & 63, wr = wid >> 2, wc = wid & 3, fr = lane & 15, fq = lane >> 4;
    const int K = g.K, nt = g.KL / BK;
    unsigned voffA[2], voffB[2];
#pragma unroll
    for (int i = 0; i < 2; ++i) { int R, C; stage_rc(tid * 16 + i * 8192, R, C); const int Rb = Epi::PERM ? ((R & ~31) + perm32(R & 31)) : R;
        voffA[i] = (unsigned)(R * K + C) * 2u; voffB[i] = (unsigned)(Rb * K + C) * 2u; }
    const size_t kstep = (size_t)(BK * 2);
    const size_t hstep = (size_t)HALF * K * 2;
    const size_t tstep = 2 * hstep;
    const unsigned ldsw = (unsigned)wid * 1024u;
    const int aoff = lds_byte(wr * 64 + fr, fq * 8), boff = lds_byte(wc * 32 + fr, fq * 8);
#define PG8_SA(b, h) (((b) * 2 + (h)) * HTB)
#define PG8_SB(b, h) ((4 + (b) * 2 + (h)) * HTB)
#define PG8_STAGE(bufoff, gbase, voff) do { _Pragma("unroll") for (int _i = 0; _i < 2; ++_i) \
        __builtin_amdgcn_global_load_lds((const unsigned*)((const char*)(gbase) + (voff)[_i]), (PG8_LAS unsigned*)(lds + (bufoff) + ldsw + _i * 8192), 16, 0, 0); } while (0)
#define PG8_LDA(dst, b, h) do { _Pragma("unroll") for (int m = 0; m < 4; ++m) _Pragma("unroll") for (int k = 0; k < 2; ++k) dst[m][k] = *(const PG8_LAS bf16x8*)(lds + PG8_SA(b, h) + aoff + m * 2048 + k * 1024); } while (0)
#define PG8_LDB(dst, b, h) do { _Pragma("unroll") for (int n = 0; n < 2; ++n) _Pragma("unroll") for (int k = 0; k < 2; ++k) dst[n][k] = *(const PG8_LAS bf16x8*)(lds + PG8_SB(b, h) + boff + n * 2048 + k * 1024); } while (0)
#define PG8_MMA(ai, bj, At, Bt) do { __builtin_amdgcn_s_setprio(1); _Pragma("unroll") for (int m = 0; m < 4; ++m) _Pragma("unroll") for (int n = 0; n < 2; ++n) _Pragma("unroll") for (int k = 0; k < 2; ++k) \
        acc[ai][bj][m][n] = __builtin_amdgcn_mfma_f32_16x16x32_bf16(Bt[n][k], At[m][k], acc[ai][bj][m][n], 0, 0, 0); __builtin_amdgcn_s_setprio(0); } while (0)
#define PG8_WAIT_V(n) asm volatile("s_waitcnt vmcnt(" #n ")" ::: "memory")
#define PG8_WAIT_L(n) asm volatile("s_waitcnt lgkmcnt(" #n ")" ::: "memory")
#define PG8_BAR __builtin_amdgcn_s_barrier()
#define PG8_SCHED __builtin_amdgcn_sched_barrier(0)
    Unit cur, nxt; int ui = 0;
    if (!S.next(0, cur)) return;
    f32x4 acc[2][2][4][2];
#pragma unroll
    for (int a = 0; a < 2; ++a)
#pragma unroll
        for (int b = 0; b < 2; ++b)
#pragma unroll
            for (int m = 0; m < 4; ++m)
#pragma unroll
                for (int n = 0; n < 2; ++n) acc[a][b][m][n] = (f32x4){0.f, 0.f, 0.f, 0.f};
    bf16x8 At[4][2], B0[2][2], B1[2][2];
    const char* cA = (const char*)g.A + (size_t)cur.pm * tstep + cur.koff; const char* cB = (const char*)g.Bt + (size_t)cur.pn * tstep + cur.koff;
    S.a_ready(cur);
    if constexpr (SP2) {
        PG8_STAGE(PG8_SB(0, 0), cB, voffB); PG8_STAGE(PG8_SB(0, 1), cB + hstep, voffB); PG8_STAGE(PG8_SA(0, 0), cA, voffA); PG8_STAGE(PG8_SA(0, 1), cA + hstep, voffA);
        if (wr == 1) PG8_BAR;
        PG8_WAIT_V(2); PG8_BAR;
        PG8_STAGE(PG8_SB(1, 0), cB + kstep, voffB); PG8_STAGE(PG8_SA(1, 0), cA + kstep, voffA); PG8_STAGE(PG8_SB(1, 1), cB + hstep + kstep, voffB);
        PG8_WAIT_V(6); PG8_BAR;
    } else {
        PG8_STAGE(PG8_SB(0, 0), cB, voffB); PG8_STAGE(PG8_SA(0, 0), cA, voffA); PG8_STAGE(PG8_SB(0, 1), cB + hstep, voffB); PG8_STAGE(PG8_SA(0, 1), cA + hstep, voffA);
        if (wr == 1) PG8_BAR;
        PG8_WAIT_V(4); PG8_BAR;
        PG8_STAGE(PG8_SB(1, 0), cB + kstep, voffB); PG8_STAGE(PG8_SA(1, 0), cA + kstep, voffA); PG8_STAGE(PG8_SB(1, 1), cB + hstep + kstep, voffB);
        PG8_WAIT_V(6); PG8_BAR;
    }
    for (;;) {
        const bool has_next = S.next(ui + 1, nxt);
        const char* nA = has_next ? (const char*)g.A + (size_t)nxt.pm * tstep + nxt.koff : cA; const char* nB = has_next ? (const char*)g.Bt + (size_t)nxt.pn * tstep + nxt.koff : cB;
        for (int t = 0; t < nt; t += 2) {
            const bool last = (t == nt - 2);
            const char* a1 = cA + (size_t)(t + 1) * kstep;
            const char* a2 = last ? nA : cA + (size_t)(t + 2) * kstep; const char* b2 = last ? nB : cB + (size_t)(t + 2) * kstep;
            const char* a3 = a2 + kstep; const char* b3 = b2 + kstep;
            if (last && has_next) S.a_ready(nxt);
            if constexpr (SP2) {
            PG8_LDB(B0, 0, 0); PG8_LDB(B1, 0, 1); PG8_SCHED; PG8_LDA(At, 0, 0); PG8_STAGE(PG8_SA(1, 1), a1 + hstep, voffA);
            PG8_WAIT_V(8); PG8_WAIT_L(0); PG8_BAR; PG8_MMA(0, 0, At, B0); PG8_MMA(0, 1, At, B1); PG8_BAR; PG8_SCHED;
            PG8_LDA(At, 0, 1); PG8_STAGE(PG8_SB(0, 0), b2, voffB); PG8_STAGE(PG8_SB(0, 1), b2 + hstep, voffB); PG8_STAGE(PG8_SA(0, 0), a2, voffA);
            PG8_WAIT_V(8); PG8_WAIT_L(0); PG8_BAR; PG8_MMA(1, 0, At, B0); PG8_MMA(1, 1, At, B1); PG8_BAR; PG8_SCHED;
            PG8_LDB(B0, 1, 0); PG8_LDB(B1, 1, 1); PG8_SCHED; PG8_LDA(At, 1, 0); PG8_STAGE(PG8_SA(0, 1), a2 + hstep, voffA);
            PG8_WAIT_V(8); PG8_WAIT_L(0); PG8_BAR; PG8_MMA(0, 0, At, B0); PG8_MMA(0, 1, At, B1); PG8_BAR; PG8_SCHED;
            PG8_LDA(At, 1, 1); PG8_STAGE(PG8_SB(1, 0), b3, voffB); PG8_STAGE(PG8_SB(1, 1), b3 + hstep, voffB); PG8_STAGE(PG8_SA(1, 0), a3, voffA);
            PG8_WAIT_V(8); PG8_WAIT_L(0); PG8_BAR; PG8_MMA(1, 0, At, B0); PG8_MMA(1, 1, At, B1); PG8_BAR; PG8_SCHED;
            } else {
            PG8_LDB(B0, 0, 0); PG8_SCHED; PG8_LDA(At, 0, 0); PG8_STAGE(PG8_SA(1, 1), a1 + hstep, voffA);
            PG8_WAIT_L(8); PG8_BAR; PG8_WAIT_L(0); PG8_MMA(0, 0, At, B0); PG8_BAR; PG8_SCHED;
            PG8_LDB(B1, 0, 1); PG8_STAGE(PG8_SB(0, 0), b2, voffB);
            PG8_BAR; PG8_WAIT_L(0); PG8_MMA(0, 1, At, B1); PG8_BAR;
            PG8_LDA(At, 0, 1); PG8_STAGE(PG8_SA(0, 0), a2, voffA);
            PG8_BAR; PG8_WAIT_L(0); PG8_MMA(1, 0, At, B0); PG8_BAR; PG8_SCHED;
            PG8_STAGE(PG8_SB(0, 1), b2 + hstep, voffB);
            PG8_WAIT_V(6); PG8_BAR; PG8_MMA(1, 1, At, B1); PG8_BAR;
            PG8_LDB(B0, 1, 0); PG8_SCHED; PG8_LDA(At, 1, 0); PG8_STAGE(PG8_SA(0, 1), a2 + hstep, voffA);
            PG8_WAIT_L(8); PG8_BAR; PG8_WAIT_L(0); PG8_MMA(0, 0, At, B0); PG8_BAR; PG8_SCHED;
            PG8_LDB(B1, 1, 1); PG8_STAGE(PG8_SB(1, 0), b3, voffB);
            PG8_BAR; PG8_WAIT_L(0); PG8_MMA(0, 1, At, B1); PG8_BAR;
            PG8_LDA(At, 1, 1); PG8_STAGE(PG8_SA(1, 0), a3, voffA);
            PG8_BAR; PG8_WAIT_L(0); PG8_MMA(1, 0, At, B0); PG8_BAR; PG8_SCHED;
            PG8_STAGE(PG8_SB(1, 1), b3 + hstep, voffB);
            PG8_WAIT_V(6); PG8_BAR; PG8_MMA(1, 1, At, B1); PG8_BAR;
            }
        }
        if constexpr (ALIGN_EPI) { if (wr == 0) PG8_BAR; }
        if constexpr (!Epi::AFTER_DRAIN) { E(acc, cur, wr, wc, fr, fq); S.done(cur); }
        if (!has_next) break;
#pragma unroll
        for (int a = 0; a < 2; ++a)
#pragma unroll
            for (int b = 0; b < 2; ++b)
#pragma unroll
                for (int m = 0; m < 4; ++m)
#pragma unroll
                    for (int n = 0; n < 2; ++n) acc[a][b][m][n] = (f32x4){0.f, 0.f, 0.f, 0.f};
        cur = nxt; cA = nA; cB = nB; ++ui;
        if constexpr (ALIGN_EPI) { if (wr == 1) PG8_BAR; }
    }
    PG8_WAIT_V(0);
    if constexpr (!ALIGN_EPI) { if (wr == 0) PG8_BAR; }
    PG8_BAR;
    if constexpr (Epi::AFTER_DRAIN) { E.fused(acc, cur, wr, wc, fr, fq, lds, wid, lane); S.done(cur); }
#undef PG8_SA
#undef PG8_SB
#undef PG8_STAGE
#undef PG8_LDA
#undef PG8_LDB
#undef PG8_MMA
#undef PG8_WAIT_V
#undef PG8_WAIT_L
#undef PG8_BAR
#undef PG8_SCHED
}
}
typedef unsigned short bf16_t;
typedef short bf16x8 __attribute__((ext_vector_type(8)));
typedef float f32x4 __attribute__((ext_vector_type(4)));
typedef float f32x16 __attribute__((ext_vector_type(16)));
typedef unsigned u32x4 __attribute__((ext_vector_type(4)));
typedef unsigned u32x2 __attribute__((ext_vector_type(2)));
using pg8::pk2; using pg8::pk8; using pg8::MROWS; using pg8::RMS_EPS;
constexpr int NTHR = 512, NWAVES = 8;
constexpr int MP = 16384, MT = 16640, DM = 1024, DFF = 2816;
constexpr size_t MiB = 1u << 20;
constexpr size_t WS_SSQ = 1 * MiB, WS_WSB = 2 * MiB, WS_W1 = 3 * MiB, WS_W2 = 47 * MiB, WS_EIN = 69 * MiB, WS_EOUT = 76 * MiB, WS_OIN = 78 * MiB, WS_OOUT = 82 * MiB,
                 WS_XB = 84 * MiB, WS_CAT = 117 * MiB, WS_BIG = 150 * MiB, WS_END = 248 * MiB;
constexpr size_t W1_BYTES = 11 * MiB, W2_BYTES = 5767168;
constexpr int LDS_BYTES = 147456;
constexpr size_t O_YP = 0, O_YS = 16777216, O_PK = O_YS + 131072, O_PV = O_PK + 8388608, O_PLF = O_PV + 8388608, O_PSC = O_PLF + 131072, O_PCC = O_PSC + 8192,
                 O_SK = O_PCC + 122880, O_SV = O_SK + 65536, O_SLF = O_SV + 65536, O_SSC = O_SLF + 1024, O_SCC = O_SSC + 8192, O_SGV = O_SCC + 122880, O_END = O_SGV + 65536;
constexpr float LOG2E = 1.4426950408889634f;

struct Params { const float* in[31]; float* out; unsigned char* ws; };

__device__ __forceinline__ float wave_sum(float v) {
    v += __builtin_bit_cast(float, __builtin_amdgcn_mov_dpp(__builtin_bit_cast(int, v), 0xB1, 0xF, 0xF, true));
    v += __builtin_bit_cast(float, __builtin_amdgcn_mov_dpp(__builtin_bit_cast(int, v), 0x4E, 0xF, 0xF, true));
    v += __builtin_bit_cast(float, __builtin_amdgcn_mov_dpp(__builtin_bit_cast(int, v), 0x141, 0xF, 0xF, true));
    v += __builtin_bit_cast(float, __builtin_amdgcn_mov_dpp(__builtin_bit_cast(int, v), 0x140, 0xF, 0xF, true));
    v = sum_xor16(v); v = sum_xor32(v);
    return v;
}
__device__ __forceinline__ float bf2f(unsigned short b) { return __uint_as_float((unsigned)b << 16); }
__device__ __forceinline__ float bflo(unsigned w) { return __uint_as_float(w << 16); }
__device__ __forceinline__ float bfhi(unsigned w) { return __uint_as_float(w & 0xffff0000u); }

__device__ __forceinline__ int map_row(int mode, int n0) {
    if (mode == 0) return n0;
    if (mode == 1) return (n0 >> 7) * 256 + (n0 & 127);
    if (mode == 2) return (n0 >> 7) * 256 + 128 + (n0 & 127);
    if (n0 < 1024) return n0;
    if (n0 < 1536) { const int j = n0 - 1024; return 1024 + (j >> 7) * 256 + (j & 127); }
    { const int j = n0 - 1536; return 1024 + (j >> 7) * 256 + 128 + (j & 127); }
}
__device__ __forceinline__ void tr_item(const float* __restrict__ W, const float* __restrict__ gain, int K, int Nsrc, int nblk, bf16_t* WT, int mode, float* scr, int item, int lane) {
    const int kb = item / nblk, nb = item - kb * nblk, k0 = 64 * kb, n0 = 64 * nb;
    const int kr = lane >> 4, n4 = (lane & 15) * 4; const bool nv = (n0 + n4) < Nsrc;
    f32x4 v[16];
#pragma unroll
    for (int i = 0; i < 16; ++i) v[i] = nv ? *(const f32x4*)(W + (size_t)(k0 + 4 * i + kr) * Nsrc + n0 + n4) : (f32x4){0.f, 0.f, 0.f, 0.f};
    if (gain) {
#pragma unroll
        for (int i = 0; i < 16; ++i) v[i] *= gain[k0 + 4 * i + kr]; }
#pragma unroll
    for (int i = 0; i < 16; ++i) { float* d = scr + (4 * i + kr) * 65 + n4; d[0] = v[i][0]; d[1] = v[i][1]; d[2] = v[i][2]; d[3] = v[i][3]; }
    asm volatile("s_waitcnt lgkmcnt(0)" ::: "memory");
    const int rb = map_row(mode, n0);
#pragma unroll
    for (int jj = 0; jj < 8; ++jj) { const int id = lane + 64 * jj, nn = id >> 3, c = id & 7; const float* s = scr + (8 * c) * 65 + nn;
        u32x4 o; o.x = pk2(s[0 * 65], s[1 * 65]); o.y = pk2(s[2 * 65], s[3 * 65]); o.z = pk2(s[4 * 65], s[5 * 65]); o.w = pk2(s[6 * 65], s[7 * 65]);
        *(u32x4*)(WT + (size_t)(rb + nn) * K + k0 + 8 * c) = o; }
    asm volatile("s_waitcnt lgkmcnt(0)" ::: "memory");
}

__device__ __forceinline__ int crow(int r, int hi) { return (r & 3) + 8 * (r >> 2) + 4 * hi; }
struct AttnState { float m, l; f32x16 o[2]; };
template <bool MASK> __device__ __forceinline__ void attn_tile(AttnState& st, const bf16x8 (&kf)[2][4], const bf16x8 (&vf)[2][4], const bf16x8 (&qr)[4], const float* clt, int hi, int kv_limit) {
    f32x16 p[2];
#pragma unroll
    for (int kvb = 0; kvb < 2; ++kvb) {
#pragma unroll
        for (int r4 = 0; r4 < 4; ++r4) { const f32x4 bv = *(const f32x4*)(clt + 32 * kvb + 8 * r4 + 4 * hi);
            p[kvb][4 * r4] = bv[0]; p[kvb][4 * r4 + 1] = bv[1]; p[kvb][4 * r4 + 2] = bv[2]; p[kvb][4 * r4 + 3] = bv[3]; }
#pragma unroll
        for (int d0 = 0; d0 < 4; ++d0) p[kvb] = __builtin_amdgcn_mfma_f32_32x32x16_bf16(kf[kvb][d0], qr[d0], p[kvb], 0, 0, 0); }
    float mx = -1e30f;
#pragma unroll
    for (int kvb = 0; kvb < 2; ++kvb)
#pragma unroll
        for (int r = 0; r < 16; ++r) { float s = p[kvb][r];
            if (MASK) { const int kvl = 32 * kvb + 8 * (r >> 2) + 4 * hi + (r & 3); s = (kvl > kv_limit) ? -1e30f : s; p[kvb][r] = s; }
            mx = fmaxf(mx, s); }
    mx = max_xor32(mx);
    const float mn = fmaxf(st.m, mx), alpha = __builtin_amdgcn_exp2f(st.m - mn); st.m = mn;
    float ls = 0.f;
#pragma unroll
    for (int kvb = 0; kvb < 2; ++kvb)
#pragma unroll
        for (int r = 0; r < 16; ++r) { const float e = __builtin_amdgcn_exp2f(p[kvb][r] - mn); p[kvb][r] = e; ls += e; }
    st.l = st.l * alpha + ls;
#pragma unroll
    for (int db = 0; db < 2; ++db)
#pragma unroll
        for (int r = 0; r < 16; ++r) st.o[db][r] *= alpha;
    bf16x8 pb[4];
#pragma unroll
    for (int s = 0; s < 4; ++s) { const int kvb = s >> 1, b0 = 8 * (s & 1);
        u32x4 w; w.x = pk2(p[kvb][b0 + 0], p[kvb][b0 + 1]); w.y = pk2(p[kvb][b0 + 2], p[kvb][b0 + 3]); w.z = pk2(p[kvb][b0 + 4], p[kvb][b0 + 5]); w.w = pk2(p[kvb][b0 + 6], p[kvb][b0 + 7]);
        pb[s] = __builtin_bit_cast(bf16x8, w); }
#pragma unroll
    for (int db = 0; db < 2; ++db)
#pragma unroll
        for (int s = 0; s < 4; ++s) st.o[db] = __builtin_amdgcn_mfma_f32_32x32x16_bf16(vf[db][s], pb[s], st.o[db], 0, 0, 0);
}
template <int NV, class F> __device__ __forceinline__ void block_cumsum(float* cl, float* tmp, F getv, int tid, int lane, int wid) {
    float v[NV];
#pragma unroll
    for (int e = 0; e < NV; ++e) v[e] = getv(NV * tid + e);
#pragma unroll
    for (int e = 1; e < NV; ++e) v[e] += v[e - 1];
    const float tot = v[NV - 1]; float sc = tot;
#pragma unroll
    for (int off = 1; off < 64; off <<= 1) { const float t = __shfl_up(sc, off); if (lane >= off) sc += t; }
    if (lane == 63) tmp[wid] = sc;
    __syncthreads();
    float base = 0.f;
#pragma unroll
    for (int w = 0; w < 8; ++w) base += (w < wid) ? tmp[w] : 0.f;
    const float excl = base + sc - tot;
#pragma unroll
    for (int e = 0; e < NV; ++e) cl[NV * tid + e] = -(excl + v[e]) * LOG2E;
}
constexpr int AL_KS = 0, AL_VT = 18432, AL_CL = 35840, AL_TMP = 35840 + 10240, AL_OW = 49152, AL_ML = 49152 + 65536, AL_SK = 49152;

__device__ __forceinline__ void attn_prompt_unit(unsigned char* lds, int b, int h, int qb, const bf16_t* __restrict__ ZB, const float* __restrict__ logf, bf16_t* CAT) {
    const int tid = opaque_tid(), lane = tid & 63, wid = __builtin_amdgcn_readfirstlane(tid >> 6), r32 = lane & 31, hi = lane >> 5;
    float* cl = (float*)(lds + AL_CL); float* tmp = (float*)(lds + AL_TMP);
    const int rowbase = b * 2048, q0 = qb * 256, NT = 4 * (qb + 1), nk = NT * 64;
    const bf16_t* Qp = ZB + (size_t)(rowbase + q0 + 32 * wid + r32) * 3072 + 1536 + h * 64;
    bf16x8 qr[4];
#pragma unroll
    for (int d0 = 0; d0 < 4; ++d0) qr[d0] = *(const bf16x8*)(Qp + 16 * d0 + 8 * hi);
    const int lkv = tid >> 3, lch = tid & 7;
    const bf16_t* Kg = ZB + (size_t)(rowbase + lkv) * 3072 + 2048 + h * 64 + 8 * lch;
    const bf16_t* Vg = ZB + (size_t)(rowbase + lane) * 3072 + 2560 + h * 64 + 8 * wid;
    u32x4 kreg = *(const u32x4*)Kg, vreg = *(const u32x4*)Vg;
    block_cumsum<4>(cl, tmp, [&](int k) { return (k < nk) ? logf[(size_t)(rowbase + k) * 8 + h] : 0.f; }, tid, lane, wid);
    auto stage = [&](int buf) {
        *(u32x4*)(lds + AL_KS + buf * 9216 + lkv * 144 + lch * 16) = kreg;
        unsigned short* vt = (unsigned short*)(lds + AL_VT + buf * 8704) + (8 * wid) * 68 + lane;
        vt[0 * 68] = (unsigned short)(vreg.x & 0xffff); vt[1 * 68] = (unsigned short)(vreg.x >> 16); vt[2 * 68] = (unsigned short)(vreg.y & 0xffff); vt[3 * 68] = (unsigned short)(vreg.y >> 16);
        vt[4 * 68] = (unsigned short)(vreg.z & 0xffff); vt[5 * 68] = (unsigned short)(vreg.z >> 16); vt[6 * 68] = (unsigned short)(vreg.w & 0xffff); vt[7 * 68] = (unsigned short)(vreg.w >> 16); };
    stage(0);
    __syncthreads();
    AttnState st; st.m = -1e30f; st.l = 0.f; st.o[0] = f32x16{}; st.o[1] = f32x16{};
    const int qg = q0 + 32 * wid + r32;
    for (int t = 0; t < NT; ++t) {
        if (t + 1 < NT) { kreg = *(const u32x4*)(Kg + (size_t)(t + 1) * 64 * 3072); vreg = *(const u32x4*)(Vg + (size_t)(t + 1) * 64 * 3072); }
        if (64 * t <= q0 + 32 * wid + 31) {
            const unsigned char* ks = lds + AL_KS + (t & 1) * 9216; const unsigned char* vt = lds + AL_VT + (t & 1) * 8704;
            bf16x8 kf[2][4], vf[2][4];
#pragma unroll
            for (int kvb = 0; kvb < 2; ++kvb)
#pragma unroll
                for (int d0 = 0; d0 < 4; ++d0) kf[kvb][d0] = *(const bf16x8*)(ks + (32 * kvb + r32) * 144 + (16 * d0 + 8 * hi) * 2);
#pragma unroll
            for (int db = 0; db < 2; ++db)
#pragma unroll
                for (int s = 0; s < 4; ++s) { const unsigned char* p = vt + (32 * db + r32) * 136 + (16 * s + 4 * hi) * 2; const u32x2 lo = *(const u32x2*)p, hv = *(const u32x2*)(p + 16);
                    vf[db][s] = __builtin_bit_cast(bf16x8, (u32x4){lo.x, lo.y, hv.x, hv.y}); }
            if (64 * t + 63 > q0 + 32 * wid) attn_tile<true>(st, kf, vf, qr, cl + 64 * t, hi, qg - 64 * t); else attn_tile<false>(st, kf, vf, qr, cl + 64 * t, hi, 64);
        }
        if (t + 1 < NT) stage((t + 1) & 1);
        __syncthreads();
    }
    const float lt = sum_xor32(st.l), inv = 1.0f / lt;
    bf16_t* Op = CAT + (size_t)(rowbase + qg) * 1024 + 512 + h * 64 + 4 * hi;
#pragma unroll
    for (int db = 0; db < 2; ++db)
#pragma unroll
        for (int r4 = 0; r4 < 4; ++r4) { u32x2 w; w.x = pk2(st.o[db][4 * r4] * inv, st.o[db][4 * r4 + 1] * inv); w.y = pk2(st.o[db][4 * r4 + 2] * inv, st.o[db][4 * r4 + 3] * inv);
            *(u32x2*)(Op + 32 * db + 8 * r4) = w; }
}

__device__ __forceinline__ void attn_sample_unit(unsigned char* lds, int b, int h, const bf16_t* __restrict__ ZB, const float* __restrict__ cK, const float* __restrict__ cV, const float* __restrict__ cLF,
                                                 const float* __restrict__ nK, const float* __restrict__ nV, const float* __restrict__ nLF, bf16_t* CAT) {
    const int tid = opaque_tid(), lane = tid & 63, wid = __builtin_amdgcn_readfirstlane(tid >> 6), r32 = lane & 31, hi = lane >> 5;
    float* cl = (float*)(lds + AL_CL); float* tmp = (float*)(lds + AL_TMP);
    block_cumsum<5>(cl, tmp, [&](int k) { return (k < 2048) ? cLF[(size_t)(b * 2048 + k) * 8 + h] : ((k < 2064) ? nLF[(size_t)(b * 16 + k - 2048) * 8 + h] : 0.f); }, tid, lane, wid);
    __syncthreads();
    const bf16_t* Qp = ZB + (size_t)(MP + 16 * b + r32) * 3072 + 1536 + h * 64;
    bf16x8 qr[4];
#pragma unroll
    for (int d0 = 0; d0 < 4; ++d0) qr[d0] = *(const bf16x8*)(Qp + 16 * d0 + 8 * hi);
    AttnState st; st.m = -1e30f; st.l = 0.f; st.o[0] = f32x16{}; st.o[1] = f32x16{};
    auto rowp = [&](const float* c, const float* n, int kv) -> const float* {
        return (kv < 2048) ? c + ((size_t)(b * 2048 + kv) * 8 + h) * 64 : n + ((size_t)(b * 16 + min(kv - 2048, 15)) * 8 + h) * 64; };
    for (int t = wid; t < 33; t += 8) {
        bf16x8 kf[2][4], vf[2][4];
        {
            unsigned char* kst = lds + AL_SK + wid * 9216; f32x4 kr[16], vr[16];
#pragma unroll
            for (int i = 0; i < 16; ++i) kr[i] = *(const f32x4*)(rowp(cK, nK, 64 * t + 4 * i + (lane >> 4)) + 4 * (lane & 15));
#pragma unroll
            for (int i = 0; i < 16; ++i) { u32x2 w; w.x = pk2(kr[i][0], kr[i][1]); w.y = pk2(kr[i][2], kr[i][3]); *(u32x2*)(kst + (4 * i + (lane >> 4)) * 144 + (lane & 15) * 8) = w; }
#pragma unroll
            for (int i = 0; i < 16; ++i) vr[i] = *(const f32x4*)(rowp(cV, nV, 64 * t + 4 * i + (lane >> 4)) + 4 * (lane & 15));
            asm volatile("s_waitcnt lgkmcnt(0)" ::: "memory");
#pragma unroll
            for (int kvb = 0; kvb < 2; ++kvb)
#pragma unroll
                for (int d0 = 0; d0 < 4; ++d0) kf[kvb][d0] = *(const bf16x8*)(kst + (32 * kvb + r32) * 144 + (16 * d0 + 8 * hi) * 2);
            asm volatile("s_waitcnt lgkmcnt(0)" ::: "memory");
#pragma unroll
            for (int i = 0; i < 16; ++i) { u32x2 w; w.x = pk2(vr[i][0], vr[i][1]); w.y = pk2(vr[i][2], vr[i][3]); *(u32x2*)(kst + (4 * i + (lane >> 4)) * 144 + (lane & 15) * 8) = w; }
            asm volatile("s_waitcnt lgkmcnt(0)" ::: "memory");
#pragma unroll
            for (int s = 0; s < 4; ++s)
#pragma unroll
                for (int db = 0; db < 2; ++db) { unsigned e[8];
#pragma unroll
                    for (int j = 0; j < 8; ++j) e[j] = *(const unsigned short*)(kst + (16 * s + 4 * hi + (j & 3) + 8 * (j >> 2)) * 144 + (32 * db + r32) * 2);
                    vf[db][s] = __builtin_bit_cast(bf16x8, (u32x4){e[0] | (e[1] << 16), e[2] | (e[3] << 16), e[4] | (e[5] << 16), e[6] | (e[7] << 16)}); }
            asm volatile("s_waitcnt lgkmcnt(0)" ::: "memory");
        }
        attn_tile<true>(st, kf, vf, qr, cl + 64 * t, hi, 2048 + r32 - 64 * t);
    }
    __syncthreads();
    const float lt = sum_xor32(st.l);
    float* ow = (float*)(lds + AL_OW) + wid * 2048; float* ml = (float*)(lds + AL_ML) + wid * 64;
    if (hi == 0) { ml[r32] = st.m; ml[32 + r32] = lt; }
#pragma unroll
    for (int db = 0; db < 2; ++db)
#pragma unroll
        for (int r = 0; r < 16; ++r) ow[(32 * db + crow(r, hi)) * 32 + r32] = st.o[db][r];
    __syncthreads();
#pragma unroll
    for (int e = 0; e < 2; ++e) { const int oi = tid + 512 * e, q = oi >> 6, d = oi & 63; const float* mlb = (const float*)(lds + AL_ML); const float* owb = (const float*)(lds + AL_OW);
        float M = -1e30f;
#pragma unroll
        for (int w = 0; w < 8; ++w) M = fmaxf(M, mlb[w * 64 + q]);
        float L = 0.f, O = 0.f;
#pragma unroll
        for (int w = 0; w < 8; ++w) { const float f = __builtin_amdgcn_exp2f(mlb[w * 64 + q] - M); L += mlb[w * 64 + 32 + q] * f; O += owb[w * 2048 + d * 32 + q] * f; }
        CAT[(size_t)(MP + 16 * b + q) * 1024 + 512 + h * 64 + d] = (bf16_t)(pk2(O / L, 0.f) & 0xffff); }
    __syncthreads();
}

__device__ __forceinline__ void conva_item(int item, const bf16_t* __restrict__ ZB, const float* __restrict__ cw, const float* __restrict__ st_sc, bf16_t* CAT, float* out) {
    const int tid = opaque_tid(), rb = tid >> 6, ch = (tid & 63) * 8, R0 = item * 64 + rb * 8;
    if (R0 >= MROWS) return;
    const bool samp = R0 >= MP; const bool start = samp ? (((R0 - MP) & 15) == 0) : ((R0 & 2047) == 0);
    u32x4 xa[10], gc[10], gbv[8];
#pragma unroll
    for (int i = 0; i < 10; ++i) { const int row = (start && i < 2) ? R0 : R0 - 2 + i; xa[i] = *(const u32x4*)(ZB + (size_t)row * 3072 + ch); gc[i] = *(const u32x4*)(ZB + (size_t)row * 3072 + 1024 + ch); }
#pragma unroll
    for (int i = 0; i < 8; ++i) gbv[i] = *(const u32x4*)(ZB + (size_t)(R0 + i) * 3072 + 512 + ch);
    float w0[8], w1[8], w2[8], p2[8], p1[8];
#pragma unroll
    for (int e = 0; e < 8; ++e) { w0[e] = cw[ch + e]; w1[e] = cw[512 + ch + e]; w2[e] = cw[1024 + ch + e]; }
    auto prod = [&](const u32x4 a, const u32x4 c, float* pr) {
        pr[0] = bflo(a.x) * bflo(c.x); pr[1] = bfhi(a.x) * bfhi(c.x); pr[2] = bflo(a.y) * bflo(c.y); pr[3] = bfhi(a.y) * bfhi(c.y);
        pr[4] = bflo(a.z) * bflo(c.z); pr[5] = bfhi(a.z) * bfhi(c.z); pr[6] = bflo(a.w) * bflo(c.w); pr[7] = bfhi(a.w) * bfhi(c.w); };
    if (start) {
        if (samp) { const int b = (R0 - MP) >> 4;
#pragma unroll
            for (int e = 0; e < 8; ++e) { p2[e] = st_sc[(size_t)(b * 2 + 0) * 512 + ch + e]; p1[e] = st_sc[(size_t)(b * 2 + 1) * 512 + ch + e]; } }
        else {
#pragma unroll
            for (int e = 0; e < 8; ++e) { p2[e] = 0.f; p1[e] = 0.f; } }
    } else { prod(xa[0], gc[0], p2); prod(xa[1], gc[1], p1); }
#pragma unroll
    for (int i = 0; i < 8; ++i) { const int row = R0 + i; float p0[8]; prod(xa[i + 2], gc[i + 2], p0);
        const u32x4 g = gbv[i];
        const float gf[8] = {bflo(g.x), bfhi(g.x), bflo(g.y), bfhi(g.y), bflo(g.z), bfhi(g.z), bflo(g.w), bfhi(g.w)};
        float y[8];
#pragma unroll
        for (int e = 0; e < 8; ++e) y[e] = gf[e] * (w0[e] * p2[e] + w1[e] * p1[e] + w2[e] * p0[e]);
        *(u32x4*)(CAT + (size_t)row * 1024 + ch) = pk8((f32x4){y[0], y[1], y[2], y[3]}, (f32x4){y[4], y[5], y[6], y[7]});
        int orow = -1; float* ob = nullptr;
        if (!samp) { const int tt = row & 2047; if (tt >= 2046) { orow = (row >> 11) * 2 + (tt - 2046); ob = out + O_PSC; } }
        else { const int ii = (row - MP) & 15; if (ii >= 14) { orow = ((row - MP) >> 4) * 2 + (ii - 14); ob = out + O_SSC; } }
        if (orow >= 0) { *(f32x4*)(ob + (size_t)orow * 512 + ch) = (f32x4){p0[0], p0[1], p0[2], p0[3]}; *(f32x4*)(ob + (size_t)orow * 512 + ch + 4) = (f32x4){p0[4], p0[5], p0[6], p0[7]}; }
#pragma unroll
        for (int e = 0; e < 8; ++e) { p2[e] = p1[e]; p1[e] = p0[e]; } }
}
constexpr int CL_STAT = 0, CL_VNT = 2048;
__device__ __forceinline__ void gmlp_unit(unsigned char* lds, int R0, int gh, bool samp, int sb, const bf16_t* __restrict__ ZO, const bf16_t* __restrict__ WSB, const float* __restrict__ lng, const float* __restrict__ lnb,
                                          const float* __restrict__ bs, bf16_t* CAT, float* out) {
    const int tid = opaque_tid(), lane = tid & 63, wid = __builtin_amdgcn_readfirstlane(tid >> 6), r32 = lane & 31, hi = lane >> 5;
    float* stat = (float*)(lds + CL_STAT);
    { u32x4 av[16];
#pragma unroll
      for (int i = 0; i < 16; ++i) av[i] = *(const u32x4*)(ZO + (size_t)(R0 + wid * 16 + i) * 1536 + 512 + 8 * lane);
#pragma unroll
      for (int i = 0; i < 16; ++i) { const int s = wid * 16 + i; const u32x4 a = av[i];
        const float v[8] = {bflo(a.x), bfhi(a.x), bflo(a.y), bfhi(a.y), bflo(a.z), bfhi(a.z), bflo(a.w), bfhi(a.w)};
        float sm = 0.f;
#pragma unroll
        for (int e = 0; e < 8; ++e) sm += v[e];
        const float mean = wave_sum(sm) * (1.0f / 512.0f); float q = 0.f;
#pragma unroll
        for (int e = 0; e < 8; ++e) q += (v[e] - mean) * (v[e] - mean);
        const float rstd = __builtin_amdgcn_rsqf(wave_sum(q) * (1.0f / 512.0f) + RMS_EPS);
        if (lane == 0) { stat[2 * s] = mean; stat[2 * s + 1] = rstd; }
        if (samp && gh == 0 && s < 16) { float* o = out + O_SGV + (size_t)(sb * 16 + s) * 512 + 8 * lane;
#pragma unroll
            for (int e = 0; e < 8; ++e) o[e] = (v[e] - mean) * rstd * lng[8 * lane + e] + lnb[8 * lane + e]; } } }
    __syncthreads();
    for (int gi = 0; gi < 4; ++gi) { const int g = gh * 4 + gi;
        { const int s = tid & 127, c0 = 16 * (tid >> 7); const float mean = stat[2 * s], rstd = stat[2 * s + 1];
            const bf16_t* src = ZO + (size_t)(R0 + s) * 1536 + 512 + g * 64 + c0; unsigned short* vt = (unsigned short*)(lds + CL_VNT) + c0 * 136 + s;
#pragma unroll
            for (int hh = 0; hh < 2; ++hh) { const u32x4 a = *(const u32x4*)(src + 8 * hh); const float v[8] = {bflo(a.x), bfhi(a.x), bflo(a.y), bfhi(a.y), bflo(a.z), bfhi(a.z), bflo(a.w), bfhi(a.w)};
#pragma unroll
                for (int e = 0; e < 8; ++e) { const int c = g * 64 + c0 + 8 * hh + e; const float y = (v[e] - mean) * rstd * lng[c] + lnb[c]; vt[(8 * hh + e) * 136] = (unsigned short)(pk2(y, 0.f) & 0xffff); } } }
        __syncthreads();
        { const int cb = wid & 1, tb = wid >> 1;
          if (!samp || tb == 0) {
            f32x16 acc = f32x16{};
            const unsigned char* ap = lds + CL_VNT + (32 * cb + r32) * 272 + 16 * hi; const bf16_t* bp = WSB + (size_t)(g * 128 + 32 * tb + r32) * 128 + 8 * hi;
            bf16x8 Bf[8];
#pragma unroll
            for (int ks = 0; ks < 8; ++ks) Bf[ks] = (ks < 2 * (tb + 1)) ? *(const bf16x8*)(bp + 16 * ks) : (bf16x8){0, 0, 0, 0, 0, 0, 0, 0};
#pragma unroll
            for (int ks = 0; ks < 8; ++ks) if (ks < 2 * (tb + 1)) { const bf16x8 A = *(const bf16x8*)(ap + 32 * ks); acc = __builtin_amdgcn_mfma_f32_32x32x16_bf16(A, Bf[ks], acc, 0, 0, 0); }
            const int t = 32 * tb + r32; const float bst = bs[g * 128 + t];
            if (!samp || t < 16) {
#pragma unroll
                for (int r4 = 0; r4 < 4; ++r4) { const int c = g * 64 + 32 * cb + 8 * r4 + 4 * hi; const u32x2 uu = *(const u32x2*)(ZO + (size_t)(R0 + t) * 1536 + c);
                    u32x2 w; w.x = pk2(bflo(uu.x) * (acc[4 * r4] + bst), bfhi(uu.x) * (acc[4 * r4 + 1] + bst)); w.y = pk2(bflo(uu.y) * (acc[4 * r4 + 2] + bst), bfhi(uu.y) * (acc[4 * r4 + 3] + bst));
                    *(u32x2*)(CAT + (size_t)(R0 + t) * 1024 + c) = w; } }
          } }
        __syncthreads();
    }
}
__device__ __forceinline__ void gmlp_sample_unit(unsigned char* lds, int sb, const bf16_t* __restrict__ ZO, const bf16_t* __restrict__ WSB, const float* __restrict__ lng, const float* __restrict__ lnb,
                                                 const float* __restrict__ bs, bf16_t* CAT, float* out) {
    const int tid = opaque_tid(), lane = tid & 63, wid = __builtin_amdgcn_readfirstlane(tid >> 6), r32 = lane & 31, hi = lane >> 5;
    const int R0 = MP + 16 * sb;
    float* stat = (float*)(lds + CL_STAT); unsigned char* vn8 = lds + CL_VNT;
    { u32x4 av[2];
#pragma unroll
      for (int i = 0; i < 2; ++i) av[i] = *(const u32x4*)(ZO + (size_t)(R0 + 2 * wid + i) * 1536 + 512 + 8 * lane);
#pragma unroll
      for (int i = 0; i < 2; ++i) { const int s = 2 * wid + i; const u32x4 a = av[i];
        const float v[8] = {bflo(a.x), bfhi(a.x), bflo(a.y), bfhi(a.y), bflo(a.z), bfhi(a.z), bflo(a.w), bfhi(a.w)};
        float sm = 0.f;
#pragma unroll
        for (int e = 0; e < 8; ++e) sm += v[e];
        const float mean = wave_sum(sm) * (1.0f / 512.0f); float q = 0.f;
#pragma unroll
        for (int e = 0; e < 8; ++e) q += (v[e] - mean) * (v[e] - mean);
        const float rstd = __builtin_amdgcn_rsqf(wave_sum(q) * (1.0f / 512.0f) + RMS_EPS);
        if (lane == 0) { stat[2 * s] = mean; stat[2 * s + 1] = rstd; }
        float* o = out + O_SGV + (size_t)(sb * 16 + s) * 512 + 8 * lane;
#pragma unroll
        for (int e = 0; e < 8; ++e) o[e] = (v[e] - mean) * rstd * lng[8 * lane + e] + lnb[8 * lane + e]; } }
    __syncthreads();
    { const int s = tid >> 5, ch0 = (tid & 31) * 16; const float mean = stat[2 * s], rstd = stat[2 * s + 1];
      const bf16_t* src = ZO + (size_t)(R0 + s) * 1536 + 512 + ch0; unsigned short* vt = (unsigned short*)vn8 + (size_t)((ch0 >> 6) * 64 + (ch0 & 63)) * 40 + s;
#pragma unroll
      for (int hh = 0; hh < 2; ++hh) { const u32x4 a = *(const u32x4*)(src + 8 * hh); const float v[8] = {bflo(a.x), bfhi(a.x), bflo(a.y), bfhi(a.y), bflo(a.z), bfhi(a.z), bflo(a.w), bfhi(a.w)};
#pragma unroll
          for (int e = 0; e < 8; ++e) { const int c = ch0 + 8 * hh + e; const float y = (v[e] - mean) * rstd * lng[c] + lnb[c]; vt[(8 * hh + e) * 40] = (unsigned short)(pk2(y, 0.f) & 0xffff); vt[(8 * hh + e) * 40 + 16] = 0; } } }
    __syncthreads();
#pragma unroll
    for (int k = 0; k < 2; ++k) { const int task = wid + 8 * k, g = task >> 1, cb = task & 1;
        const unsigned char* ap = vn8 + (size_t)(g * 64 + 32 * cb + r32) * 80 + 16 * hi; const bf16_t* bp = WSB + (size_t)(g * 128 + r32) * 128 + 8 * hi;
        f32x16 acc = f32x16{};
#pragma unroll
        for (int ks = 0; ks < 2; ++ks) { const bf16x8 A = *(const bf16x8*)(ap + 32 * ks), B = *(const bf16x8*)(bp + 16 * ks); acc = __builtin_amdgcn_mfma_f32_32x32x16_bf16(A, B, acc, 0, 0, 0); }
        const int t = r32;
        if (t < 16) { const float bst = bs[g * 128 + t];
#pragma unroll
            for (int r4 = 0; r4 < 4; ++r4) { const int c = g * 64 + 32 * cb + 8 * r4 + 4 * hi; const u32x2 uu = *(const u32x2*)(ZO + (size_t)(R0 + t) * 1536 + c);
                u32x2 w; w.x = pk2(bflo(uu.x) * (acc[4 * r4] + bst), bfhi(uu.x) * (acc[4 * r4 + 1] + bst)); w.y = pk2(bflo(uu.y) * (acc[4 * r4 + 2] + bst), bfhi(uu.y) * (acc[4 * r4 + 3] + bst));
                *(u32x2*)(CAT + (size_t)(R0 + t) * 1024 + c) = w; } } }
    __syncthreads();
}
template <bool SAMP> __device__ __forceinline__ void cconv_unit(unsigned char* lds, int R0, int sb, const bf16_t* __restrict__ ZO, const float* __restrict__ dw, const float* __restrict__ dwb, const float* __restrict__ cng,
                                           const float* __restrict__ cnb, const float* __restrict__ st_cc, bf16_t* CAT) {
    typedef float f32x2 __attribute__((ext_vector_type(2)));
    const int tid = opaque_tid(), lane = tid & 63, wid = __builtin_amdgcn_readfirstlane(tid >> 6), cp = tid & 255, c = 2 * cp, h = tid >> 8;
    float* cd = (float*)lds;
    f32x2 w[31];
#pragma unroll
    for (int j = 0; j < 31; ++j) w[j] = *(const f32x2*)(dw + j * 512 + c);
    const f32x2 bias = *(const f32x2*)(dwb + c);
    const f32x4 g0 = *(const f32x4*)(cng + 4 * lane), g1 = *(const f32x4*)(cng + 256 + 4 * lane), c0 = *(const f32x4*)(cnb + 4 * lane), c1 = *(const f32x4*)(cnb + 256 + 4 * lane);
    constexpr int NSTEP = SAMP ? 1 : 2;
#pragma unroll
    for (int step = 0; step < NSTEP; ++step) { const int Rs = R0 + 32 * h + 16 * step;
        if (!SAMP || h == 0) {
            f32x2 x[46];
            if (SAMP) {
#pragma unroll
                for (int i = 0; i < 46; ++i) { if (i < 30) x[i] = *(const f32x2*)(st_cc + (size_t)(sb * 30 + i) * 512 + c); else { const unsigned v = *(const unsigned*)(ZO + (size_t)(Rs + i - 30) * 1536 + 1024 + c); x[i] = (f32x2){bflo(v), bfhi(v)}; } }
            } else { const int ts = (Rs & 2047) - 30;
#pragma unroll
                for (int i = 0; i < 46; ++i) { const unsigned v = (ts + i >= 0) ? *(const unsigned*)(ZO + (size_t)(Rs - 30 + i) * 1536 + 1024 + c) : 0u; x[i] = (f32x2){bflo(v), bfhi(v)}; } }
#pragma unroll
            for (int i = 0; i < 16; ++i) { f32x2 a = bias;
#pragma unroll
                for (int j = 0; j < 31; ++j) a += w[j] * x[i + j];
                *(f32x2*)(cd + (16 * h + i) * 512 + c) = a; }
        }
        __syncthreads();
        constexpr int RPW = SAMP ? 2 : 4;
#pragma unroll
        for (int rr = 0; rr < RPW; ++rr) { const int i = RPW * wid + rr; const f32x4 a = *(const f32x4*)(cd + i * 512 + 4 * lane), b2 = *(const f32x4*)(cd + i * 512 + 256 + 4 * lane);
            const float mean = wave_sum((a[0] + a[1]) + (a[2] + a[3]) + (b2[0] + b2[1]) + (b2[2] + b2[3])) * (1.0f / 512.0f);
            const f32x4 da = a - mean, db = b2 - mean;
            const float rstd = __builtin_amdgcn_rsqf(wave_sum((da[0] * da[0] + da[1] * da[1]) + (da[2] * da[2] + da[3] * da[3]) + (db[0] * db[0] + db[1] * db[1]) + (db[2] * db[2] + db[3] * db[3])) * (1.0f / 512.0f) + RMS_EPS);
            f32x4 y0 = da * rstd * g0 + c0, y1 = db * rstd * g1 + c1;
#pragma unroll
            for (int e = 0; e < 4; ++e) { y0[e] = pg8::siluf_(y0[e]); y1[e] = pg8::siluf_(y1[e]); }
            const int orow = R0 + 32 * (i >> 4) + 16 * step + (i & 15);
            bf16_t* op = CAT + (size_t)orow * 1024 + 512 + 4 * lane;
            u32x2 w0; w0.x = pk2(y0[0], y0[1]); w0.y = pk2(y0[2], y0[3]); *(u32x2*)op = w0;
            u32x2 w1; w1.x = pk2(y1[0], y1[1]); w1.y = pk2(y1[2], y1[3]); *(u32x2*)(op + 256) = w1; }
        __syncthreads();
    }
}

#define GAS __attribute__((address_space(1)))
#define LAS __attribute__((address_space(3)))
typedef GAS unsigned gu32;
typedef GAS unsigned long long gu64;
#define RLX_AGENT __ATOMIC_RELAXED, __HIP_MEMORY_SCOPE_AGENT
#define LDS_WAIT() asm volatile("s_waitcnt lgkmcnt(0)" ::: "memory")
#define VM_WAIT() asm volatile("s_waitcnt vmcnt(0)" ::: "memory")
__device__ __forceinline__ unsigned long long rt() { return __builtin_amdgcn_s_memrealtime(); }
#define XB_TMO      128
#define XB_XCNT(j)  (256  + 64 * (j))
#define XB_XSUB(j)  (1280 + 64 * (j))
#define XB_XGEN(j)  (2304 + 64 * (j))
#define XB_TOP      3328
#define XB_TOPGEN   3392
#define XCD_BAR_WORDS 3456
#define XB_SPIN_CAP (1u << 18)

__device__ __forceinline__ unsigned xb_ld(unsigned* p)              { return __hip_atomic_load(p, __ATOMIC_RELAXED, __HIP_MEMORY_SCOPE_AGENT); }
__device__ __forceinline__ unsigned xb_add(unsigned* p, unsigned v) { return __hip_atomic_fetch_add(p, v, __ATOMIC_RELAXED, __HIP_MEMORY_SCOPE_AGENT); }
__device__ __forceinline__ unsigned xb_xcc_id() { return (unsigned)__builtin_amdgcn_s_getreg((3 << 11) | 20) & 0xFu; }
#define XB_SPIN(cond, bar) do { unsigned _sp = 0; while (cond) { __builtin_amdgcn_s_sleep(1); \
    if ((++_sp & 255u) == 0u) { if (xb_ld(&(bar)[XB_TMO])) break; if (_sp > XB_SPIN_CAP) { atomicAdd(&(bar)[XB_TMO], 1u); break; } } } } while (0)

struct XcdBarrier {
    unsigned* bar; unsigned x;
    volatile LAS unsigned* st;
};

__device__ __forceinline__ XcdBarrier xcd_barrier_post(unsigned* bar, volatile LAS unsigned* st) {
    XcdBarrier b; b.bar = bar; b.x = xb_xcc_id(); b.st = st;
    if (threadIdx.x == 0) (void)xb_add(&bar[XB_XCNT(b.x)], 1u);
    return b;
}
__device__ __forceinline__ void xcd_barrier_complete(unsigned* bar, unsigned x, unsigned& nloc, unsigned& nx) {
    const unsigned G = gridDim.x * gridDim.y * gridDim.z;
    unsigned sum, cnt, mine, sp = 0u;
    for (;;) {
        sum = 0u; cnt = 0u; mine = 0u;
#pragma unroll
        for (unsigned j = 0; j < 16; ++j) { const unsigned c = xb_ld(&bar[XB_XCNT(j)]); sum += c; cnt += (c > 0u) ? 1u : 0u; mine = (j == x) ? c : mine; }
        if (sum == G) break;
        __builtin_amdgcn_s_sleep(1);
        if ((++sp & 255u) == 0u) { if (xb_ld(&bar[XB_TMO])) break; if (sp > XB_SPIN_CAP) { atomicAdd(&bar[XB_TMO], 1u); break; } }
    }
    nloc = mine > 0u ? mine : 1u; nx = cnt > 0u ? cnt : 1u;
}

__device__ __forceinline__ void xcd_barrier(const XcdBarrier& b) {
    asm volatile("s_waitcnt vmcnt(0)" ::: "memory");
    __syncthreads();
    if (opaque_tid() == 0) {
        unsigned* bar = b.bar; asm volatile("" : "+s"(bar)); unsigned bx = b.x; asm volatile("" : "+s"(bx));
        __builtin_amdgcn_s_waitcnt(0);
        unsigned nloc = b.st[0], nx = b.st[1];
        if (nloc == 0u) { xcd_barrier_complete(bar, bx, nloc, nx); b.st[0] = nloc; b.st[1] = nx; }
        const unsigned old = xb_add(&bar[XB_XSUB(bx)], 1u);
        const unsigned gen = old / nloc;
        if (old + 1u == (gen + 1u) * nloc) {
            __builtin_amdgcn_fence(__ATOMIC_RELEASE, "agent");
            asm volatile("s_waitcnt vmcnt(0)" ::: "memory");
            const unsigned og = xb_add(&bar[XB_TOP], 1u);
            const unsigned tg = og / nx;
            if (og + 1u == (tg + 1u) * nx) xb_add(&bar[XB_TOPGEN], 1u);
            else XB_SPIN(xb_ld(&bar[XB_TOPGEN]) == tg, bar);
            __builtin_amdgcn_fence(__ATOMIC_ACQUIRE, "agent");
            xb_add(&bar[XB_XGEN(bx)], 1u);
            asm volatile("s_waitcnt vmcnt(0)" ::: "memory");
        } else {
            XB_SPIN(xb_ld(&bar[XB_XGEN(bx)]) == gen, bar);
            __builtin_amdgcn_fence(__ATOMIC_ACQUIRE, "agent");
            asm volatile("s_waitcnt vmcnt(0)" ::: "memory");
        }
    }
    __syncthreads();
}


__device__ __forceinline__ void refresh_sample(const pg8::StaticOrder& S, const float* X, bf16_t* XBp, float* ssq) {
    bool own = false; pg8::Unit u;
    for (int i = 0; S.next(i, u); ++i) own = own || (u.pm == 64);
    if (!own) return;
    const int tid = opaque_tid(), lane = tid & 63, wid = __builtin_amdgcn_readfirstlane(tid >> 6);
    for (int hb = 0; hb < 2; ++hb) { const int r0 = MP + wid * 16 + hb * 8; f32x4 v[8][4];
#pragma unroll
        for (int i = 0; i < 8; ++i)
#pragma unroll
            for (int j = 0; j < 4; ++j) v[i][j] = ((const f32x4*)(X + (size_t)(r0 + i) * DM) + lane)[64 * j];
#pragma unroll
        for (int i = 0; i < 8; ++i) { u32x2* xb = (u32x2*)(XBp + (size_t)(r0 + i) * DM) + lane; float ss = 0.f;
#pragma unroll
            for (int j = 0; j < 4; ++j) { u32x2 w; w.x = pk2(v[i][j][0], v[i][j][1]); w.y = pk2(v[i][j][2], v[i][j][3]); xb[64 * j] = w; ss += (v[i][j][0] * v[i][j][0] + v[i][j][1] * v[i][j][1]) + (v[i][j][2] * v[i][j][2] + v[i][j][3] * v[i][j][3]); }
            ss = wave_sum(ss); if (lane == 0) ssq[r0 + i] = ss; } }
    __builtin_amdgcn_fence(__ATOMIC_RELEASE, "agent"); asm volatile("s_waitcnt vmcnt(0)" ::: "memory");
    __syncthreads();
    __builtin_amdgcn_fence(__ATOMIC_ACQUIRE, "agent"); asm volatile("s_waitcnt vmcnt(0)" ::: "memory");
    __syncthreads();
}

template <int NS> __device__ __forceinline__ void skinny_resid_unit(unsigned char* lds, const bf16_t* __restrict__ A, const bf16_t* __restrict__ Bt, int u, const float* Xs_in, float* X, bf16_t* XBp, float* ssq, float scale) {
    constexpr int K = NS * 32 * 8;
    const int tid = opaque_tid(), lane = tid & 63, wid = __builtin_amdgcn_readfirstlane(tid >> 6), fr = lane & 15, fq = lane >> 4;
    const int rb = u & 7, cb = u >> 3, k0 = wid * (K / 8);
    const bf16_t* ap = A + (size_t)(16 * rb + fr) * K + k0 + 8 * fq; const bf16_t* bp0 = Bt + (size_t)(32 * cb + fr) * K + k0 + 8 * fq; const bf16_t* bp1 = bp0 + (size_t)16 * K;
    bf16x8 a[NS], p[NS], q[NS];
#pragma unroll
    for (int i = 0; i < NS; ++i) { a[i] = *(const bf16x8*)(ap + 32 * i); p[i] = *(const bf16x8*)(bp0 + 32 * i); q[i] = *(const bf16x8*)(bp1 + 32 * i); }
    f32x4 acc0 = {0.f, 0.f, 0.f, 0.f}, acc1 = {0.f, 0.f, 0.f, 0.f};
#pragma unroll
    for (int i = 0; i < NS; ++i) { acc0 = __builtin_amdgcn_mfma_f32_16x16x32_bf16(p[i], a[i], acc0, 0, 0, 0); acc1 = __builtin_amdgcn_mfma_f32_16x16x32_bf16(q[i], a[i], acc1, 0, 0, 0); }
    float* red = (float*)lds;
#pragma unroll
    for (int e = 0; e < 4; ++e) { red[(wid * 8 + e) * 64 + lane] = acc0[e]; red[(wid * 8 + 4 + e) * 64 + lane] = acc1[e]; }
    __syncthreads();
    { const int r = tid >> 5, c = tid & 31, src = (4 * (c >> 4) + (c & 3)) * 64 + r + 16 * ((c & 15) >> 2);
      float sum = 0.f;
#pragma unroll
      for (int w = 0; w < 8; ++w) sum += red[w * 512 + src];
      const int row = MP + 16 * rb + r, col = 32 * cb + c;
      const float x = Xs_in[(size_t)(16 * rb + r) * DM + col] + scale * sum;
      X[(size_t)row * DM + col] = x; XBp[(size_t)row * DM + col] = (bf16_t)(pk2(x, 0.f) & 0xffff);
      float ss = x * x;
      ss += __builtin_bit_cast(float, __builtin_amdgcn_mov_dpp(__builtin_bit_cast(int, ss), 0xB1, 0xF, 0xF, true));
      ss += __builtin_bit_cast(float, __builtin_amdgcn_mov_dpp(__builtin_bit_cast(int, ss), 0x4E, 0xF, 0xF, true));
      ss += __builtin_bit_cast(float, __builtin_amdgcn_mov_dpp(__builtin_bit_cast(int, ss), 0x141, 0xF, 0xF, true));
      ss += __builtin_bit_cast(float, __builtin_amdgcn_mov_dpp(__builtin_bit_cast(int, ss), 0x140, 0xF, 0xF, true));
      ss = sum_xor16(ss);
      if (c == 0) unsafeAtomicAdd(ssq + row, ss); }
    __syncthreads();
}
__global__ void __launch_bounds__(NTHR, 2) mega_fwd(Params P) {
    extern __shared__ __attribute__((aligned(16))) unsigned char lds[];
    cg::grid_group grid = cg::this_grid();
    if (gridDim.x == 0x7fffffffu) grid.sync();
    const int G = gridDim.x, bid = blockIdx.x;
    unsigned char* const ws = P.ws; float* const out = P.out;
    volatile LAS unsigned* bst = (volatile LAS unsigned*)((LAS unsigned char*)lds + LDS_BYTES - 64);
    if (threadIdx.x < 4) bst[threadIdx.x] = 0u;
    __syncthreads();
    const XcdBarrier xbar = xcd_barrier_post((unsigned*)ws, bst);
#define SSQ ((float*)(ws + WS_SSQ))
#define WSB ((bf16_t*)(ws + WS_WSB))
#define XB ((bf16_t*)(ws + WS_XB))
#define CAT ((bf16_t*)(ws + WS_CAT))
#define BIG ((bf16_t*)(ws + WS_BIG))
#define EIN ((bf16_t*)(ws + WS_EIN))
#define EOUT ((bf16_t*)(ws + WS_EOUT))
#define OIN ((bf16_t*)(ws + WS_OIN))
#define OOUT ((bf16_t*)(ws + WS_OOUT))
#define ldsa ((PG8_LAS unsigned char*)lds)
#define x_prompt P.in[0]
#define x_sample P.in[1]
#define cache_k P.in[2]
#define cache_v P.in[3]
#define cache_lf P.in[4]
#define st_sconv P.in[5]
#define st_cconv P.in[6]
#define ffn1_g P.in[7]
#define ffn1_wg P.in[8]
#define ffn1_wu P.in[9]
#define ffn1_wd P.in[10]
#define mix_g P.in[11]
#define ffn2_g P.in[12]
#define ffn2_wg P.in[13]
#define ffn2_wu P.in[14]
#define ffn2_wd P.in[15]
#define e_w_in P.in[16]
#define e_b_f P.in[17]
#define e_conv_w P.in[18]
#define e_w_out P.in[19]
#define o_w_in P.in[20]
#define o_ln_g P.in[21]
#define o_ln_b P.in[22]
#define o_ws P.in[23]
#define o_bs P.in[24]
#define o_dw P.in[25]
#define o_dw_b P.in[26]
#define o_cn_g P.in[27]
#define o_cn_b P.in[28]
#define o_w_out P.in[29]
#define final_g P.in[30]

    {
        const int tid = opaque_tid(), lane = tid & 63, wid = __builtin_amdgcn_readfirstlane(tid >> 6);
        const int gw = bid * NWAVES + wid, NGW = G * NWAVES, gt = bid * NTHR + tid, NGT = G * NTHR;
        float* scr = (float*)(lds + wid * 16640);
        int base = 0;
#define TR_JOB(SRC, GAIN, KK, NSRC, NBLK, DST, MODE) do { const int n_ = ((KK) / 64) * (NBLK); int first_ = (gw - base) % NGW; if (first_ < 0) first_ += NGW; \
        for (int it_ = first_; it_ < n_; it_ += NGW) tr_item((SRC), (GAIN), (KK), (NSRC), (NBLK), (DST), (MODE), scr, it_, lane); base += n_; } while (0)
#define FFN_JOBS(F_) do { const int f_ = (F_), l_ = f_ >> 1, second_ = f_ & 1; \
            const float* wg_ = (second_ ? ffn2_wg : ffn1_wg) + (size_t)l_ * DM * DFF; const float* wu_ = (second_ ? ffn2_wu : ffn1_wu) + (size_t)l_ * DM * DFF; const float* wd_ = (second_ ? ffn2_wd : ffn1_wd) + (size_t)l_ * DFF * DM; \
            const float* gn_ = (second_ ? ffn2_g : ffn1_g) + l_ * DM; \
            bf16_t* w1_ = (bf16_t*)(ws + WS_W1 + f_ * W1_BYTES); bf16_t* w2_ = (bf16_t*)(ws + WS_W2 + f_ * W2_BYTES); \
            TR_JOB(wg_, gn_, DM, DFF, DFF / 64, w1_, 1); TR_JOB(wu_, gn_, DM, DFF, DFF / 64, w1_, 2); TR_JOB(wd_, (const float*)nullptr, DFF, DM, DM / 64, w2_, 0); } while (0)
        FFN_JOBS(0);
        for (int r0 = gw * 4; r0 < MT; r0 += NGW * 4) {
            if (r0 < MROWS) { f32x4 v[4][4];
#pragma unroll
                for (int i = 0; i < 4; ++i) { const int r = r0 + i; const f32x4* src = (const f32x4*)((r < MP) ? x_prompt + (size_t)r * DM : x_sample + (size_t)(r - MP) * DM) + lane;
#pragma unroll
                    for (int j = 0; j < 4; ++j) v[i][j] = src[64 * j]; }
#pragma unroll
                for (int i = 0; i < 4; ++i) { u32x2* xb = (u32x2*)(XB + (size_t)(r0 + i) * DM) + lane; float ss = 0.f;
#pragma unroll
                    for (int j = 0; j < 4; ++j) { u32x2 w; w.x = pk2(v[i][j][0], v[i][j][1]); w.y = pk2(v[i][j][2], v[i][j][3]); xb[64 * j] = w; ss += (v[i][j][0] * v[i][j][0] + v[i][j][1] * v[i][j][1]) + (v[i][j][2] * v[i][j][2] + v[i][j][3] * v[i][j][3]); }
                    ss = wave_sum(ss); if (lane == 0) SSQ[r0 + i] = ss; }
            } else {
#pragma unroll
                for (int i = 0; i < 4; ++i) { u32x2* xb = (u32x2*)(XB + (size_t)(r0 + i) * DM) + lane;
#pragma unroll
                    for (int j = 0; j < 4; ++j) xb[64 * j] = (u32x2){0u, 0u};
                    if (lane == 0) SSQ[r0 + i] = 1024.f; } }
        }
        for (int i = gt; i < 6 * MT; i += NGT) SSQ[MT + i] = 0.f;
        for (int i = gt; i < 8 * 128 * 128; i += NGT) { const int s = i & 127, t = (i >> 7) & 127; WSB[i] = (bf16_t)(pk2((s <= t) ? o_ws[i] : 0.f, 0.f) & 0xffff); }
    }
    xcd_barrier(xbar);

    for (int layer = 0; layer < 2; ++layer) {
        for (int f = 0; f < 2; ++f) {
            const int wi = layer * 2 + f, si = layer * 3 + (f ? 2 : 0);
            { pg8::Gemm g{XB, (const bf16_t*)(ws + WS_W1 + wi * W1_BYTES), MT, 2 * DFF, DM, DM}; pg8::StaticOrder S; S.init(MT, 2 * DFF, G, bid);
              pg8::EpiSwiglu E{SSQ + si * MT, BIG};
              pg8::gemm_phase<pg8::EpiSwiglu, pg8::StaticOrder, true, true>(ldsa, g, S, E); }
            if (wi < 3) {
                const int nheavy = (1430 > 5 * G && 1430 <= 6 * G) ? 1430 - 5 * G : 0;
                if (bid >= nheavy) {
                    const int tid = opaque_tid(), lane = tid & 63, wid = __builtin_amdgcn_readfirstlane(tid >> 6);
                    const int gw = (bid - nheavy) * NWAVES + wid, NGW = (G - nheavy) * NWAVES; float* scr = (float*)(lds + wid * 16640); int base = 0;
                    if (wi == 0) { TR_JOB(e_w_in, mix_g, DM, 3080, 3328 / 64, EIN, 0); TR_JOB(e_w_out, (const float*)nullptr, DM, DM, DM / 64, EOUT, 0); FFN_JOBS(1); }
                    else if (wi == 1) { FFN_JOBS(2); }
                    else { TR_JOB(o_w_in, mix_g + DM, DM, 2048, 2048 / 64, OIN, 3); TR_JOB(o_w_out, (const float*)nullptr, DM, DM, DM / 64, OOUT, 0); FFN_JOBS(3); }
                }
            }
            xcd_barrier(xbar);
            { pg8::Gemm g{BIG, (const bf16_t*)(ws + WS_W2 + wi * W2_BYTES), MP, DM, DFF, DFF}; pg8::StaticOrder S; S.init(MP, DM, G, bid);
              pg8::EpiResid E{(wi == 0) ? x_prompt : (const float*)out, out, XB, SSQ + (si + 1) * MT, 0.5f};
              pg8::gemm_phase<pg8::EpiResid, pg8::StaticOrder, true, true>(ldsa, g, S, E); }
            for (int u = bid; u < 256; u += G) skinny_resid_unit<11>(lds, BIG + (size_t)MP * DFF, (const bf16_t*)(ws + WS_W2 + wi * W2_BYTES), u, (wi == 0) ? x_sample : (const float*)(out + O_YS), out, XB, SSQ + (si + 1) * MT, 0.5f);
            xcd_barrier(xbar);
            if (f == 1) break;
            if (layer == 0) {
                { pg8::Gemm g{XB, EIN, MT, 3328, DM, DM}; pg8::StaticOrder S; S.init(MT, 3328, G, bid);
                  pg8::EpiEvenIn E{SSQ + 1 * MT, BIG, out + O_PK, out + O_PV, out + O_PLF, out + O_SK, out + O_SV, out + O_SLF, e_b_f};
                  pg8::gemm_phase<pg8::EpiEvenIn, pg8::StaticOrder, true, true>(ldsa, g, S, E); }
                xcd_barrier(xbar);
                #ifndef NO_CONVA
                for (int it = bid; it < 258; it += G) conva_item(it, BIG, e_conv_w, st_sconv, CAT, out);
#endif
#ifndef NO_PATTN
                for (int u = bid; u < 256; u += G) { const int bh = u >> 2, role = u & 3, ab = bh >> 3, ah = bh & 7;
                    if (role == 0) attn_sample_unit(lds, ab, ah, BIG, cache_k, cache_v, cache_lf, out + O_SK, out + O_SV, out + O_SLF, CAT);
                    const int nq = (role == 3) ? 3 : (role == 0) ? 1 : 2, qlist = (role == 0) ? 0x5 : (role == 1) ? 0x17 : (role == 2) ? 0x26 : 0x034;
                    for (int i = 0; i < nq; ++i) attn_prompt_unit(lds, ab, ah, (qlist >> (4 * i)) & 15, BIG, out + O_PLF, CAT); }
#endif
                xcd_barrier(xbar);
                { pg8::Gemm g{CAT, EOUT, MP, DM, DM, DM}; pg8::StaticOrder S; S.init(MP, DM, G, bid);
                  pg8::EpiResid E{out, out, XB, SSQ + 2 * MT, 1.0f};
                  pg8::gemm_phase<pg8::EpiResid, pg8::StaticOrder, true, true>(ldsa, g, S, E); }
                for (int u = bid; u < 256; u += G) skinny_resid_unit<4>(lds, CAT + (size_t)MP * DM, EOUT, u, out + O_YS, out, XB, SSQ + 2 * MT, 1.0f);
                xcd_barrier(xbar);
            } else {
                { pg8::Gemm g{XB, OIN, MT, 2048, DM, DM}; pg8::StaticOrder S; S.init(MT, 2048, G, bid);
                  pg8::EpiOddIn E{SSQ + 4 * MT, BIG};
                  pg8::gemm_phase<pg8::EpiOddIn, pg8::StaticOrder, true, true>(ldsa, g, S, E); }
                xcd_barrier(xbar);
#ifndef NO_CCONV
                for (int u = bid; u < 256; u += G) cconv_unit<false>(lds, 64 * u, 0, BIG, o_dw, o_dw_b, o_cn_g, o_cn_b, st_cconv, CAT);
                for (int u = bid; u < 8; u += G) cconv_unit<true>(lds, MP + 16 * u, u, BIG, o_dw, o_dw_b, o_cn_g, o_cn_b, st_cconv, CAT);
#endif
#ifndef NO_GMLP
                for (int u = bid; u < 256; u += G) gmlp_unit(lds, 128 * (u >> 1), u & 1, false, 0, BIG, WSB, o_ln_g, o_ln_b, o_bs, CAT, out);
                for (int u = bid - 8; u < 8; u += G) if (u >= 0) gmlp_sample_unit(lds, u, BIG, WSB, o_ln_g, o_ln_b, o_bs, CAT, out);
#endif
                for (int i = bid * NTHR + opaque_tid(); i < 8 * 30 * 512; i += G * NTHR) { const int c = i & 511, j = (i >> 9) % 30, b = i / (30 * 512);
                    out[O_PCC + i] = bf2f(BIG[(size_t)(b * 2048 + 2018 + j) * 1536 + 1024 + c]);
                    out[O_SCC + i] = (j < 14) ? st_cconv[(size_t)(b * 30 + 16 + j) * 512 + c] : bf2f(BIG[(size_t)(MP + 16 * b + j - 14) * 1536 + 1024 + c]); }
                xcd_barrier(xbar);
                { pg8::Gemm g{CAT, OOUT, MP, DM, DM, DM}; pg8::StaticOrder S; S.init(MP, DM, G, bid);
                  pg8::EpiResid E{out, out, XB, SSQ + 5 * MT, 1.0f};
                  pg8::gemm_phase<pg8::EpiResid, pg8::StaticOrder, true, true>(ldsa, g, S, E); }
                for (int u = bid; u < 256; u += G) skinny_resid_unit<4>(lds, CAT + (size_t)MP * DM, OOUT, u, out + O_YS, out, XB, SSQ + 5 * MT, 1.0f);
                xcd_barrier(xbar);
            }
        }
    }
    const int ftid = opaque_tid(), lane = ftid & 63;
    { const int gwf = bid * NWAVES + (ftid >> 6), NGWF = G * NWAVES; const f32x4* gp = (const f32x4*)final_g + lane;
      f32x4 gv[4];
#pragma unroll
      for (int j = 0; j < 4; ++j) gv[j] = gp[64 * j];
      for (int r0 = gwf * 4; r0 < MROWS; r0 += NGWF * 4) {
        f32x4 v[4][4];
#pragma unroll
        for (int i = 0; i < 4; ++i)
#pragma unroll
            for (int j = 0; j < 4; ++j) v[i][j] = ((const f32x4*)(out + (size_t)(r0 + i) * DM) + lane)[64 * j];
#pragma unroll
        for (int i = 0; i < 4; ++i) { float ss = 0.f;
#pragma unroll
            for (int j = 0; j < 4; ++j) ss += (v[i][j][0] * v[i][j][0] + v[i][j][1] * v[i][j][1]) + (v[i][j][2] * v[i][j][2] + v[i][j][3] * v[i][j][3]);
            const float rs = __builtin_amdgcn_rsqf(wave_sum(ss) * (1.0f / 1024.0f) + RMS_EPS);
#pragma unroll
            for (int j = 0; j < 4; ++j) ((f32x4*)(out + (size_t)(r0 + i) * DM) + lane)[64 * j] = v[i][j] * rs * gv[j]; } } }
}

extern "C" void kernel_launch(void* const* d_in, const int* in_sizes, int n_in, void* d_out, int out_size, void* d_ws, size_t ws_size, hipStream_t stream) {
    static int grid = 0;
    if (grid == 0) {
        if (n_in != 31 || (size_t)out_size != O_END || ws_size < WS_END) { fprintf(stderr, "kernel_launch: unexpected sizes n_in %d out %d ws %zu\n", n_in, out_size, ws_size); grid = -1; return; }
        int dev = 0, cus = 0, per_cu = 0;
        hipGetDevice(&dev); hipDeviceGetAttribute(&cus, hipDeviceAttributeMultiprocessorCount, dev);
        if (hipFuncSetAttribute((const void*)mega_fwd, hipFuncAttributeMaxDynamicSharedMemorySize, LDS_BYTES) != hipSuccess) { fprintf(stderr, "hipFuncSetAttribute failed\n"); grid = -1; return; }
        hipOccupancyMaxActiveBlocksPerMultiprocessor(&per_cu, (const void*)mega_fwd, NTHR, LDS_BYTES);
        if (per_cu < 1) { fprintf(stderr, "occupancy query says %d blocks/CU\n", per_cu); per_cu = 1; }
        (void)hipGetLastError();
        grid = cus;
    }
    if (grid < 0) return;
    Params p{};
    for (int i = 0; i < 31; ++i) p.in[i] = (const float*)d_in[i];
    p.out = (float*)d_out; p.ws = (unsigned char*)d_ws;
    if (hipMemsetAsync(d_ws, 0, 16384, stream) != hipSuccess) { fprintf(stderr, "memset failed\n"); return; }
    void* args[] = {&p};
    hipError_t e = hipLaunchCooperativeKernel((const void*)mega_fwd, dim3(grid), dim3(NTHR), args, LDS_BYTES, stream);
    if (e != hipSuccess) fprintf(stderr, "cooperative launch failed: %s (grid %d)\n", hipGetErrorString(e), grid);
}
```

```cpp
#include <hip/hip_runtime.h>
#include <hip/hip_cooperative_groups.h>
#include <cstdio>
#include <cstdint>
namespace cg = cooperative_groups;
__device__ __forceinline__ int opaque_tid() { int t = threadIdx.x; asm volatile("" : "+v"(t)); return t; }
namespace pg8 {
#define PG8_LAS __attribute__((address_space(3)))
typedef unsigned short bf16_t;
typedef short bf16x8 __attribute__((ext_vector_type(8)));
typedef float f32x4 __attribute__((ext_vector_type(4)));
typedef unsigned u32x4 __attribute__((ext_vector_type(4)));
constexpr int BM = 256, BK = 64, HALF = 128, HTB = HALF * BK * 2  , STAGE_BYTES = 8 * HTB, NXCD = 8, WGM = 8;

__host__ __device__ __forceinline__ int lds_byte(int r, int c) { const int st = (r >> 4) * 2 + (c >> 5), rr = r & 15, cc = c & 31, ob = rr * 64 + cc * 2; return st * 1024 + (ob ^ (((ob >> 9) & 1) << 5)); }
__host__ __device__ __forceinline__ void stage_rc(int b, int& R, int& C) { const int st = b / 1024, sb = b % 1024, swz = sb ^ (((sb >> 9) & 1) << 5); R = (st >> 1) * 16 + swz / 64; C = (st & 1) * 32 + (swz % 64) / 2; }
__host__ __device__ __forceinline__ int perm32(int rho) { const int n = rho >> 4, i = rho & 15; return 8 * (i >> 2) + 4 * n + (i & 3); }

struct Unit { int pm, pn; int koff = 0; };
struct Gemm { const bf16_t* A; const bf16_t* Bt; int M, N, K; int KL; };

struct StaticOrder {
    int nM, nN, nwg, G, c;
    __host__ __device__ void init(int M, int N, int G_, int c_) { nM = M / BM; nN = N / BM; nwg = nM * nN; G = G_; c = c_; }
    __host__ __device__ bool next(int i, Unit& u) const {
        const long L = (long)i * G + c; if (L >= nwg) return false;
        int wgid = (int)L; { const int q = nwg / NXCD, r = nwg % NXCD, xcd = wgid % NXCD, off = wgid / NXCD; wgid = (xcd < r ? xcd * (q + 1) : r * (q + 1) + (xcd - r) * q) + off; }
        const int nig = WGM * nN, gid = wgid / nig, fm = gid * WGM, gsz = (nM - fm) < WGM ? (nM - fm) : WGM;
        u.pm = fm + ((wgid % nig) % gsz); u.pn = (wgid % nig) / gsz; u.koff = 0; return true;
    }
    __device__ __forceinline__ void a_ready(const Unit&) const {}
    __device__ __forceinline__ void done(const Unit&) const {}
};

typedef float f32x2 __attribute__((ext_vector_type(2)));
typedef __bf16 bf16x2_t __attribute__((ext_vector_type(2)));
__device__ __forceinline__ unsigned pk2(float lo, float hi) { f32x2 v = {lo, hi}; bf16x2_t b = __builtin_convertvector(v, bf16x2_t); return __builtin_bit_cast(unsigned, b); }
__device__ __forceinline__ u32x4 pk8(f32x4 a, f32x4 b) { u32x4 w; w.x = pk2(a[0], a[1]); w.y = pk2(a[2], a[3]); w.z = pk2(b[0], b[1]); w.w = pk2(b[2], b[3]); return w; }
__device__ __forceinline__ float fast_exp(float x) { return __builtin_amdgcn_exp2f(x * 1.4426950408889634f); }
__device__ __forceinline__ float sigmoidf_(float x) { return __builtin_amdgcn_rcpf(1.0f + fast_exp(-x)); }
__device__ __forceinline__ float siluf_(float x) { return x * sigmoidf_(x); }
__device__ __forceinline__ float gelu_tanh(float x) { const float u = 1.5957691216057308f * (x + 0.044715f * x * x * x); return x * sigmoidf_(u); }
constexpr int MROWS = 16512;
constexpr float RMS_EPS = 1e-6f;

struct EpiSwiglu {
    static constexpr bool PERM = true, AFTER_DRAIN = false;
    const float* ssq; bf16_t* O;
    __device__ __forceinline__ void operator()(const f32x4 (&acc)[2][2][4][2], const Unit& u, int wr, int wc, int fr, int fq) const {
        const int row0 = u.pm * BM + wr * 64 + fr, col0 = u.pn * 128 + wc * 32 + 8 * fq;
        float rsv[8];
#pragma unroll
        for (int i = 0; i < 8; ++i) rsv[i] = ssq[row0 + (i >> 2) * HALF + (i & 3) * 16];
#pragma unroll
        for (int i = 0; i < 8; ++i) rsv[i] = __builtin_amdgcn_rsqf(rsv[i] * (1.0f / 1024.0f) + RMS_EPS);
#pragma unroll
        for (int ai = 0; ai < 2; ++ai)
#pragma unroll
            for (int m = 0; m < 4; ++m) { const int row = row0 + ai * HALF + m * 16; const float rs = rsv[ai * 4 + m];
                f32x4 o0, o1;
#pragma unroll
                for (int e = 0; e < 4; ++e) { o0[e] = siluf_(acc[ai][0][m][0][e] * rs) * (acc[ai][1][m][0][e] * rs); o1[e] = siluf_(acc[ai][0][m][1][e] * rs) * (acc[ai][1][m][1][e] * rs); }
                *(u32x4*)(O + (size_t)row * 2816 + col0) = pk8(o0, o1); }
    }
};
struct EpiResid {
    static constexpr bool PERM = true, AFTER_DRAIN = false;
    const float* Xin; float* X; bf16_t* XB; float* ssq_out; float scale;
    __device__ __forceinline__ void operator()(const f32x4 (&acc)[2][2][4][2], const Unit& u, int wr, int wc, int fr, int fq) const {
        const int row0 = u.pm * BM + wr * 64 + fr, col0 = u.pn * BM + wc * 32 + 8 * fq;
#pragma unroll
        for (int ai = 0; ai < 2; ++ai) {
            f32x4 xv[4][2][2];
#pragma unroll
            for (int m = 0; m < 4; ++m) { const int row = row0 + ai * HALF + m * 16; const bool valid = row < MROWS;
#pragma unroll
                for (int bj = 0; bj < 2; ++bj) { const float* xi = Xin + (size_t)row * 1024 + col0 + bj * HALF;
                    xv[m][bj][0] = valid ? *(const f32x4*)xi : (f32x4){0.f, 0.f, 0.f, 0.f}; xv[m][bj][1] = valid ? *(const f32x4*)(xi + 4) : (f32x4){0.f, 0.f, 0.f, 0.f}; } }
            asm volatile("" ::: "memory");
#pragma unroll
            for (int m = 0; m < 4; ++m) { const int row = row0 + ai * HALF + m * 16; const bool valid = row < MROWS; float ss = 0.f;
#pragma unroll
                for (int bj = 0; bj < 2; ++bj) { float* xp = X + (size_t)row * 1024 + col0 + bj * HALF;
                    const f32x4 x0 = xv[m][bj][0] + acc[ai][bj][m][0] * scale, x1 = xv[m][bj][1] + acc[ai][bj][m][1] * scale;
                    if (valid) { *(f32x4*)xp = x0; *(f32x4*)(xp + 4) = x1; }
                    *(u32x4*)(XB + (size_t)row * 1024 + col0 + bj * HALF) = pk8(x0, x1);
                    ss += (x0[0] * x0[0] + x0[1] * x0[1]) + (x0[2] * x0[2] + x0[3] * x0[3]) + (x1[0] * x1[0] + x1[1] * x1[1]) + (x1[2] * x1[2] + x1[3] * x1[3]); }
                ss += __shfl_xor(ss, 16); ss += __shfl_xor(ss, 32);
                if (fq == 0) unsafeAtomicAdd(ssq_out + row, ss); }
            asm volatile("" ::: "memory");
        }
    }
};
constexpr float QSCALE = 0.125f * 1.4426950408889634f;
struct EpiEvenIn {
    static constexpr bool PERM = true, AFTER_DRAIN = false;
    const float* ssq; bf16_t* ZB; float* pk_; float* pv_; float* plf; float* sk_; float* sv_; float* slf; const float* b_f;
    __device__ __forceinline__ void operator()(const f32x4 (&acc)[2][2][4][2], const Unit& u, int wr, int wc, int fr, int fq) const {
        const int row0 = u.pm * BM + wr * 64 + fr, pn = u.pn, lc = wc * 32 + 8 * fq;
        float rsv[8];
#pragma unroll
        for (int i = 0; i < 8; ++i) rsv[i] = ssq[row0 + (i >> 2) * HALF + (i & 3) * 16];
#pragma unroll
        for (int i = 0; i < 8; ++i) rsv[i] = __builtin_amdgcn_rsqf(rsv[i] * (1.0f / 1024.0f) + RMS_EPS);
#pragma unroll
        for (int ai = 0; ai < 2; ++ai)
#pragma unroll
            for (int m = 0; m < 4; ++m) { const int row = row0 + ai * HALF + m * 16; const float rs = rsv[ai * 4 + m];
                if (pn < 12) {
                    const float sc = (pn == 6 || pn == 7) ? rs * QSCALE : rs;
#pragma unroll
                    for (int bj = 0; bj < 2; ++bj) { const int col = pn * BM + bj * HALF + lc; const f32x4 v0 = acc[ai][bj][m][0] * sc, v1 = acc[ai][bj][m][1] * sc;
                        *(u32x4*)(ZB + (size_t)row * 3072 + col) = pk8(v0, v1);
                        if (pn >= 8 && row < MROWS) { const int cc = (pn >= 10) ? col - 2560 : col - 2048;
                            float* dst = (row < 16384) ? ((pn >= 10 ? pv_ : pk_) + (size_t)row * 512 + cc) : ((pn >= 10 ? sv_ : sk_) + (size_t)(row - 16384) * 512 + cc);
                            *(f32x4*)dst = v0; *(f32x4*)(dst + 4) = v1; } }
                } else if (wc == 0 && fq == 0 && row < MROWS) {
                    float* dst = (row < 16384) ? plf + (size_t)row * 8 : slf + (size_t)(row - 16384) * 8; f32x4 o0, o1;
#pragma unroll
                    for (int e = 0; e < 4; ++e) { const float a = acc[ai][0][m][0][e] * rs + b_f[e], b = acc[ai][0][m][1][e] * rs + b_f[4 + e];
                        o0[e] = fminf(a, 0.f) - log1pf(__expf(-fabsf(a))); o1[e] = fminf(b, 0.f) - log1pf(__expf(-fabsf(b))); }
                    *(f32x4*)dst = o0; *(f32x4*)(dst + 4) = o1; }
            }
    }
};
struct EpiOddIn {
    static constexpr bool PERM = true, AFTER_DRAIN = false;
    const float* ssq; bf16_t* ZO;
    __device__ __forceinline__ void operator()(const f32x4 (&acc)[2][2][4][2], const Unit& u, int wr, int wc, int fr, int fq) const {
        const int row0 = u.pm * BM + wr * 64 + fr, pn = u.pn, lc = wc * 32 + 8 * fq;
        float rsv[8];
#pragma unroll
        for (int i = 0; i < 8; ++i) rsv[i] = ssq[row0 + (i >> 2) * HALF + (i & 3) * 16];
#pragma unroll
        for (int i = 0; i < 8; ++i) rsv[i] = __builtin_amdgcn_rsqf(rsv[i] * (1.0f / 1024.0f) + RMS_EPS);
#pragma unroll
        for (int ai = 0; ai < 2; ++ai)
#pragma unroll
            for (int m = 0; m < 4; ++m) { const int row = row0 + ai * HALF + m * 16; const float rs = rsv[ai * 4 + m];
                if (pn < 4) {
#pragma unroll
                    for (int bj = 0; bj < 2; ++bj) { f32x4 v0, v1;
#pragma unroll
                        for (int e = 0; e < 4; ++e) { v0[e] = gelu_tanh(acc[ai][bj][m][0][e] * rs); v1[e] = gelu_tanh(acc[ai][bj][m][1][e] * rs); }
                        *(u32x4*)(ZO + (size_t)row * 1536 + pn * BM + bj * HALF + lc) = pk8(v0, v1); }
                } else { f32x4 v0, v1;
#pragma unroll
                    for (int e = 0; e < 4; ++e) { v0[e] = acc[ai][0][m][0][e] * rs * sigmoidf_(acc[ai][1][m][0][e] * rs); v1[e] = acc[ai][0][m][1][e] * rs * sigmoidf_(acc[ai][1][m][1][e] * rs); }
                    *(u32x4*)(ZO + (size_t)row * 1536 + 1024 + (pn - 4) * HALF + lc) = pk8(v0, v1); }
            }
    }
};

struct ChunkOrder {
    int c, nchunk;
    __device__ __forceinline__ bool next(int i, Unit& u) const { if (i > 0 || c >= nchunk) return false; u.pm = 64; u.pn = c & 3; u.koff = (c >> 2) * 512; return true; }
    __device__ __forceinline__ void a_ready(const Unit&) const {}
    __device__ __forceinline__ void done(const Unit&) const {}
};
struct EpiAtomX {
    static constexpr bool PERM = true, AFTER_DRAIN = false;
    float* X; float scale;
    __device__ __forceinline__ void operator()(const f32x4 (&acc)[2][2][4][2], const Unit& u, int wr, int wc, int fr, int fq) const {
        const int row0 = u.pm * BM + wr * 64 + fr, col0 = u.pn * BM + wc * 32 + 8 * fq;
#pragma unroll
        for (int m = 0; m < 4; ++m) { const int row = row0 + m * 16;
#pragma unroll
            for (int bj = 0; bj < 2; ++bj) { float* xp = X + (size_t)row * 1024 + col0 + bj * HALF;
#pragma unroll
                for (int e = 0; e < 4; ++e) { unsafeAtomicAdd(xp + e, acc[0][bj][m][0][e] * scale); unsafeAtomicAdd(xp + 4 + e, acc[0][bj][m][1][e] * scale); } } }
    }
};
template <class Epi, class Sched, bool ALIGN_EPI = false, bool SP2 = false>
__device__ __forceinline__ void gemm_phase(PG8_LAS unsigned char* lds, const Gemm g, const Sched& S, const Epi& E) {
    const int tid = opaque_tid(), wid = __builtin_amdgcn_readfirstlane(tid >> 6), lane = tid & 63, wr = wid >> 2, wc = wid & 3, fr = lane & 15, fq = lane >> 4;
    const int K = g.K, nt = g.KL / BK;
    unsigned voffA[2], voffB[2];
#pragma unroll
    for (int i = 0; i < 2; ++i) { int R, C; stage_rc(tid * 16 + i * 8192, R, C); const int Rb = Epi::PERM ? ((R & ~31) + perm32(R & 31)) : R;
        voffA[i] = (unsigned)(R * K + C) * 2u; voffB[i] = (unsigned)(Rb * K + C) * 2u; }
    const size_t kstep = (size_t)(BK * 2);
    const size_t hstep = (size_t)HALF * K * 2;
    const size_t tstep = 2 * hstep;
    const unsigned ldsw = (unsigned)wid * 1024u;
    const int aoff = lds_byte(wr * 64 + fr, fq * 8), boff = lds_byte(wc * 32 + fr, fq * 8);
#define PG8_SA(b, h) (((b) * 2 + (h)) * HTB)
#define PG8_SB(b, h) ((4 + (b) * 2 + (h)) * HTB)
#define PG8_STAGE(bufoff, gbase, voff) do { _Pragma("unroll") for (int _i = 0; _i < 2; ++_i) \
        __builtin_amdgcn_global_load_lds((const unsigned*)((const char*)(gbase) + (voff)[_i]), (PG8_LAS unsigned*)(lds + (bufoff) + ldsw + _i * 8192), 16, 0, 0); } while (0)
#define PG8_LDA(dst, b, h) do { _Pragma("unroll") for (int m = 0; m < 4; ++m) _Pragma("unroll") for (int k = 0; k < 2; ++k) dst[m][k] = *(const PG8_LAS bf16x8*)(lds + PG8_SA(b, h) + aoff + m * 2048 + k * 1024); } while (0)
#define PG8_LDB(dst, b, h) do { _Pragma("unroll") for (int n = 0; n < 2; ++n) _Pragma("unroll") for (int k = 0; k < 2; ++k) dst[n][k] = *(const PG8_LAS bf16x8*)(lds + PG8_SB(b, h) + boff + n * 2048 + k * 1024); } while (0)
#define PG8_MMA(ai, bj, At, Bt) do { __builtin_amdgcn_s_setprio(1); _Pragma("unroll") for (int m = 0; m < 4; ++m) _Pragma("unroll") for (int n = 0; n < 2; ++n) _Pragma("unroll") for (int k = 0; k < 2; ++k) \
        acc[ai][bj][m][n] = __builtin_amdgcn_mfma_f32_16x16x32_bf16(Bt[n][k], At[m][k], acc[ai][bj][m][n], 0, 0, 0); __builtin_amdgcn_s_setprio(0); } while (0)
#define PG8_WAIT_V(n) asm volatile("s_waitcnt vmcnt(" #n ")" ::: "memory")
#define PG8_WAIT_L(n) asm volatile("s_waitcnt lgkmcnt(" #n ")" ::: "memory")
#define PG8_BAR __builtin_amdgcn_s_barrier()
#define PG8_SCHED __builtin_amdgcn_sched_barrier(0)
    Unit cur, nxt; int ui = 0;
    if (!S.next(0, cur)) return;
    f32x4 acc[2][2][4][2];
#pragma unroll
    for (int a = 0; a < 2; ++a)
#pragma unroll
        for (int b = 0; b < 2; ++b)
#pragma unroll
            for (int m = 0; m < 4; ++m)
#pragma unroll
                for (int n = 0; n < 2; ++n) acc[a][b][m][n] = (f32x4){0.f, 0.f, 0.f, 0.f};
    bf16x8 At[4][2], B0[2][2], B1[2][2];
    const char* cA = (const char*)g.A + (size_t)cur.pm * tstep + cur.koff; const char* cB = (const char*)g.Bt + (size_t)cur.pn * tstep + cur.koff;
    S.a_ready(cur);
    if constexpr (SP2) {
        PG8_STAGE(PG8_SB(0, 0), cB, voffB); PG8_STAGE(PG8_SB(0, 1), cB + hstep, voffB); PG8_STAGE(PG8_SA(0, 0), cA, voffA); PG8_STAGE(PG8_SA(0, 1), cA + hstep, voffA);
        if (wr == 1) PG8_BAR;
        PG8_WAIT_V(2); PG8_BAR;
        PG8_STAGE(PG8_SB(1, 0), cB + kstep, voffB); PG8_STAGE(PG8_SA(1, 0), cA + kstep, voffA); PG8_STAGE(PG8_SB(1, 1), cB + hstep + kstep, voffB);
        PG8_WAIT_V(6); PG8_BAR;
    } else {
        PG8_STAGE(PG8_SB(0, 0), cB, voffB); PG8_STAGE(PG8_SA(0, 0), cA, voffA); PG8_STAGE(PG8_SB(0, 1), cB + hstep, voffB); PG8_STAGE(PG8_SA(0, 1), cA + hstep, voffA);
        if (wr == 1) PG8_BAR;
        PG8_WAIT_V(4); PG8_BAR;
        PG8_STAGE(PG8_SB(1, 0), cB + kstep, voffB); PG8_STAGE(PG8_SA(1, 0), cA + kstep, voffA); PG8_STAGE(PG8_SB(1, 1), cB + hstep + kstep, voffB);
        PG8_WAIT_V(6); PG8_BAR;
    }
    for (;;) {
        const bool has_next = S.next(ui + 1, nxt);
        const char* nA = has_next ? (const char*)g.A + (size_t)nxt.pm * tstep + nxt.koff : cA; const char* nB = has_next ? (const char*)g.Bt + (size_t)nxt.pn * tstep + nxt.koff : cB;
        for (int t = 0; t < nt; t += 2) {
            const bool last = (t == nt - 2);
            const char* a1 = cA + (size_t)(t + 1) * kstep;
            const char* a2 = last ? nA : cA + (size_t)(t + 2) * kstep; const char* b2 = last ? nB : cB + (size_t)(t + 2) * kstep;
            const char* a3 = a2 + kstep; const char* b3 = b2 + kstep;
            if (last && has_next) S.a_ready(nxt);
            if constexpr (SP2) {
            PG8_LDB(B0, 0, 0); PG8_LDB(B1, 0, 1); PG8_SCHED; PG8_LDA(At, 0, 0); PG8_STAGE(PG8_SA(1, 1), a1 + hstep, voffA);
            PG8_WAIT_V(8); PG8_WAIT_L(0); PG8_BAR; PG8_MMA(0, 0, At, B0); PG8_MMA(0, 1, At, B1); PG8_BAR; PG8_SCHED;
            PG8_LDA(At, 0, 1); PG8_STAGE(PG8_SB(0, 0), b2, voffB); PG8_STAGE(PG8_SB(0, 1), b2 + hstep, voffB); PG8_STAGE(PG8_SA(0, 0), a2, voffA);
            PG8_WAIT_V(8); PG8_WAIT_L(0); PG8_BAR; PG8_MMA(1, 0, At, B0); PG8_MMA(1, 1, At, B1); PG8_BAR; PG8_SCHED;
            PG8_LDB(B0, 1, 0); PG8_LDB(B1, 1, 1); PG8_SCHED; PG8_LDA(At, 1, 0); PG8_STAGE(PG8_SA(0, 1), a2 + hstep, voffA);
            PG8_WAIT_V(8); PG8_WAIT_L(0); PG8_BAR; PG8_MMA(0, 0, At, B0); PG8_MMA(0, 1, At, B1); PG8_BAR; PG8_SCHED;
            PG8_LDA(At, 1, 1); PG8_STAGE(PG8_SB(1, 0), b3, voffB); PG8_STAGE(PG8_SB(1, 1), b3 + hstep, voffB); PG8_STAGE(PG8_SA(1, 0), a3, voffA);
            PG8_WAIT_V(8); PG8_WAIT_L(0); PG8_BAR; PG8_MMA(1, 0, At, B0); PG8_MMA(1, 1, At, B1); PG8_BAR; PG8_SCHED;
            } else {
            PG8_LDB(B0, 0, 0); PG8_SCHED; PG8_LDA(At, 0, 0); PG8_STAGE(PG8_SA(1, 1), a1 + hstep, voffA);
            PG8_WAIT_L(8); PG8_BAR; PG8_WAIT_L(0); PG8_MMA(0, 0, At, B0); PG8_BAR; PG8_SCHED;
            PG8_LDB(B1, 0, 1); PG8_STAGE(PG8_SB(0, 0), b2, voffB);
            PG8_BAR; PG8_WAIT_L(0); PG8_MMA(0, 1, At, B1); PG8_BAR;
            PG8_LDA(At, 0, 1); PG8_STAGE(PG8_SA(0, 0), a2, voffA);
            PG8_BAR; PG8_WAIT_L(0); PG8_MMA(1, 0, At, B0); PG8_BAR; PG8_SCHED;
            PG8_STAGE(PG8_SB(0, 1), b2 + hstep, voffB);
            PG8_WAIT_V(6); PG8_BAR; PG8_MMA(1, 1, At, B1); PG8_BAR;
            PG8_LDB(B0, 1, 0); PG8_SCHED; PG8_LDA(At, 1, 0); PG8_STAGE(PG8_SA(0, 1), a2 + hstep, voffA);
            PG8_WAIT_L(8); PG8_BAR; PG8_WAIT_L(0); PG8_MMA(0, 0, At, B0); PG8_BAR; PG8_SCHED;
            PG8_LDB(B1, 1, 1); PG8_STAGE(PG8_SB(1, 0), b3, voffB);
            PG8_BAR; PG8_WAIT_L(0); PG8_MMA(0, 1, At, B1); PG8_BAR;
            PG8_LDA(At, 1, 1); PG8_STAGE(PG8_SA(1, 0), a3, voffA);
            PG8_BAR; PG8_WAIT_L(0); PG8_MMA(1, 0, At, B0); PG8_BAR; PG8_SCHED;
            PG8_STAGE(PG8_SB(1, 1), b3 + hstep, voffB);
            PG8_WAIT_V(6); PG8_BAR; PG8_MMA(1, 1, At, B1); PG8_BAR;
            }
        }
        if constexpr (ALIGN_EPI) { if (wr == 0) PG8_BAR; }
        if constexpr (!Epi::AFTER_DRAIN) { E(acc, cur, wr, wc, fr, fq); S.done(cur); }
        if (!has_next) break;
#pragma unroll
        for (int a = 0; a < 2; ++a)
#pragma unroll
            for (int b = 0; b < 2; ++b)
#pragma unroll
                for (int m = 0; m < 4; ++m)
#pragma unroll
                    for (int n = 0; n < 2; ++n) acc[a][b][m][n] = (f32x4){0.f, 0.f, 0.f, 0.f};
        cur = nxt; cA = nA; cB = nB; ++ui;
        if constexpr (ALIGN_EPI) { if (wr == 1) PG8_BAR; }
    }
    PG8_WAIT_V(0);
    if constexpr (!ALIGN_EPI) { if (wr == 0) PG8_BAR; }
    PG8_BAR;
    if constexpr (Epi::AFTER_DRAIN) { E.fused(acc, cur, wr, wc, fr, fq, lds, wid, lane); S.done(cur); }
#undef PG8_SA
#undef PG8_SB
#undef PG8_STAGE
#undef PG8_LDA
#undef PG8_LDB
#undef PG8_MMA
#undef PG8_WAIT_V
#undef PG8_WAIT_L
#undef PG8_BAR
#undef PG8_SCHED
}
}
typedef unsigned short bf16_t;
typedef short bf16x8 __attribute__((ext_vector_type(8)));
typedef float f32x4 __attribute__((ext_vector_type(4)));
typedef float f32x16 __attribute__((ext_vector_type(16)));
typedef unsigned u32x4 __attribute__((ext_vector_type(4)));
typedef unsigned u32x2 __attribute__((ext_vector_type(2)));
using pg8::pk2; using pg8::pk8; using pg8::MROWS; using pg8::RMS_EPS;
constexpr int NTHR = 512, NWAVES = 8;
constexpr int MP = 16384, MT = 16640, DM = 1024, DFF = 2816;
constexpr size_t MiB = 1u << 20;
constexpr size_t WS_SSQ = 1 * MiB, WS_WSB = 2 * MiB, WS_W1 = 3 * MiB, WS_W2 = 47 * MiB, WS_EIN = 69 * MiB, WS_EOUT = 76 * MiB, WS_OIN = 78 * MiB, WS_OOUT = 82 * MiB,
                 WS_XB = 84 * MiB, WS_CAT = 117 * MiB, WS_BIG = 150 * MiB, WS_END = 248 * MiB;
constexpr size_t W1_BYTES = 11 * MiB, W2_BYTES = 5767168;
constexpr int LDS_BYTES = 147456;
constexpr size_t O_YP = 0, O_YS = 16777216, O_PK = O_YS + 131072, O_PV = O_PK + 8388608, O_PLF = O_PV + 8388608, O_PSC = O_PLF + 131072, O_PCC = O_PSC + 8192,
                 O_SK = O_PCC + 122880, O_SV = O_SK + 65536, O_SLF = O_SV + 65536, O_SSC = O_SLF + 1024, O_SCC = O_SSC + 8192, O_SGV = O_SCC + 122880, O_END = O_SGV + 65536;
constexpr float LOG2E = 1.4426950408889634f;

struct Params { const float* in[31]; float* out; unsigned char* ws; };

__device__ __forceinline__ float sum_xor32(float v) { const auto rr = __builtin_amdgcn_permlane32_swap(__float_as_uint(v), __float_as_uint(v), false, false); return __uint_as_float(rr[0]) + __uint_as_float(rr[1]); }
__device__ __forceinline__ float max_xor32(float v) { const auto rr = __builtin_amdgcn_permlane32_swap(__float_as_uint(v), __float_as_uint(v), false, false); return fmaxf(__uint_as_float(rr[0]), __uint_as_float(rr[1])); }
__device__ __forceinline__ float sum_xor16(float v) { const auto rr = __builtin_amdgcn_permlane16_swap(__float_as_uint(v), __float_as_uint(v), false, false); return __uint_as_float(rr[0]) + __uint_as_float(rr[1]); }
__device__ __forceinline__ float wave_sum(float v) {
    v += __builtin_bit_cast(float, __builtin_amdgcn_mov_dpp(__builtin_bit_cast(int, v), 0xB1, 0xF, 0xF, true));
    v += __builtin_bit_cast(float, __builtin_amdgcn_mov_dpp(__builtin_bit_cast(int, v), 0x4E, 0xF, 0xF, true));
    v += __builtin_bit_cast(float, __builtin_amdgcn_mov_dpp(__builtin_bit_cast(int, v), 0x141, 0xF, 0xF, true));
    v += __builtin_bit_cast(float, __builtin_amdgcn_mov_dpp(__builtin_bit_cast(int, v), 0x140, 0xF, 0xF, true));
    v = sum_xor16(v); v = sum_xor32(v);
    return v;
}
__device__ __forceinline__ float bf2f(unsigned short b) { return __uint_as_float((unsigned)b << 16); }
__device__ __forceinline__ float bflo(unsigned w) { return __uint_as_float(w << 16); }
__device__ __forceinline__ float bfhi(unsigned w) { return __uint_as_float(w & 0xffff0000u); }

__device__ __forceinline__ int map_row(int mode, int n0) {
    if (mode == 0) return n0;
    if (mode == 1) return (n0 >> 7) * 256 + (n0 & 127);
    if (mode == 2) return (n0 >> 7) * 256 + 128 + (n0 & 127);
    if (n0 < 1024) return n0;
    if (n0 < 1536) { const int j = n0 - 1024; return 1024 + (j >> 7) * 256 + (j & 127); }
    { const int j = n0 - 1536; return 1024 + (j >> 7) * 256 + 128 + (j & 127); }
}
__device__ __forceinline__ void tr_item(const float* __restrict__ W, const float* __restrict__ gain, int K, int Nsrc, int nblk, bf16_t* WT, int mode, float* scr, int item, int lane) {
    const int kb = item / nblk, nb = item - kb * nblk, k0 = 64 * kb, n0 = 64 * nb;
    const int kr = lane >> 4, n4 = (lane & 15) * 4; const bool nv = (n0 + n4) < Nsrc;
    f32x4 v[16];
#pragma unroll
    for (int i = 0; i < 16; ++i) v[i] = nv ? *(const f32x4*)(W + (size_t)(k0 + 4 * i + kr) * Nsrc + n0 + n4) : (f32x4){0.f, 0.f, 0.f, 0.f};
    if (gain) {
#pragma unroll
        for (int i = 0; i < 16; ++i) v[i] *= gain[k0 + 4 * i + kr]; }
#pragma unroll
    for (int i = 0; i < 16; ++i) { float* d = scr + (4 * i + kr) * 65 + n4; d[0] = v[i][0]; d[1] = v[i][1]; d[2] = v[i][2]; d[3] = v[i][3]; }
    asm volatile("s_waitcnt lgkmcnt(0)" ::: "memory");
    const int rb = map_row(mode, n0);
#pragma unroll
    for (int jj = 0; jj < 8; ++jj) { const int id = lane + 64 * jj, nn = id >> 3, c = id & 7; const float* s = scr + (8 * c) * 65 + nn;
        u32x4 o; o.x = pk2(s[0 * 65], s[1 * 65]); o.y = pk2(s[2 * 65], s[3 * 65]); o.z = pk2(s[4 * 65], s[5 * 65]); o.w = pk2(s[6 * 65], s[7 * 65]);
        *(u32x4*)(WT + (size_t)(rb + nn) * K + k0 + 8 * c) = o; }
    asm volatile("s_waitcnt lgkmcnt(0)" ::: "memory");
}

__device__ __forceinline__ int crow(int r, int hi) { return (r & 3) + 8 * (r >> 2) + 4 * hi; }
struct AttnState { float m, l; f32x16 o[2]; };
template <bool MASK> __device__ __forceinline__ void attn_tile(AttnState& st, const bf16x8 (&kf)[2][4], const bf16x8 (&vf)[2][4], const bf16x8 (&qr)[4], const float* clt, int hi, int kv_limit) {
    f32x16 p[2];
#pragma unroll
    for (int kvb = 0; kvb < 2; ++kvb) {
#pragma unroll
        for (int r4 = 0; r4 < 4; ++r4) { const f32x4 bv = *(const f32x4*)(clt + 32 * kvb + 8 * r4 + 4 * hi);
            p[kvb][4 * r4] = bv[0]; p[kvb][4 * r4 + 1] = bv[1]; p[kvb][4 * r4 + 2] = bv[2]; p[kvb][4 * r4 + 3] = bv[3]; }
#pragma unroll
        for (int d0 = 0; d0 < 4; ++d0) p[kvb] = __builtin_amdgcn_mfma_f32_32x32x16_bf16(kf[kvb][d0], qr[d0], p[kvb], 0, 0, 0); }
    float mx = -1e30f;
#pragma unroll
    for (int kvb = 0; kvb < 2; ++kvb)
#pragma unroll
        for (int r = 0; r < 16; ++r) { float s = p[kvb][r];
            if (MASK) { const int kvl = 32 * kvb + 8 * (r >> 2) + 4 * hi + (r & 3); s = (kvl > kv_limit) ? -1e30f : s; p[kvb][r] = s; }
            mx = fmaxf(mx, s); }
    mx = max_xor32(mx);
    const float mn = fmaxf(st.m, mx), alpha = __builtin_amdgcn_exp2f(st.m - mn); st.m = mn;
    float ls = 0.f;
#pragma unroll
    for (int kvb = 0; kvb < 2; ++kvb)
#pragma unroll
        for (int r = 0; r < 16; ++r) { const float e = __builtin_amdgcn_exp2f(p[kvb][r] - mn); p[kvb][r] = e; ls += e; }
    st.l = st.l * alpha + ls;
#pragma unroll
    for (int db = 0; db < 2; ++db)
#pragma unroll
        for (int r = 0; r < 16; ++r) st.o[db][r] *= alpha;
    bf16x8 pb[4];
#pragma unroll
    for (int s = 0; s < 4; ++s) { const int kvb = s >> 1, b0 = 8 * (s & 1);
        u32x4 w; w.x = pk2(p[kvb][b0 + 0], p[kvb][b0 + 1]); w.y = pk2(p[kvb][b0 + 2], p[kvb][b0 + 3]); w.z = pk2(p[kvb][b0 + 4], p[kvb][b0 + 5]); w.w = pk2(p[kvb][b0 + 6], p[kvb][b0 + 7]);
        pb[s] = __builtin_bit_cast(bf16x8, w); }
#pragma unroll
    for (int db = 0; db < 2; ++db)
#pragma unroll
        for (int s = 0; s < 4; ++s) st.o[db] = __builtin_amdgcn_mfma_f32_32x32x16_bf16(vf[db][s], pb[s], st.o[db], 0, 0, 0);
}
template <int NV, class F> __device__ __forceinline__ void block_cumsum(float* cl, float* tmp, F getv, int tid, int lane, int wid) {
    float v[NV];
#pragma unroll
    for (int e = 0; e < NV; ++e) v[e] = getv(NV * tid + e);
#pragma unroll
    for (int e = 1; e < NV; ++e) v[e] += v[e - 1];
    const float tot = v[NV - 1]; float sc = tot;
#pragma unroll
    for (int off = 1; off < 64; off <<= 1) { const float t = __shfl_up(sc, off); if (lane >= off) sc += t; }
    if (lane == 63) tmp[wid] = sc;
    __syncthreads();
    float base = 0.f;
#pragma unroll
    for (int w = 0; w < 8; ++w) base += (w < wid) ? tmp[w] : 0.f;
    const float excl = base + sc - tot;
#pragma unroll
    for (int e = 0; e < NV; ++e) cl[NV * tid + e] = -(excl + v[e]) * LOG2E;
}
constexpr int AL_KS = 0, AL_VT = 18432, AL_CL = 35840, AL_TMP = 35840 + 10240, AL_OW = 49152, AL_ML = 49152 + 65536, AL_SK = 49152;

__device__ __forceinline__ void attn_prompt_unit(unsigned char* lds, int b, int h, int qb, const bf16_t* __restrict__ ZB, const float* __restrict__ logf, bf16_t* CAT) {
    const int tid = opaque_tid(), lane = tid & 63, wid = __builtin_amdgcn_readfirstlane(tid >> 6), r32 = lane & 31, hi = lane >> 5;
    float* cl = (float*)(lds + AL_CL); float* tmp = (float*)(lds + AL_TMP);
    const int rowbase = b * 2048, q0 = qb * 256, NT = 4 * (qb + 1), nk = NT * 64;
    const bf16_t* Qp = ZB + (size_t)(rowbase + q0 + 32 * wid + r32) * 3072 + 1536 + h * 64;
    bf16x8 qr[4];
#pragma unroll
    for (int d0 = 0; d0 < 4; ++d0) qr[d0] = *(const bf16x8*)(Qp + 16 * d0 + 8 * hi);
    const int lkv = tid >> 3, lch = tid & 7;
    const bf16_t* Kg = ZB + (size_t)(rowbase + lkv) * 3072 + 2048 + h * 64 + 8 * lch;
    const bf16_t* Vg = ZB + (size_t)(rowbase + lane) * 3072 + 2560 + h * 64 + 8 * wid;
    u32x4 kreg = *(const u32x4*)Kg, vreg = *(const u32x4*)Vg;
    block_cumsum<4>(cl, tmp, [&](int k) { return (k < nk) ? logf[(size_t)(rowbase + k) * 8 + h] : 0.f; }, tid, lane, wid);
    auto stage = [&](int buf) {
        *(u32x4*)(lds + AL_KS + buf * 9216 + lkv * 144 + lch * 16) = kreg;
        unsigned short* vt = (unsigned short*)(lds + AL_VT + buf * 8704) + (8 * wid) * 68 + lane;
        vt[0 * 68] = (unsigned short)(vreg.x & 0xffff); vt[1 * 68] = (unsigned short)(vreg.x >> 16); vt[2 * 68] = (unsigned short)(vreg.y & 0xffff); vt[3 * 68] = (unsigned short)(vreg.y >> 16);
        vt[4 * 68] = (unsigned short)(vreg.z & 0xffff); vt[5 * 68] = (unsigned short)(vreg.z >> 16); vt[6 * 68] = (unsigned short)(vreg.w & 0xffff); vt[7 * 68] = (unsigned short)(vreg.w >> 16); };
    stage(0);
    __syncthreads();
    AttnState st; st.m = -1e30f; st.l = 0.f; st.o[0] = f32x16{}; st.o[1] = f32x16{};
    const int qg = q0 + 32 * wid + r32;
    for (int t = 0; t < NT; ++t) {
        if (t + 1 < NT) { kreg = *(const u32x4*)(Kg + (size_t)(t + 1) * 64 * 3072); vreg = *(const u32x4*)(Vg + (size_t)(t + 1) * 64 * 3072); }
        if (64 * t <= q0 + 32 * wid + 31) {
            const unsigned char* ks = lds + AL_KS + (t & 1) * 9216; const unsigned char* vt = lds + AL_VT + (t & 1) * 8704;
            bf16x8 kf[2][4], vf[2][4];
#pragma unroll
            for (int kvb = 0; kvb < 2; ++kvb)
#pragma unroll
                for (int d0 = 0; d0 < 4; ++d0) kf[kvb][d0] = *(const bf16x8*)(ks + (32 * kvb + r32) * 144 + (16 * d0 + 8 * hi) * 2);
#pragma unroll
            for (int db = 0; db < 2; ++db)
#pragma unroll
                for (int s = 0; s < 4; ++s) { const unsigned char* p = vt + (32 * db + r32) * 136 + (16 * s + 4 * hi) * 2; const u32x2 lo = *(const u32x2*)p, hv = *(const u32x2*)(p + 16);
                    vf[db][s] = __builtin_bit_cast(bf16x8, (u32x4){lo.x, lo.y, hv.x, hv.y}); }
            if (64 * t + 63 > q0 + 32 * wid) attn_tile<true>(st, kf, vf, qr, cl + 64 * t, hi, qg - 64 * t); else attn_tile<false>(st, kf, vf, qr, cl + 64 * t, hi, 64);
        }
        if (t + 1 < NT) stage((t + 1) & 1);
        __syncthreads();
    }
    const float lt = sum_xor32(st.l), inv = 1.0f / lt;
    bf16_t* Op = CAT + (size_t)(rowbase + qg) * 1024 + 512 + h * 64 + 4 * hi;
#pragma unroll
    for (int db = 0; db < 2; ++db)
#pragma unroll
        for (int r4 = 0; r4 < 4; ++r4) { u32x2 w; w.x = pk2(st.o[db][4 * r4] * inv, st.o[db][4 * r4 + 1] * inv); w.y = pk2(st.o[db][4 * r4 + 2] * inv, st.o[db][4 * r4 + 3] * inv);
            *(u32x2*)(Op + 32 * db + 8 * r4) = w; }
}

__device__ __forceinline__ void attn_sample_unit(unsigned char* lds, int b, int h, const bf16_t* __restrict__ ZB, const float* __restrict__ cK, const float* __restrict__ cV, const float* __restrict__ cLF,
                                                 const float* __restrict__ nK, const float* __restrict__ nV, const float* __restrict__ nLF, bf16_t* CAT) {
    const int tid = opaque_tid(), lane = tid & 63, wid = __builtin_amdgcn_readfirstlane(tid >> 6), r32 = lane & 31, hi = lane >> 5;
    float* cl = (float*)(lds + AL_CL); float* tmp = (float*)(lds + AL_TMP);
    block_cumsum<5>(cl, tmp, [&](int k) { return (k < 2048) ? cLF[(size_t)(b * 2048 + k) * 8 + h] : ((k < 2064) ? nLF[(size_t)(b * 16 + k - 2048) * 8 + h] : 0.f); }, tid, lane, wid);
    __syncthreads();
    const bf16_t* Qp = ZB + (size_t)(MP + 16 * b + r32) * 3072 + 1536 + h * 64;
    bf16x8 qr[4];
#pragma unroll
    for (int d0 = 0; d0 < 4; ++d0) qr[d0] = *(const bf16x8*)(Qp + 16 * d0 + 8 * hi);
    AttnState st; st.m = -1e30f; st.l = 0.f; st.o[0] = f32x16{}; st.o[1] = f32x16{};
    auto rowp = [&](const float* c, const float* n, int kv) -> const float* {
        return (kv < 2048) ? c + ((size_t)(b * 2048 + kv) * 8 + h) * 64 : n + ((size_t)(b * 16 + min(kv - 2048, 15)) * 8 + h) * 64; };
    for (int t = wid; t < 33; t += 8) {
        bf16x8 kf[2][4], vf[2][4];
        {
            unsigned char* kst = lds + AL_SK + wid * 9216; f32x4 kr[16], vr[16];
#pragma unroll
            for (int i = 0; i < 16; ++i) kr[i] = *(const f32x4*)(rowp(cK, nK, 64 * t + 4 * i + (lane >> 4)) + 4 * (lane & 15));
#pragma unroll
            for (int i = 0; i < 16; ++i) { u32x2 w; w.x = pk2(kr[i][0], kr[i][1]); w.y = pk2(kr[i][2], kr[i][3]); *(u32x2*)(kst + (4 * i + (lane >> 4)) * 144 + (lane & 15) * 8) = w; }
#pragma unroll
            for (int i = 0; i < 16; ++i) vr[i] = *(const f32x4*)(rowp(cV, nV, 64 * t + 4 * i + (lane >> 4)) + 4 * (lane & 15));
            asm volatile("s_waitcnt lgkmcnt(0)" ::: "memory");
#pragma unroll
            for (int kvb = 0; kvb < 2; ++kvb)
#pragma unroll
                for (int d0 = 0; d0 < 4; ++d0) kf[kvb][d0] = *(const bf16x8*)(kst + (32 * kvb + r32) * 144 + (16 * d0 + 8 * hi) * 2);
            asm volatile("s_waitcnt lgkmcnt(0)" ::: "memory");
#pragma unroll
            for (int i = 0; i < 16; ++i) { u32x2 w; w.x = pk2(vr[i][0], vr[i][1]); w.y = pk2(vr[i][2], vr[i][3]); *(u32x2*)(kst + (4 * i + (lane >> 4)) * 144 + (lane & 15) * 8) = w; }
            asm volatile("s_waitcnt lgkmcnt(0)" ::: "memory");
#pragma unroll
            for (int s = 0; s < 4; ++s)
#pragma unroll
                for (int db = 0; db < 2; ++db) { unsigned e[8];
#pragma unroll
                    for (int j = 0; j < 8; ++j) e[j] = *(const unsigned short*)(kst + (16 * s + 4 * hi + (j & 3) + 8 * (j >> 2)) * 144 + (32 * db + r32) * 2);
                    vf[db][s] = __builtin_bit_cast(bf16x8, (u32x4){e[0] | (e[1] << 16), e[2] | (e[3] << 16), e[4] | (e[5] << 16), e[6] | (e[7] << 16)}); }
            asm volatile("s_waitcnt lgkmcnt(0)" ::: "memory");
        }
        attn_tile<true>(st, kf, vf, qr, cl + 64 * t, hi, 2048 + r32 - 64 * t);
    }
    __syncthreads();
    const float lt = sum_xor32(st.l);
    float* ow = (float*)(lds + AL_OW) + wid * 2048; float* ml = (float*)(lds + AL_ML) + wid * 64;
    if (hi == 0) { ml[r32] = st.m; ml[32 + r32] = lt; }
#pragma unroll
    for (int db = 0; db < 2; ++db)
#pragma unroll
        for (int r = 0; r < 16; ++r) ow[(32 * db + crow(r, hi)) * 32 + r32] = st.o[db][r];
    __syncthreads();
#pragma unroll
    for (int e = 0; e < 2; ++e) { const int oi = tid + 512 * e, q = oi >> 6, d = oi & 63; const float* mlb = (const float*)(lds + AL_ML); const float* owb = (const float*)(lds + AL_OW);
        float M = -1e30f;
#pragma unroll
        for (int w = 0; w < 8; ++w) M = fmaxf(M, mlb[w * 64 + q]);
        float L = 0.f, O = 0.f;
#pragma unroll
        for (int w = 0; w < 8; ++w) { const float f = __builtin_amdgcn_exp2f(mlb[w * 64 + q] - M); L += mlb[w * 64 + 32 + q] * f; O += owb[w * 2048 + d * 32 + q] * f; }
        CAT[(size_t)(MP + 16 * b + q) * 1024 + 512 + h * 64 + d] = (bf16_t)(pk2(O / L, 0.f) & 0xffff); }
    __syncthreads();
}

__device__ __forceinline__ void conva_item(int item, const bf16_t* __restrict__ ZB, const float* __restrict__ cw, const float* __restrict__ st_sc, bf16_t* CAT, float* out) {
    const int tid = opaque_tid(), rb = tid >> 6, ch = (tid & 63) * 8, R0 = item * 64 + rb * 8;
    if (R0 >= MROWS) return;
    const bool samp = R0 >= MP; const bool start = samp ? (((R0 - MP) & 15) == 0) : ((R0 & 2047) == 0);
    u32x4 xa[10], gc[10], gbv[8];
#pragma unroll
    for (int i = 0; i < 10; ++i) { const int row = (start && i < 2) ? R0 : R0 - 2 + i; xa[i] = *(const u32x4*)(ZB + (size_t)row * 3072 + ch); gc[i] = *(const u32x4*)(ZB + (size_t)row * 3072 + 1024 + ch); }
#pragma unroll
    for (int i = 0; i < 8; ++i) gbv[i] = *(const u32x4*)(ZB + (size_t)(R0 + i) * 3072 + 512 + ch);
    float w0[8], w1[8], w2[8], p2[8], p1[8];
#pragma unroll
    for (int e = 0; e < 8; ++e) { w0[e] = cw[ch + e]; w1[e] = cw[512 + ch + e]; w2[e] = cw[1024 + ch + e]; }
    auto prod = [&](const u32x4 a, const u32x4 c, float* pr) {
        pr[0] = bflo(a.x) * bflo(c.x); pr[1] = bfhi(a.x) * bfhi(c.x); pr[2] = bflo(a.y) * bflo(c.y); pr[3] = bfhi(a.y) * bfhi(c.y);
        pr[4] = bflo(a.z) * bflo(c.z); pr[5] = bfhi(a.z) * bfhi(c.z); pr[6] = bflo(a.w) * bflo(c.w); pr[7] = bfhi(a.w) * bfhi(c.w); };
    if (start) {
        if (samp) { const int b = (R0 - MP) >> 4;
#pragma unroll
            for (int e = 0; e < 8; ++e) { p2[e] = st_sc[(size_t)(b * 2 + 0) * 512 + ch + e]; p1[e] = st_sc[(size_t)(b * 2 + 1) * 512 + ch + e]; } }
        else {
#pragma unroll
            for (int e = 0; e < 8; ++e) { p2[e] = 0.f; p1[e] = 0.f; } }
    } else { prod(xa[0], gc[0], p2); prod(xa[1], gc[1], p1); }
#pragma unroll
    for (int i = 0; i < 8; ++i) { const int row = R0 + i; float p0[8]; prod(xa[i + 2], gc[i + 2], p0);
        const u32x4 g = gbv[i];
        const float gf[8] = {bflo(g.x), bfhi(g.x), bflo(g.y), bfhi(g.y), bflo(g.z), bfhi(g.z), bflo(g.w), bfhi(g.w)};
        float y[8];
#pragma unroll
        for (int e = 0; e < 8; ++e) y[e] = gf[e] * (w0[e] * p2[e] + w1[e] * p1[e] + w2[e] * p0[e]);
        *(u32x4*)(CAT + (size_t)row * 1024 + ch) = pk8((f32x4){y[0], y[1], y[2], y[3]}, (f32x4){y[4], y[5], y[6], y[7]});
        int orow = -1; float* ob = nullptr;
        if (!samp) { const int tt = row & 2047; if (tt >= 2046) { orow = (row >> 11) * 2 + (tt - 2046); ob = out + O_PSC; } }
        else { const int ii = (row - MP) & 15; if (ii >= 14) { orow = ((row - MP) >> 4) * 2 + (ii - 14); ob = out + O_SSC; } }
        if (orow >= 0) { *(f32x4*)(ob + (size_t)orow * 512 + ch) = (f32x4){p0[0], p0[1], p0[2], p0[3]}; *(f32x4*)(ob + (size_t)orow * 512 + ch + 4) = (f32x4){p0[4], p0[5], p0[6], p0[7]}; }
#pragma unroll
        for (int e = 0; e < 8; ++e) { p2[e] = p1[e]; p1[e] = p0[e]; } }
}
constexpr int CL_STAT = 0, CL_VNT = 2048;
__device__ __forceinline__ void gmlp_unit(unsigned char* lds, int R0, int gh, bool samp, int sb, const bf16_t* __restrict__ ZO, const bf16_t* __restrict__ WSB, const float* __restrict__ lng, const float* __restrict__ lnb,
                                          const float* __restrict__ bs, bf16_t* CAT, float* out) {
    const int tid = opaque_tid(), lane = tid & 63, wid = __builtin_amdgcn_readfirstlane(tid >> 6), r32 = lane & 31, hi = lane >> 5;
    float* stat = (float*)(lds + CL_STAT);
    { u32x4 av[16];
#pragma unroll
      for (int i = 0; i < 16; ++i) av[i] = *(const u32x4*)(ZO + (size_t)(R0 + wid * 16 + i) * 1536 + 512 + 8 * lane);
#pragma unroll
      for (int i = 0; i < 16; ++i) { const int s = wid * 16 + i; const u32x4 a = av[i];
        const float v[8] = {bflo(a.x), bfhi(a.x), bflo(a.y), bfhi(a.y), bflo(a.z), bfhi(a.z), bflo(a.w), bfhi(a.w)};
        float sm = 0.f;
#pragma unroll
        for (int e = 0; e < 8; ++e) sm += v[e];
        const float mean = wave_sum(sm) * (1.0f / 512.0f); float q = 0.f;
#pragma unroll
        for (int e = 0; e < 8; ++e) q += (v[e] - mean) * (v[e] - mean);
        const float rstd = __builtin_amdgcn_rsqf(wave_sum(q) * (1.0f / 512.0f) + RMS_EPS);
        if (lane == 0) { stat[2 * s] = mean; stat[2 * s + 1] = rstd; }
        if (samp && gh == 0 && s < 16) { float* o = out + O_SGV + (size_t)(sb * 16 + s) * 512 + 8 * lane;
#pragma unroll
            for (int e = 0; e < 8; ++e) o[e] = (v[e] - mean) * rstd * lng[8 * lane + e] + lnb[8 * lane + e]; } } }
    __syncthreads();
    for (int gi = 0; gi < 4; ++gi) { const int g = gh * 4 + gi;
        { const int s = tid & 127, c0 = 16 * (tid >> 7); const float mean = stat[2 * s], rstd = stat[2 * s + 1];
            const bf16_t* src = ZO + (size_t)(R0 + s) * 1536 + 512 + g * 64 + c0; unsigned short* vt = (unsigned short*)(lds + CL_VNT) + c0 * 136 + s;
#pragma unroll
            for (int hh = 0; hh < 2; ++hh) { const u32x4 a = *(const u32x4*)(src + 8 * hh); const float v[8] = {bflo(a.x), bfhi(a.x), bflo(a.y), bfhi(a.y), bflo(a.z), bfhi(a.z), bflo(a.w), bfhi(a.w)};
#pragma unroll
                for (int e = 0; e < 8; ++e) { const int c = g * 64 + c0 + 8 * hh + e; const float y = (v[e] - mean) * rstd * lng[c] + lnb[c]; vt[(8 * hh + e) * 136] = (unsigned short)(pk2(y, 0.f) & 0xffff); } } }
        __syncthreads();
        { const int cb = wid & 1, tb = wid >> 1;
          if (!samp || tb == 0) {
            f32x16 acc = f32x16{};
            const unsigned char* ap = lds + CL_VNT + (32 * cb + r32) * 272 + 16 * hi; const bf16_t* bp = WSB + (size_t)(g * 128 + 32 * tb + r32) * 128 + 8 * hi;
            bf16x8 Bf[8];
#pragma unroll
            for (int ks = 0; ks < 8; ++ks) Bf[ks] = (ks < 2 * (tb + 1)) ? *(const bf16x8*)(bp + 16 * ks) : (bf16x8){0, 0, 0, 0, 0, 0, 0, 0};
#pragma unroll
            for (int ks = 0; ks < 8; ++ks) if (ks < 2 * (tb + 1)) { const bf16x8 A = *(const bf16x8*)(ap + 32 * ks); acc = __builtin_amdgcn_mfma_f32_32x32x16_bf16(A, Bf[ks], acc, 0, 0, 0); }
            const int t = 32 * tb + r32; const float bst = bs[g * 128 + t];
            if (!samp || t < 16) {
#pragma unroll
                for (int r4 = 0; r4 < 4; ++r4) { const int c = g * 64 + 32 * cb + 8 * r4 + 4 * hi; const u32x2 uu = *(const u32x2*)(ZO + (size_t)(R0 + t) * 1536 + c);
                    u32x2 w; w.x = pk2(bflo(uu.x) * (acc[4 * r4] + bst), bfhi(uu.x) * (acc[4 * r4 + 1] + bst)); w.y = pk2(bflo(uu.y) * (acc[4 * r4 + 2] + bst), bfhi(uu.y) * (acc[4 * r4 + 3] + bst));
                    *(u32x2*)(CAT + (size_t)(R0 + t) * 1024 + c) = w; } }
          } }
        __syncthreads();
    }
}
__device__ __forceinline__ void gmlp_sample_unit(unsigned char* lds, int sb, const bf16_t* __restrict__ ZO, const bf16_t* __restrict__ WSB, const float* __restrict__ lng, const float* __restrict__ lnb,
                                                 const float* __restrict__ bs, bf16_t* CAT, float* out) {
    const int tid = opaque_tid(), lane = tid & 63, wid = __builtin_amdgcn_readfirstlane(tid >> 6), r32 = lane & 31, hi = lane >> 5;
    const int R0 = MP + 16 * sb;
    float* stat = (float*)(lds + CL_STAT); unsigned char* vn8 = lds + CL_VNT;
    { u32x4 av[2];
#pragma unroll
      for (int i = 0; i < 2; ++i) av[i] = *(const u32x4*)(ZO + (size_t)(R0 + 2 * wid + i) * 1536 + 512 + 8 * lane);
#pragma unroll
      for (int i = 0; i < 2; ++i) { const int s = 2 * wid + i; const u32x4 a = av[i];
        const float v[8] = {bflo(a.x), bfhi(a.x), bflo(a.y), bfhi(a.y), bflo(a.z), bfhi(a.z), bflo(a.w), bfhi(a.w)};
        float sm = 0.f;
#pragma unroll
        for (int e = 0; e < 8; ++e) sm += v[e];
        const float mean = wave_sum(sm) * (1.0f / 512.0f); float q = 0.f;
#pragma unroll
        for (int e = 0; e < 8; ++e) q += (v[e] - mean) * (v[e] - mean);
        const float rstd = __builtin_amdgcn_rsqf(wave_sum(q) * (1.0f / 512.0f) + RMS_EPS);
        if (lane == 0) { stat[2 * s] = mean; stat[2 * s + 1] = rstd; }
        float* o = out + O_SGV + (size_t)(sb * 16 + s) * 512 + 8 * lane;
#pragma unroll
        for (int e = 0; e < 8; ++e) o[e] = (v[e] - mean) * rstd * lng[8 * lane + e] + lnb[8 * lane + e]; } }
    __syncthreads();
    { const int s = tid >> 5, ch0 = (tid & 31) * 16; const float mean = stat[2 * s], rstd = stat[2 * s + 1];
      const bf16_t* src = ZO + (size_t)(R0 + s) * 1536 + 512 + ch0; unsigned short* vt = (unsigned short*)vn8 + (size_t)((ch0 >> 6) * 64 + (ch0 & 63)) * 40 + s;
#pragma unroll
      for (int hh = 0; hh < 2; ++hh) { const u32x4 a = *(const u32x4*)(src + 8 * hh); const float v[8] = {bflo(a.x), bfhi(a.x), bflo(a.y), bfhi(a.y), bflo(a.z), bfhi(a.z), bflo(a.w), bfhi(a.w)};
#pragma unroll
          for (int e = 0; e < 8; ++e) { const int c = ch0 + 8 * hh + e; const float y = (v[e] - mean) * rstd * lng[c] + lnb[c]; vt[(8 * hh + e) * 40] = (unsigned short)(pk2(y, 0.f) & 0xffff); vt[(8 * hh + e) * 40 + 16] = 0; } } }
    __syncthreads();
#pragma unroll
    for (int k = 0; k < 2; ++k) { const int task = wid + 8 * k, g = task >> 1, cb = task & 1;
        const unsigned char* ap = vn8 + (size_t)(g * 64 + 32 * cb + r32) * 80 + 16 * hi; const bf16_t* bp = WSB + (size_t)(g * 128 + r32) * 128 + 8 * hi;
        f32x16 acc = f32x16{};
#pragma unroll
        for (int ks = 0; ks < 2; ++ks) { const bf16x8 A = *(const bf16x8*)(ap + 32 * ks), B = *(const bf16x8*)(bp + 16 * ks); acc = __builtin_amdgcn_mfma_f32_32x32x16_bf16(A, B, acc, 0, 0, 0); }
        const int t = r32;
        if (t < 16) { const float bst = bs[g * 128 + t];
#pragma unroll
            for (int r4 = 0; r4 < 4; ++r4) { const int c = g * 64 + 32 * cb + 8 * r4 + 4 * hi; const u32x2 uu = *(const u32x2*)(ZO + (size_t)(R0 + t) * 1536 + c);
                u32x2 w; w.x = pk2(bflo(uu.x) * (acc[4 * r4] + bst), bfhi(uu.x) * (acc[4 * r4 + 1] + bst)); w.y = pk2(bflo(uu.y) * (acc[4 * r4 + 2] + bst), bfhi(uu.y) * (acc[4 * r4 + 3] + bst));
                *(u32x2*)(CAT + (size_t)(R0 + t) * 1024 + c) = w; } } }
    __syncthreads();
}
template <bool SAMP> __device__ __forceinline__ void cconv_unit(unsigned char* lds, int R0, int sb, const bf16_t* __restrict__ ZO, const float* __restrict__ dw, const float* __restrict__ dwb, const float* __restrict__ cng,
                                           const float* __restrict__ cnb, const float* __restrict__ st_cc, bf16_t* CAT) {
    typedef float f32x2 __attribute__((ext_vector_type(2)));
    const int tid = opaque_tid(), lane = tid & 63, wid = __builtin_amdgcn_readfirstlane(tid >> 6), cp = tid & 255, c = 2 * cp, h = tid >> 8;
    float* cd = (float*)lds;
    f32x2 w[31];
#pragma unroll
    for (int j = 0; j < 31; ++j) w[j] = *(const f32x2*)(dw + j * 512 + c);
    const f32x2 bias = *(const f32x2*)(dwb + c);
    const f32x4 g0 = *(const f32x4*)(cng + 4 * lane), g1 = *(const f32x4*)(cng + 256 + 4 * lane), c0 = *(const f32x4*)(cnb + 4 * lane), c1 = *(const f32x4*)(cnb + 256 + 4 * lane);
    constexpr int NSTEP = SAMP ? 1 : 2;
#pragma unroll
    for (int step = 0; step < NSTEP; ++step) { const int Rs = R0 + 32 * h + 16 * step;
        if (!SAMP || h == 0) {
            f32x2 x[46];
            if (SAMP) {
#pragma unroll
                for (int i = 0; i < 46; ++i) { if (i < 30) x[i] = *(const f32x2*)(st_cc + (size_t)(sb * 30 + i) * 512 + c); else { const unsigned v = *(const unsigned*)(ZO + (size_t)(Rs + i - 30) * 1536 + 1024 + c); x[i] = (f32x2){bflo(v), bfhi(v)}; } }
            } else { const int ts = (Rs & 2047) - 30;
#pragma unroll
                for (int i = 0; i < 46; ++i) { const unsigned v = (ts + i >= 0) ? *(const unsigned*)(ZO + (size_t)(Rs - 30 + i) * 1536 + 1024 + c) : 0u; x[i] = (f32x2){bflo(v), bfhi(v)}; } }
#pragma unroll
            for (int i = 0; i < 16; ++i) { f32x2 a = bias;
#pragma unroll
                for (int j = 0; j < 31; ++j) a += w[j] * x[i + j];
                *(f32x2*)(cd + (16 * h + i) * 512 + c) = a; }
        }
        __syncthreads();
        constexpr int RPW = SAMP ? 2 : 4;
#pragma unroll
        for (int rr = 0; rr < RPW; ++rr) { const int i = RPW * wid + rr; const f32x4 a = *(const f32x4*)(cd + i * 512 + 4 * lane), b2 = *(const f32x4*)(cd + i * 512 + 256 + 4 * lane);
            const float mean = wave_sum((a[0] + a[1]) + (a[2] + a[3]) + (b2[0] + b2[1]) + (b2[2] + b2[3])) * (1.0f / 512.0f);
            const f32x4 da = a - mean, db = b2 - mean;
            const float rstd = __builtin_amdgcn_rsqf(wave_sum((da[0] * da[0] + da[1] * da[1]) + (da[2] * da[2] + da[3] * da[3]) + (db[0] * db[0] + db[1] * db[1]) + (db[2] * db[2] + db[3] * db[3])) * (1.0f / 512.0f) + RMS_EPS);
            f32x4 y0 = da * rstd * g0 + c0, y1 = db * rstd * g1 + c1;
#pragma unroll
            for (int e = 0; e < 4; ++e) { y0[e] = pg8::siluf_(y0[e]); y1[e] = pg8::siluf_(y1[e]); }
            const int orow = R0 + 32 * (i >> 4) + 16 * step + (i & 15);
            bf16_t* op = CAT + (size_t)orow * 1024 + 512 + 4 * lane;
            u32x2 w0; w0.x = pk2(y0[0], y0[1]); w0.y = pk2(y0[2], y0[3]); *(u32x2*)op = w0;
            u32x2 w1; w1.x = pk2(y1[0], y1[1]); w1.y = pk2(y1[2], y1[3]); *(u32x2*)(op + 256) = w1; }
        __syncthreads();
    }
}

#define GAS __attribute__((address_space(1)))
#define LAS __attribute__((address_space(3)))
typedef GAS unsigned gu32;
typedef GAS unsigned long long gu64;
#define RLX_AGENT __ATOMIC_RELAXED, __HIP_MEMORY_SCOPE_AGENT
#define LDS_WAIT() asm volatile("s_waitcnt lgkmcnt(0)" ::: "memory")
#define VM_WAIT() asm volatile("s_waitcnt vmcnt(0)" ::: "memory")
__device__ __forceinline__ unsigned long long rt() { return __builtin_amdgcn_s_memrealtime(); }
#define XB_TMO      128
#define XB_XCNT(j)  (256  + 64 * (j))
#define XB_XSUB(j)  (1280 + 64 * (j))
#define XB_XGEN(j)  (2304 + 64 * (j))
#define XB_TOP      3328
#define XB_TOPGEN   3392
#define XCD_BAR_WORDS 3456
#define XB_SPIN_CAP (1u << 18)

__device__ __forceinline__ unsigned xb_ld(unsigned* p)              { return __hip_atomic_load(p, __ATOMIC_RELAXED, __HIP_MEMORY_SCOPE_AGENT); }
__device__ __forceinline__ unsigned xb_add(unsigned* p, unsigned v) { return __hip_atomic_fetch_add(p, v, __ATOMIC_RELAXED, __HIP_MEMORY_SCOPE_AGENT); }
__device__ __forceinline__ unsigned xb_xcc_id() { return (unsigned)__builtin_amdgcn_s_getreg((3 << 11) | 20) & 0xFu; }
#define XB_SPIN(cond, bar) do { unsigned _sp = 0; while (cond) { __builtin_amdgcn_s_sleep(1); \
    if ((++_sp & 255u) == 0u) { if (xb_ld(&(bar)[XB_TMO])) break; if (_sp > XB_SPIN_CAP) { atomicAdd(&(bar)[XB_TMO], 1u); break; } } } } while (0)

struct XcdBarrier {
    unsigned* bar; unsigned x;
    volatile LAS unsigned* st;
};

__device__ __forceinline__ XcdBarrier xcd_barrier_post(unsigned* bar, volatile LAS unsigned* st) {
    XcdBarrier b; b.bar = bar; b.x = xb_xcc_id(); b.st = st;
    if (threadIdx.x == 0) (void)xb_add(&bar[XB_XCNT(b.x)], 1u);
    return b;
}
__device__ __forceinline__ void xcd_barrier_complete(unsigned* bar, unsigned x, unsigned& nloc, unsigned& nx) {
    const unsigned G = gridDim.x * gridDim.y * gridDim.z;
    unsigned sum, cnt, mine, sp = 0u;
    for (;;) {
        sum = 0u; cnt = 0u; mine = 0u;
#pragma unroll
        for (unsigned j = 0; j < 16; ++j) { const unsigned c = xb_ld(&bar[XB_XCNT(j)]); sum += c; cnt += (c > 0u) ? 1u : 0u; mine = (j == x) ? c : mine; }
        if (sum == G) break;
        __builtin_amdgcn_s_sleep(1);
        if ((++sp & 255u) == 0u) { if (xb_ld(&bar[XB_TMO])) break; if (sp > XB_SPIN_CAP) { atomicAdd(&bar[XB_TMO], 1u); break; } }
    }
    nloc = mine > 0u ? mine : 1u; nx = cnt > 0u ? cnt : 1u;
}

__device__ __forceinline__ void xcd_barrier(const XcdBarrier& b) {
    asm volatile("s_waitcnt vmcnt(0)" ::: "memory");
    __syncthreads();
    if (opaque_tid() == 0) {
        unsigned* bar = b.bar; asm volatile("" : "+s"(bar)); unsigned bx = b.x; asm volatile("" : "+s"(bx));
        __builtin_amdgcn_s_waitcnt(0);
        unsigned nloc = b.st[0], nx = b.st[1];
        if (nloc == 0u) { xcd_barrier_complete(bar, bx, nloc, nx); b.st[0] = nloc; b.st[1] = nx; }
        const unsigned old = xb_add(&bar[XB_XSUB(bx)], 1u);
        const unsigned gen = old / nloc;
        if (old + 1u == (gen + 1u) * nloc) {
            __builtin_amdgcn_fence(__ATOMIC_RELEASE, "agent");
            asm volatile("s_waitcnt vmcnt(0)" ::: "memory");
            const unsigned og = xb_add(&bar[XB_TOP], 1u);
            const unsigned tg = og / nx;
            if (og + 1u == (tg + 1u) * nx) xb_add(&bar[XB_TOPGEN], 1u);
            else XB_SPIN(xb_ld(&bar[XB_TOPGEN]) == tg, bar);
            __builtin_amdgcn_fence(__ATOMIC_ACQUIRE, "agent");
            xb_add(&bar[XB_XGEN(bx)], 1u);
            asm volatile("s_waitcnt vmcnt(0)" ::: "memory");
        } else {
            XB_SPIN(xb_ld(&bar[XB_XGEN(bx)]) == gen, bar);
            __builtin_amdgcn_fence(__ATOMIC_ACQUIRE, "agent");
            asm volatile("s_waitcnt vmcnt(0)" ::: "memory");
        }
    }
    __syncthreads();
}


__device__ __forceinline__ void refresh_sample(const pg8::StaticOrder& S, const float* X, bf16_t* XBp, float* ssq) {
    bool own = false; pg8::Unit u;
    for (int i = 0; S.next(i, u); ++i) own = own || (u.pm == 64);
    if (!own) return;
    const int tid = opaque_tid(), lane = tid & 63, wid = __builtin_amdgcn_readfirstlane(tid >> 6);
    for (int hb = 0; hb < 2; ++hb) { const int r0 = MP + wid * 16 + hb * 8; f32x4 v[8][4];
#pragma unroll
        for (int i = 0; i < 8; ++i)
#pragma unroll
            for (int j = 0; j < 4; ++j) v[i][j] = ((const f32x4*)(X + (size_t)(r0 + i) * DM) + lane)[64 * j];
#pragma unroll
        for (int i = 0; i < 8; ++i) { u32x2* xb = (u32x2*)(XBp + (size_t)(r0 + i) * DM) + lane; float ss = 0.f;
#pragma unroll
            for (int j = 0; j < 4; ++j) { u32x2 w; w.x = pk2(v[i][j][0], v[i][j][1]); w.y = pk2(v[i][j][2], v[i][j][3]); xb[64 * j] = w; ss += (v[i][j][0] * v[i][j][0] + v[i][j][1] * v[i][j][1]) + (v[i][j][2] * v[i][j][2] + v[i][j][3] * v[i][j][3]); }
            ss = wave_sum(ss); if (lane == 0) ssq[r0 + i] = ss; } }
    __builtin_amdgcn_fence(__ATOMIC_RELEASE, "agent"); asm volatile("s_waitcnt vmcnt(0)" ::: "memory");
    __syncthreads();
    __builtin_amdgcn_fence(__ATOMIC_ACQUIRE, "agent"); asm volatile("s_waitcnt vmcnt(0)" ::: "memory");
    __syncthreads();
}

template <int NS> __device__ __forceinline__ void skinny_resid_unit(unsigned char* lds, const bf16_t* __restrict__ A, const bf16_t* __restrict__ Bt, int u, const float* Xs_in, float* X, bf16_t* XBp, float* ssq, float scale) {
    constexpr int K = NS * 32 * 8;
    const int tid = opaque_tid(), lane = tid & 63, wid = __builtin_amdgcn_readfirstlane(tid >> 6), fr = lane & 15, fq = lane >> 4;
    const int rb = u & 7, cb = u >> 3, k0 = wid * (K / 8);
    const bf16_t* ap = A + (size_t)(16 * rb + fr) * K + k0 + 8 * fq; const bf16_t* bp0 = Bt + (size_t)(32 * cb + fr) * K + k0 + 8 * fq; const bf16_t* bp1 = bp0 + (size_t)16 * K;
    bf16x8 a[NS], p[NS], q[NS];
#pragma unroll
    for (int i = 0; i < NS; ++i) { a[i] = *(const bf16x8*)(ap + 32 * i); p[i] = *(const bf16x8*)(bp0 + 32 * i); q[i] = *(const bf16x8*)(bp1 + 32 * i); }
    f32x4 acc0 = {0.f, 0.f, 0.f, 0.f}, acc1 = {0.f, 0.f, 0.f, 0.f};
#pragma unroll
    for (int i = 0; i < NS; ++i) { acc0 = __builtin_amdgcn_mfma_f32_16x16x32_bf16(p[i], a[i], acc0, 0, 0, 0); acc1 = __builtin_amdgcn_mfma_f32_16x16x32_bf16(q[i], a[i], acc1, 0, 0, 0); }
    float* red = (float*)lds;
#pragma unroll
    for (int e = 0; e < 4; ++e) { red[(wid * 8 + e) * 64 + lane] = acc0[e]; red[(wid * 8 + 4 + e) * 64 + lane] = acc1[e]; }
    __syncthreads();
    { const int r = tid >> 5, c = tid & 31, src = (4 * (c >> 4) + (c & 3)) * 64 + r + 16 * ((c & 15) >> 2);
      float sum = 0.f;
#pragma unroll
      for (int w = 0; w < 8; ++w) sum += red[w * 512 + src];
      const int row = MP + 16 * rb + r, col = 32 * cb + c;
      const float x = Xs_in[(size_t)(16 * rb + r) * DM + col] + scale * sum;
      X[(size_t)row * DM + col] = x; XBp[(size_t)row * DM + col] = (bf16_t)(pk2(x, 0.f) & 0xffff);
      float ss = x * x;
#pragma unroll
      for (int o = 1; o < 32; o <<= 1) ss += __shfl_xor(ss, o);
      if (c == 0) unsafeAtomicAdd(ssq + row, ss); }
    __syncthreads();
}
__global__ void __launch_bounds__(NTHR, 2) mega_fwd(Params P) {
    extern __shared__ __attribute__((aligned(16))) unsigned char lds[];
    cg::grid_group grid = cg::this_grid();
    if (gridDim.x == 0x7fffffffu) grid.sync();
    const int G = gridDim.x, bid = blockIdx.x;
    unsigned char* const ws = P.ws; float* const out = P.out;
    volatile LAS unsigned* bst = (volatile LAS unsigned*)((LAS unsigned char*)lds + LDS_BYTES - 64);
    if (threadIdx.x < 4) bst[threadIdx.x] = 0u;
    __syncthreads();
    const XcdBarrier xbar = xcd_barrier_post((unsigned*)ws, bst);
#define SSQ ((float*)(ws + WS_SSQ))
#define WSB ((bf16_t*)(ws + WS_WSB))
#define XB ((bf16_t*)(ws + WS_XB))
#define CAT ((bf16_t*)(ws + WS_CAT))
#define BIG ((bf16_t*)(ws + WS_BIG))
#define EIN ((bf16_t*)(ws + WS_EIN))
#define EOUT ((bf16_t*)(ws + WS_EOUT))
#define OIN ((bf16_t*)(ws + WS_OIN))
#define OOUT ((bf16_t*)(ws + WS_OOUT))
#define ldsa ((PG8_LAS unsigned char*)lds)
#define x_prompt P.in[0]
#define x_sample P.in[1]
#define cache_k P.in[2]
#define cache_v P.in[3]
#define cache_lf P.in[4]
#define st_sconv P.in[5]
#define st_cconv P.in[6]
#define ffn1_g P.in[7]
#define ffn1_wg P.in[8]
#define ffn1_wu P.in[9]
#define ffn1_wd P.in[10]
#define mix_g P.in[11]
#define ffn2_g P.in[12]
#define ffn2_wg P.in[13]
#define ffn2_wu P.in[14]
#define ffn2_wd P.in[15]
#define e_w_in P.in[16]
#define e_b_f P.in[17]
#define e_conv_w P.in[18]
#define e_w_out P.in[19]
#define o_w_in P.in[20]
#define o_ln_g P.in[21]
#define o_ln_b P.in[22]
#define o_ws P.in[23]
#define o_bs P.in[24]
#define o_dw P.in[25]
#define o_dw_b P.in[26]
#define o_cn_g P.in[27]
#define o_cn_b P.in[28]
#define o_w_out P.in[29]
#define final_g P.in[30]

    {
        const int tid = opaque_tid(), lane = tid & 63, wid = __builtin_amdgcn_readfirstlane(tid >> 6);
        const int gw = bid * NWAVES + wid, NGW = G * NWAVES, gt = bid * NTHR + tid, NGT = G * NTHR;
        float* scr = (float*)(lds + wid * 16640);
        int base = 0;
#define TR_JOB(SRC, GAIN, KK, NSRC, NBLK, DST, MODE) do { const int n_ = ((KK) / 64) * (NBLK); int first_ = (gw - base) % NGW; if (first_ < 0) first_ += NGW; \
        for (int it_ = first_; it_ < n_; it_ += NGW) tr_item((SRC), (GAIN), (KK), (NSRC), (NBLK), (DST), (MODE), scr, it_, lane); base += n_; } while (0)
#define FFN_JOBS(F_) do { const int f_ = (F_), l_ = f_ >> 1, second_ = f_ & 1; \
            const float* wg_ = (second_ ? ffn2_wg : ffn1_wg) + (size_t)l_ * DM * DFF; const float* wu_ = (second_ ? ffn2_wu : ffn1_wu) + (size_t)l_ * DM * DFF; const float* wd_ = (second_ ? ffn2_wd : ffn1_wd) + (size_t)l_ * DFF * DM; \
            const float* gn_ = (second_ ? ffn2_g : ffn1_g) + l_ * DM; \
            bf16_t* w1_ = (bf16_t*)(ws + WS_W1 + f_ * W1_BYTES); bf16_t* w2_ = (bf16_t*)(ws + WS_W2 + f_ * W2_BYTES); \
            TR_JOB(wg_, gn_, DM, DFF, DFF / 64, w1_, 1); TR_JOB(wu_, gn_, DM, DFF, DFF / 64, w1_, 2); TR_JOB(wd_, (const float*)nullptr, DFF, DM, DM / 64, w2_, 0); } while (0)
        FFN_JOBS(0);
        {
            const int rs_ = MP + gw; const bool has_s = rs_ < MROWS; f32x4 sv[4];
            if (has_s) { const f32x4* src = (const f32x4*)(x_sample + (size_t)(rs_ - MP) * DM) + lane;
#pragma unroll
                for (int j = 0; j < 4; ++j) sv[j] = src[64 * j]; }
            for (int r0 = gw * 4; r0 < MP; r0 += NGW * 4) { f32x4 v[4][4];
#pragma unroll
                for (int i = 0; i < 4; ++i) { const f32x4* src = (const f32x4*)(x_prompt + (size_t)(r0 + i) * DM) + lane;
#pragma unroll
                    for (int j = 0; j < 4; ++j) v[i][j] = src[64 * j]; }
#pragma unroll
                for (int i = 0; i < 4; ++i) { u32x2* xb = (u32x2*)(XB + (size_t)(r0 + i) * DM) + lane; float ss = 0.f;
#pragma unroll
                    for (int j = 0; j < 4; ++j) { u32x2 w; w.x = pk2(v[i][j][0], v[i][j][1]); w.y = pk2(v[i][j][2], v[i][j][3]); xb[64 * j] = w; ss += (v[i][j][0] * v[i][j][0] + v[i][j][1] * v[i][j][1]) + (v[i][j][2] * v[i][j][2] + v[i][j][3] * v[i][j][3]); }
                    ss = wave_sum(ss); if (lane == 0) SSQ[r0 + i] = ss; } }
            if (has_s) { u32x2* xb = (u32x2*)(XB + (size_t)rs_ * DM) + lane; float ss = 0.f;
#pragma unroll
                for (int j = 0; j < 4; ++j) { u32x2 w; w.x = pk2(sv[j][0], sv[j][1]); w.y = pk2(sv[j][2], sv[j][3]); xb[64 * j] = w; ss += (sv[j][0] * sv[j][0] + sv[j][1] * sv[j][1]) + (sv[j][2] * sv[j][2] + sv[j][3] * sv[j][3]); }
                ss = wave_sum(ss); if (lane == 0) SSQ[rs_] = ss; }
            for (int r = MP + gw + NGW; r < MROWS; r += NGW) {
                const f32x4* src = (const f32x4*)(x_sample + (size_t)(r - MP) * DM) + lane; u32x2* xb = (u32x2*)(XB + (size_t)r * DM) + lane; float ss = 0.f;
#pragma unroll
                for (int j = 0; j < 4; ++j) { const f32x4 v = src[64 * j]; u32x2 w; w.x = pk2(v[0], v[1]); w.y = pk2(v[2], v[3]); xb[64 * j] = w; ss += (v[0] * v[0] + v[1] * v[1]) + (v[2] * v[2] + v[3] * v[3]); }
                ss = wave_sum(ss); if (lane == 0) SSQ[r] = ss; }
            for (int r = MROWS + gw; r < MT; r += NGW) { u32x2* xb = (u32x2*)(XB + (size_t)r * DM) + lane;
#pragma unroll
                for (int j = 0; j < 4; ++j) xb[64 * j] = (u32x2){0u, 0u};
                if (lane == 0) SSQ[r] = 1024.f; }
        }
        for (int i = gt; i < 6 * MT; i += NGT) SSQ[MT + i] = 0.f;
        for (int i = gt; i < 8 * 128 * 128; i += NGT) { const int s = i & 127, t = (i >> 7) & 127; WSB[i] = (bf16_t)(pk2((s <= t) ? o_ws[i] : 0.f, 0.f) & 0xffff); }
    }
    xcd_barrier(xbar);

    for (int layer = 0; layer < 2; ++layer) {
        for (int f = 0; f < 2; ++f) {
            const int wi = layer * 2 + f, si = layer * 3 + (f ? 2 : 0);
            { pg8::Gemm g{XB, (const bf16_t*)(ws + WS_W1 + wi * W1_BYTES), MT, 2 * DFF, DM, DM}; pg8::StaticOrder S; S.init(MT, 2 * DFF, G, bid);
              pg8::EpiSwiglu E{SSQ + si * MT, BIG};
              pg8::gemm_phase<pg8::EpiSwiglu, pg8::StaticOrder, true, true>(ldsa, g, S, E); }
            if (wi < 3) {
                const int nheavy = (1430 > 5 * G && 1430 <= 6 * G) ? 1430 - 5 * G : 0;
                if (bid >= nheavy) {
                    const int tid = opaque_tid(), lane = tid & 63, wid = __builtin_amdgcn_readfirstlane(tid >> 6);
                    const int gw = (bid - nheavy) * NWAVES + wid, NGW = (G - nheavy) * NWAVES; float* scr = (float*)(lds + wid * 16640); int base = 0;
                    if (wi == 0) { TR_JOB(e_w_in, mix_g, DM, 3080, 3328 / 64, EIN, 0); TR_JOB(e_w_out, (const float*)nullptr, DM, DM, DM / 64, EOUT, 0); FFN_JOBS(1); }
                    else if (wi == 1) { FFN_JOBS(2); }
                    else { TR_JOB(o_w_in, mix_g + DM, DM, 2048, 2048 / 64, OIN, 3); TR_JOB(o_w_out, (const float*)nullptr, DM, DM, DM / 64, OOUT, 0); FFN_JOBS(3); }
                }
            }
            xcd_barrier(xbar);
            { pg8::Gemm g{BIG, (const bf16_t*)(ws + WS_W2 + wi * W2_BYTES), MP, DM, DFF, DFF}; pg8::StaticOrder S; S.init(MP, DM, G, bid);
              pg8::EpiResid E{(wi == 0) ? x_prompt : (const float*)out, out, XB, SSQ + (si + 1) * MT, 0.5f};
              pg8::gemm_phase<pg8::EpiResid, pg8::StaticOrder, true, true>(ldsa, g, S, E); }
            for (int u = bid; u < 256; u += G) skinny_resid_unit<11>(lds, BIG + (size_t)MP * DFF, (const bf16_t*)(ws + WS_W2 + wi * W2_BYTES), u, (wi == 0) ? x_sample : (const float*)(out + O_YS), out, XB, SSQ + (si + 1) * MT, 0.5f);
            xcd_barrier(xbar);
            if (f == 1) break;
            if (layer == 0) {
                { pg8::Gemm g{XB, EIN, MT, 3328, DM, DM}; pg8::StaticOrder S; S.init(MT, 3328, G, bid);
                  pg8::EpiEvenIn E{SSQ + 1 * MT, BIG, out + O_PK, out + O_PV, out + O_PLF, out + O_SK, out + O_SV, out + O_SLF, e_b_f};
                  pg8::gemm_phase<pg8::EpiEvenIn, pg8::StaticOrder, true, true>(ldsa, g, S, E); }
                xcd_barrier(xbar);
                #ifndef NO_CONVA
                for (int it = bid; it < 258; it += G) conva_item(it, BIG, e_conv_w, st_sconv, CAT, out);
#endif
#ifndef NO_PATTN
                for (int u = bid; u < 256; u += G) { const int bh = u >> 2, role = u & 3, ab = bh >> 3, ah = bh & 7;
                    if (role == 0) attn_sample_unit(lds, ab, ah, BIG, cache_k, cache_v, cache_lf, out + O_SK, out + O_SV, out + O_SLF, CAT);
                    const int nq = (role == 3) ? 3 : (role == 0) ? 1 : 2, qlist = (role == 0) ? 0x5 : (role == 1) ? 0x17 : (role == 2) ? 0x26 : 0x034;
                    for (int i = 0; i < nq; ++i) attn_prompt_unit(lds, ab, ah, (qlist >> (4 * i)) & 15, BIG, out + O_PLF, CAT); }
#endif
                xcd_barrier(xbar);
                { pg8::Gemm g{CAT, EOUT, MP, DM, DM, DM}; pg8::StaticOrder S; S.init(MP, DM, G, bid);
                  pg8::EpiResid E{out, out, XB, SSQ + 2 * MT, 1.0f};
                  pg8::gemm_phase<pg8::EpiResid, pg8::StaticOrder, true, true>(ldsa, g, S, E); }
                for (int u = bid; u < 256; u += G) skinny_resid_unit<4>(lds, CAT + (size_t)MP * DM, EOUT, u, out + O_YS, out, XB, SSQ + 2 * MT, 1.0f);
                xcd_barrier(xbar);
            } else {
                { pg8::Gemm g{XB, OIN, MT, 2048, DM, DM}; pg8::StaticOrder S; S.init(MT, 2048, G, bid);
                  pg8::EpiOddIn E{SSQ + 4 * MT, BIG};
                  pg8::gemm_phase<pg8::EpiOddIn, pg8::StaticOrder, true, true>(ldsa, g, S, E); }
                xcd_barrier(xbar);
#ifndef NO_CCONV
                for (int u = bid; u < 256; u += G) cconv_unit<false>(lds, 64 * u, 0, BIG, o_dw, o_dw_b, o_cn_g, o_cn_b, st_cconv, CAT);
                for (int u = bid; u < 8; u += G) cconv_unit<true>(lds, MP + 16 * u, u, BIG, o_dw, o_dw_b, o_cn_g, o_cn_b, st_cconv, CAT);
#endif
#ifndef NO_GMLP
                for (int u = bid; u < 256; u += G) gmlp_unit(lds, 128 * (u >> 1), u & 1, false, 0, BIG, WSB, o_ln_g, o_ln_b, o_bs, CAT, out);
                for (int u = bid - 8; u < 8; u += G) if (u >= 0) gmlp_sample_unit(lds, u, BIG, WSB, o_ln_g, o_ln_b, o_bs, CAT, out);
#endif
                for (int i = bid * NTHR + opaque_tid(); i < 8 * 30 * 512; i += G * NTHR) { const int c = i & 511, j = (i >> 9) % 30, b = i / (30 * 512);
                    out[O_PCC + i] = bf2f(BIG[(size_t)(b * 2048 + 2018 + j) * 1536 + 1024 + c]);
                    out[O_SCC + i] = (j < 14) ? st_cconv[(size_t)(b * 30 + 16 + j) * 512 + c] : bf2f(BIG[(size_t)(MP + 16 * b + j - 14) * 1536 + 1024 + c]); }
                xcd_barrier(xbar);
                { pg8::Gemm g{CAT, OOUT, MP, DM, DM, DM}; pg8::StaticOrder S; S.init(MP, DM, G, bid);
                  pg8::EpiResid E{out, out, XB, SSQ + 5 * MT, 1.0f};
                  pg8::gemm_phase<pg8::EpiResid, pg8::StaticOrder, true, true>(ldsa, g, S, E); }
                for (int u = bid; u < 256; u += G) skinny_resid_unit<4>(lds, CAT + (size_t)MP * DM, OOUT, u, out + O_YS, out, XB, SSQ + 5 * MT, 1.0f);
                xcd_barrier(xbar);
            }
        }
    }
    const int ftid = opaque_tid(), lane = ftid & 63;
    { const int gwf = bid * NWAVES + (ftid >> 6), NGWF = G * NWAVES; const f32x4* gp = (const f32x4*)final_g + lane;
      f32x4 gv[4];
#pragma unroll
      for (int j = 0; j < 4; ++j) gv[j] = gp[64 * j];
      const int rs_ = MP + gwf; const bool has_s = rs_ < MROWS; f32x4 sv[4];
      if (has_s) {
#pragma unroll
        for (int j = 0; j < 4; ++j) sv[j] = ((const f32x4*)(out + (size_t)rs_ * DM) + lane)[64 * j]; }
      for (int r0 = gwf * 4; r0 < MP; r0 += NGWF * 4) {
        f32x4 v[4][4];
#pragma unroll
        for (int i = 0; i < 4; ++i)
#pragma unroll
            for (int j = 0; j < 4; ++j) v[i][j] = ((const f32x4*)(out + (size_t)(r0 + i) * DM) + lane)[64 * j];
#pragma unroll
        for (int i = 0; i < 4; ++i) { float ss = 0.f;
#pragma unroll
            for (int j = 0; j < 4; ++j) ss += (v[i][j][0] * v[i][j][0] + v[i][j][1] * v[i][j][1]) + (v[i][j][2] * v[i][j][2] + v[i][j][3] * v[i][j][3]);
            const float rs = __builtin_amdgcn_rsqf(wave_sum(ss) * (1.0f / 1024.0f) + RMS_EPS);
#pragma unroll
            for (int j = 0; j < 4; ++j) ((f32x4*)(out + (size_t)(r0 + i) * DM) + lane)[64 * j] = v[i][j] * rs * gv[j]; } }
      if (has_s) { float ss = 0.f;
#pragma unroll
        for (int j = 0; j < 4; ++j) ss += (sv[j][0] * sv[j][0] + sv[j][1] * sv[j][1]) + (sv[j][2] * sv[j][2] + sv[j][3] * sv[j][3]);
        const float rs = __builtin_amdgcn_rsqf(wave_sum(ss) * (1.0f / 1024.0f) + RMS_EPS);
#pragma unroll
        for (int j = 0; j < 4; ++j) ((f32x4*)(out + (size_t)rs_ * DM) + lane)[64 * j] = sv[j] * rs * gv[j]; }
      for (int r = MP + gwf + NGWF; r < MROWS; r += NGWF) { f32x4 v[4]; float ss = 0.f;
#pragma unroll
        for (int j = 0; j < 4; ++j) { v[j] = ((const f32x4*)(out + (size_t)r * DM) + lane)[64 * j]; ss += (v[j][0] * v[j][0] + v[j][1] * v[j][1]) + (v[j][2] * v[j][2] + v[j][3] * v[j][3]); }
        const float rs = __builtin_amdgcn_rsqf(wave_sum(ss) * (1.0f / 1024.0f) + RMS_EPS);
#pragma unroll
        for (int j = 0; j < 4; ++j) ((f32x4*)(out + (size_t)r * DM) + lane)[64 * j] = v[j] * rs * gv[j]; } }
}

extern "C" void kernel_launch(void* const* d_in, const int* in_sizes, int n_in, void* d_out, int out_size, void* d_ws, size_t ws_size, hipStream_t stream) {
    static int grid = 0;
    if (grid == 0) {
        if (n_in != 31 || (size_t)out_size != O_END || ws_size < WS_END) { fprintf(stderr, "kernel_launch: unexpected sizes n_in %d out %d ws %zu\n", n_in, out_size, ws_size); grid = -1; return; }
        int dev = 0, cus = 0, per_cu = 0;
        hipGetDevice(&dev); hipDeviceGetAttribute(&cus, hipDeviceAttributeMultiprocessorCount, dev);
        if (hipFuncSetAttribute((const void*)mega_fwd, hipFuncAttributeMaxDynamicSharedMemorySize, LDS_BYTES) != hipSuccess) { fprintf(stderr, "hipFuncSetAttribute failed\n"); grid = -1; return; }
        hipOccupancyMaxActiveBlocksPerMultiprocessor(&per_cu, (const void*)mega_fwd, NTHR, LDS_BYTES);
        if (per_cu < 1) { fprintf(stderr, "occupancy query says %d blocks/CU\n", per_cu); per_cu = 1; }
        (void)hipGetLastError();
        grid = cus;
    }
    if (grid < 0) return;
    Params p{};
    for (int i = 0; i < 31; ++i) p.in[i] = (const float*)d_in[i];
    p.out = (float*)d_out; p.ws = (unsigned char*)d_ws;
    if (hipMemsetAsync(d_ws, 0, 16384, stream) != hipSuccess) { fprintf(stderr, "memset failed\n"); return; }
    void* args[] = {&p};
    hipError_t e = hipLaunchCooperativeKernel((const void*)mega_fwd, dim3(grid), dim3(NTHR), args, LDS_BYTES, stream);
    if (e != hipSuccess) fprintf(stderr, "cooperative launch failed: %s (grid %d)\n", hipGetErrorString(e), grid);
}
```

```cpp
#include <hip/hip_runtime.h>
#include <hip/hip_cooperative_groups.h>
#include <cstdio>
#include <cstdint>
namespace cg = cooperative_groups;
__device__ __forceinline__ int opaque_tid() { int t = threadIdx.x; asm volatile("" : "+v"(t)); return t; }
namespace pg8 {
#define PG8_LAS __attribute__((address_space(3)))
typedef unsigned short bf16_t;
typedef short bf16x8 __attribute__((ext_vector_type(8)));
typedef float f32x4 __attribute__((ext_vector_type(4)));
typedef unsigned u32x4 __attribute__((ext_vector_type(4)));
constexpr int BM = 256, BK = 64, HALF = 128, HTB = HALF * BK * 2  , STAGE_BYTES = 8 * HTB, NXCD = 8, WGM = 8;

__host__ __device__ __forceinline__ int lds_byte(int r, int c) { const int st = (r >> 4) * 2 + (c >> 5), rr = r & 15, cc = c & 31, ob = rr * 64 + cc * 2; return st * 1024 + (ob ^ (((ob >> 9) & 1) << 5)); }
__host__ __device__ __forceinline__ void stage_rc(int b, int& R, int& C) { const int st = b / 1024, sb = b % 1024, swz = sb ^ (((sb >> 9) & 1) << 5); R = (st >> 1) * 16 + swz / 64; C = (st & 1) * 32 + (swz % 64) / 2; }
__host__ __device__ __forceinline__ int perm32(int rho) { const int n = rho >> 4, i = rho & 15; return 8 * (i >> 2) + 4 * n + (i & 3); }

struct Unit { int pm, pn; int koff = 0; };
struct Gemm { const bf16_t* A; const bf16_t* Bt; int M, N, K; int KL; };

struct StaticOrder {
    int nM, nN, nwg, G, c;
    __host__ __device__ void init(int M, int N, int G_, int c_) { nM = M / BM; nN = N / BM; nwg = nM * nN; G = G_; c = c_; }
    __host__ __device__ bool next(int i, Unit& u) const {
        const long L = (long)i * G + c; if (L >= nwg) return false;
        int wgid = (int)L; { const int q = nwg / NXCD, r = nwg % NXCD, xcd = wgid % NXCD, off = wgid / NXCD; wgid = (xcd < r ? xcd * (q + 1) : r * (q + 1) + (xcd - r) * q) + off; }
        const int nig = WGM * nN, gid = wgid / nig, fm = gid * WGM, gsz = (nM - fm) < WGM ? (nM - fm) : WGM;
        u.pm = fm + ((wgid % nig) % gsz); u.pn = (wgid % nig) / gsz; u.koff = 0; return true;
    }
    __device__ __forceinline__ void a_ready(const Unit&) const {}
    __device__ __forceinline__ void done(const Unit&) const {}
};

typedef float f32x2 __attribute__((ext_vector_type(2)));
typedef __bf16 bf16x2_t __attribute__((ext_vector_type(2)));
__device__ __forceinline__ unsigned pk2(float lo, float hi) { f32x2 v = {lo, hi}; bf16x2_t b = __builtin_convertvector(v, bf16x2_t); return __builtin_bit_cast(unsigned, b); }
__device__ __forceinline__ u32x4 pk8(f32x4 a, f32x4 b) { u32x4 w; w.x = pk2(a[0], a[1]); w.y = pk2(a[2], a[3]); w.z = pk2(b[0], b[1]); w.w = pk2(b[2], b[3]); return w; }
__device__ __forceinline__ float fast_exp(float x) { return __builtin_amdgcn_exp2f(x * 1.4426950408889634f); }
__device__ __forceinline__ float sigmoidf_(float x) { return __builtin_amdgcn_rcpf(1.0f + fast_exp(-x)); }
__device__ __forceinline__ float siluf_(float x) { return x * sigmoidf_(x); }
__device__ __forceinline__ float gelu_tanh(float x) { const float u = 1.5957691216057308f * (x + 0.044715f * x * x * x); return x * sigmoidf_(u); }
constexpr int MROWS = 16512;
constexpr float RMS_EPS = 1e-6f;

struct EpiSwiglu {
    static constexpr bool PERM = true, AFTER_DRAIN = false;
    const float* ssq; bf16_t* O;
    __device__ __forceinline__ void operator()(const f32x4 (&acc)[2][2][4][2], const Unit& u, int wr, int wc, int fr, int fq) const {
        const int row0 = u.pm * BM + wr * 64 + fr, col0 = u.pn * 128 + wc * 32 + 8 * fq;
        float rsv[8];
#pragma unroll
        for (int i = 0; i < 8; ++i) rsv[i] = ssq[row0 + (i >> 2) * HALF + (i & 3) * 16];
#pragma unroll
        for (int i = 0; i < 8; ++i) rsv[i] = __builtin_amdgcn_rsqf(rsv[i] * (1.0f / 1024.0f) + RMS_EPS);
#pragma unroll
        for (int ai = 0; ai < 2; ++ai)
#pragma unroll
            for (int m = 0; m < 4; ++m) { const int row = row0 + ai * HALF + m * 16; const float rs = rsv[ai * 4 + m];
                f32x4 o0, o1;
#pragma unroll
                for (int e = 0; e < 4; ++e) { o0[e] = siluf_(acc[ai][0][m][0][e] * rs) * (acc[ai][1][m][0][e] * rs); o1[e] = siluf_(acc[ai][0][m][1][e] * rs) * (acc[ai][1][m][1][e] * rs); }
                *(u32x4*)(O + (size_t)row * 2816 + col0) = pk8(o0, o1); }
    }
};
struct EpiResid {
    static constexpr bool PERM = true, AFTER_DRAIN = false;
    const float* Xin; float* X; bf16_t* XB; float* ssq_out; float scale;
    __device__ __forceinline__ void operator()(const f32x4 (&acc)[2][2][4][2], const Unit& u, int wr, int wc, int fr, int fq) const {
        const int row0 = u.pm * BM + wr * 64 + fr, col0 = u.pn * BM + wc * 32 + 8 * fq;
#pragma unroll
        for (int ai = 0; ai < 2; ++ai) {
            f32x4 xv[4][2][2];
#pragma unroll
            for (int m = 0; m < 4; ++m) { const int row = row0 + ai * HALF + m * 16; const bool valid = row < MROWS;
#pragma unroll
                for (int bj = 0; bj < 2; ++bj) { const float* xi = Xin + (size_t)row * 1024 + col0 + bj * HALF;
                    xv[m][bj][0] = valid ? *(const f32x4*)xi : (f32x4){0.f, 0.f, 0.f, 0.f}; xv[m][bj][1] = valid ? *(const f32x4*)(xi + 4) : (f32x4){0.f, 0.f, 0.f, 0.f}; } }
            asm volatile("" ::: "memory");
#pragma unroll
            for (int m = 0; m < 4; ++m) { const int row = row0 + ai * HALF + m * 16; const bool valid = row < MROWS; float ss = 0.f;
#pragma unroll
                for (int bj = 0; bj < 2; ++bj) { float* xp = X + (size_t)row * 1024 + col0 + bj * HALF;
                    const f32x4 x0 = xv[m][bj][0] + acc[ai][bj][m][0] * scale, x1 = xv[m][bj][1] + acc[ai][bj][m][1] * scale;
                    if (valid) { *(f32x4*)xp = x0; *(f32x4*)(xp + 4) = x1; }
                    *(u32x4*)(XB + (size_t)row * 1024 + col0 + bj * HALF) = pk8(x0, x1);
                    ss += (x0[0] * x0[0] + x0[1] * x0[1]) + (x0[2] * x0[2] + x0[3] * x0[3]) + (x1[0] * x1[0] + x1[1] * x1[1]) + (x1[2] * x1[2] + x1[3] * x1[3]); }
                ss += __shfl_xor(ss, 16); ss += __shfl_xor(ss, 32);
                if (fq == 0) unsafeAtomicAdd(ssq_out + row, ss); }
            asm volatile("" ::: "memory");
        }
    }
};
constexpr float QSCALE = 0.125f * 1.4426950408889634f;
struct EpiEvenIn {
    static constexpr bool PERM = true, AFTER_DRAIN = false;
    const float* ssq; bf16_t* ZB; float* pk_; float* pv_; float* plf; float* sk_; float* sv_; float* slf; const float* b_f;
    __device__ __forceinline__ void operator()(const f32x4 (&acc)[2][2][4][2], const Unit& u, int wr, int wc, int fr, int fq) const {
        const int row0 = u.pm * BM + wr * 64 + fr, pn = u.pn, lc = wc * 32 + 8 * fq;
        float rsv[8];
#pragma unroll
        for (int i = 0; i < 8; ++i) rsv[i] = ssq[row0 + (i >> 2) * HALF + (i & 3) * 16];
#pragma unroll
        for (int i = 0; i < 8; ++i) rsv[i] = __builtin_amdgcn_rsqf(rsv[i] * (1.0f / 1024.0f) + RMS_EPS);
#pragma unroll
        for (int ai = 0; ai < 2; ++ai)
#pragma unroll
            for (int m = 0; m < 4; ++m) { const int row = row0 + ai * HALF + m * 16; const float rs = rsv[ai * 4 + m];
                if (pn < 12) {
                    const float sc = (pn == 6 || pn == 7) ? rs * QSCALE : rs;
#pragma unroll
                    for (int bj = 0; bj < 2; ++bj) { const int col = pn * BM + bj * HALF + lc; const f32x4 v0 = acc[ai][bj][m][0] * sc, v1 = acc[ai][bj][m][1] * sc;
                        *(u32x4*)(ZB + (size_t)row * 3072 + col) = pk8(v0, v1);
                        if (pn >= 8 && row < MROWS) { const int cc = (pn >= 10) ? col - 2560 : col - 2048;
                            float* dst = (row < 16384) ? ((pn >= 10 ? pv_ : pk_) + (size_t)row * 512 + cc) : ((pn >= 10 ? sv_ : sk_) + (size_t)(row - 16384) * 512 + cc);
                            *(f32x4*)dst = v0; *(f32x4*)(dst + 4) = v1; } }
                } else if (wc == 0 && fq == 0 && row < MROWS) {
                    float* dst = (row < 16384) ? plf + (size_t)row * 8 : slf + (size_t)(row - 16384) * 8; f32x4 o0, o1;
#pragma unroll
                    for (int e = 0; e < 4; ++e) { const float a = acc[ai][0][m][0][e] * rs + b_f[e], b = acc[ai][0][m][1][e] * rs + b_f[4 + e];
                        o0[e] = fminf(a, 0.f) - log1pf(__expf(-fabsf(a))); o1[e] = fminf(b, 0.f) - log1pf(__expf(-fabsf(b))); }
                    *(f32x4*)dst = o0; *(f32x4*)(dst + 4) = o1; }
            }
    }
};
struct EpiOddIn {
    static constexpr bool PERM = true, AFTER_DRAIN = false;
    const float* ssq; bf16_t* ZO;
    __device__ __forceinline__ void operator()(const f32x4 (&acc)[2][2][4][2], const Unit& u, int wr, int wc, int fr, int fq) const {
        const int row0 = u.pm * BM + wr * 64 + fr, pn = u.pn, lc = wc * 32 + 8 * fq;
        float rsv[8];
#pragma unroll
        for (int i = 0; i < 8; ++i) rsv[i] = ssq[row0 + (i >> 2) * HALF + (i & 3) * 16];
#pragma unroll
        for (int i = 0; i < 8; ++i) rsv[i] = __builtin_amdgcn_rsqf(rsv[i] * (1.0f / 1024.0f) + RMS_EPS);
#pragma unroll
        for (int ai = 0; ai < 2; ++ai)
#pragma unroll
            for (int m = 0; m < 4; ++m) { const int row = row0 + ai * HALF + m * 16; const float rs = rsv[ai * 4 + m];
                if (pn < 4) {
#pragma unroll
                    for (int bj = 0; bj < 2; ++bj) { f32x4 v0, v1;
#pragma unroll
                        for (int e = 0; e < 4; ++e) { v0[e] = gelu_tanh(acc[ai][bj][m][0][e] * rs); v1[e] = gelu_tanh(acc[ai][bj][m][1][e] * rs); }
                        *(u32x4*)(ZO + (size_t)row * 1536 + pn * BM + bj * HALF + lc) = pk8(v0, v1); }
                } else { f32x4 v0, v1;
#pragma unroll
                    for (int e = 0; e < 4; ++e) { v0[e] = acc[ai][0][m][0][e] * rs * sigmoidf_(acc[ai][1][m][0][e] * rs); v1[e] = acc[ai][0][m][1][e] * rs * sigmoidf_(acc[ai][1][m][1][e] * rs); }
                    *(u32x4*)(ZO + (size_t)row * 1536 + 1024 + (pn - 4) * HALF + lc) = pk8(v0, v1); }
            }
    }
};

struct ChunkOrder {
    int c, nchunk;
    __device__ __forceinline__ bool next(int i, Unit& u) const { if (i > 0 || c >= nchunk) return false; u.pm = 64; u.pn = c & 3; u.koff = (c >> 2) * 512; return true; }
    __device__ __forceinline__ void a_ready(const Unit&) const {}
    __device__ __forceinline__ void done(const Unit&) const {}
};
struct EpiAtomX {
    static constexpr bool PERM = true, AFTER_DRAIN = false;
    float* X; float scale;
    __device__ __forceinline__ void operator()(const f32x4 (&acc)[2][2][4][2], const Unit& u, int wr, int wc, int fr, int fq) const {
        const int row0 = u.pm * BM + wr * 64 + fr, col0 = u.pn * BM + wc * 32 + 8 * fq;
#pragma unroll
        for (int m = 0; m < 4; ++m) { const int row = row0 + m * 16;
#pragma unroll
            for (int bj = 0; bj < 2; ++bj) { float* xp = X + (size_t)row * 1024 + col0 + bj * HALF;
#pragma unroll
                for (int e = 0; e < 4; ++e) { unsafeAtomicAdd(xp + e, acc[0][bj][m][0][e] * scale); unsafeAtomicAdd(xp + 4 + e, acc[0][bj][m][1][e] * scale); } } }
    }
};
template <class Epi, class Sched, bool ALIGN_EPI = false, bool SP2 = false>
__device__ __forceinline__ void gemm_phase(PG8_LAS unsigned char* lds, const Gemm g, const Sched& S, const Epi& E) {
    const int tid = opaque_tid(), wid = __builtin_amdgcn_readfirstlane(tid >> 6), lane = tid & 63, wr = wid >> 2, wc = wid & 3, fr = lane & 15, fq = lane >> 4;
    const int K = g.K, nt = g.KL / BK;
    unsigned voffA[2], voffB[2];
#pragma unroll
    for (int i = 0; i < 2; ++i) { int R, C; stage_rc(tid * 16 + i * 8192, R, C); const int Rb = Epi::PERM ? ((R & ~31) + perm32(R & 31)) : R;
        voffA[i] = (unsigned)(R * K + C) * 2u; voffB[i] = (unsigned)(Rb * K + C) * 2u; }
    const size_t kstep = (size_t)(BK * 2);
    const size_t hstep = (size_t)HALF * K * 2;
    const size_t tstep = 2 * hstep;
    const unsigned ldsw = (unsigned)wid * 1024u;
    const int aoff = lds_byte(wr * 64 + fr, fq * 8), boff = lds_byte(wc * 32 + fr, fq * 8);
#define PG8_SA(b, h) (((b) * 2 + (h)) * HTB)
#define PG8_SB(b, h) ((4 + (b) * 2 + (h)) * HTB)
#define PG8_STAGE(bufoff, gbase, voff) do { _Pragma("unroll") for (int _i = 0; _i < 2; ++_i) \
        __builtin_amdgcn_global_load_lds((const unsigned*)((const char*)(gbase) + (voff)[_i]), (PG8_LAS unsigned*)(lds + (bufoff) + ldsw + _i * 8192), 16, 0, 0); } while (0)
#define PG8_LDA(dst, b, h) do { _Pragma("unroll") for (int m = 0; m < 4; ++m) _Pragma("unroll") for (int k = 0; k < 2; ++k) dst[m][k] = *(const PG8_LAS bf16x8*)(lds + PG8_SA(b, h) + aoff + m * 2048 + k * 1024); } while (0)
#define PG8_LDB(dst, b, h) do { _Pragma("unroll") for (int n = 0; n < 2; ++n) _Pragma("unroll") for (int k = 0; k < 2; ++k) dst[n][k] = *(const PG8_LAS bf16x8*)(lds + PG8_SB(b, h) + boff + n * 2048 + k * 1024); } while (0)
#define PG8_MMA(ai, bj, At, Bt) do { __builtin_amdgcn_s_setprio(1); _Pragma("unroll") for (int m = 0; m < 4; ++m) _Pragma("unroll") for (int n = 0; n < 2; ++n) _Pragma("unroll") for (int k = 0; k < 2; ++k) \
        acc[ai][bj][m][n] = __builtin_amdgcn_mfma_f32_16x16x32_bf16(Bt[n][k], At[m][k], acc[ai][bj][m][n], 0, 0, 0); __builtin_amdgcn_s_setprio(0); } while (0)
#define PG8_WAIT_V(n) asm volatile("s_waitcnt vmcnt(" #n ")" ::: "memory")
#define PG8_WAIT_L(n) asm volatile("s_waitcnt lgkmcnt(" #n ")" ::: "memory")
#define PG8_BAR __builtin_amdgcn_s_barrier()
#define PG8_SCHED __builtin_amdgcn_sched_barrier(0)
    Unit cur, nxt; int ui = 0;
    if (!S.next(0, cur)) return;
    f32x4 acc[2][2][4][2];
#pragma unroll
    for (int a = 0; a < 2; ++a)
#pragma unroll
        for (int b = 0; b < 2; ++b)
#pragma unroll
            for (int m = 0; m < 4; ++m)
#pragma unroll
                for (int n = 0; n < 2; ++n) acc[a][b][m][n] = (f32x4){0.f, 0.f, 0.f, 0.f};
    bf16x8 At[4][2], B0[2][2], B1[2][2];
    const char* cA = (const char*)g.A + (size_t)cur.pm * tstep + cur.koff; const char* cB = (const char*)g.Bt + (size_t)cur.pn * tstep + cur.koff;
    S.a_ready(cur);
    if constexpr (SP2) {
        PG8_STAGE(PG8_SB(0, 0), cB, voffB); PG8_STAGE(PG8_SB(0, 1), cB + hstep, voffB); PG8_STAGE(PG8_SA(0, 0), cA, voffA); PG8_STAGE(PG8_SA(0, 1), cA + hstep, voffA);
        if (wr == 1) PG8_BAR;
        PG8_WAIT_V(2); PG8_BAR;
        PG8_STAGE(PG8_SB(1, 0), cB + kstep, voffB); PG8_STAGE(PG8_SA(1, 0), cA + kstep, voffA); PG8_STAGE(PG8_SB(1, 1), cB + hstep + kstep, voffB);
        PG8_WAIT_V(6); PG8_BAR;
    } else {
        PG8_STAGE(PG8_SB(0, 0), cB, voffB); PG8_STAGE(PG8_SA(0, 0), cA, voffA); PG8_STAGE(PG8_SB(0, 1), cB + hstep, voffB); PG8_STAGE(PG8_SA(0, 1), cA + hstep, voffA);
        if (wr == 1) PG8_BAR;
        PG8_WAIT_V(4); PG8_BAR;
        PG8_STAGE(PG8_SB(1, 0), cB + kstep, voffB); PG8_STAGE(PG8_SA(1, 0), cA + kstep, voffA); PG8_STAGE(PG8_SB(1, 1), cB + hstep + kstep, voffB);
        PG8_WAIT_V(6); PG8_BAR;
    }
    for (;;) {
        const bool has_next = S.next(ui + 1, nxt);
        const char* nA = has_next ? (const char*)g.A + (size_t)nxt.pm * tstep + nxt.koff : cA; const char* nB = has_next ? (const char*)g.Bt + (size_t)nxt.pn * tstep + nxt.koff : cB;
        for (int t = 0; t < nt; t += 2) {
            const bool last = (t == nt - 2);
            const char* a1 = cA + (size_t)(t + 1) * kstep;
            const char* a2 = last ? nA : cA + (size_t)(t + 2) * kstep; const char* b2 = last ? nB : cB + (size_t)(t + 2) * kstep;
            const char* a3 = a2 + kstep; const char* b3 = b2 + kstep;
            if (last && has_next) S.a_ready(nxt);
            if constexpr (SP2) {
            PG8_LDB(B0, 0, 0); PG8_LDB(B1, 0, 1); PG8_SCHED; PG8_LDA(At, 0, 0); PG8_STAGE(PG8_SA(1, 1), a1 + hstep, voffA);
            PG8_WAIT_V(8); PG8_WAIT_L(0); PG8_BAR; PG8_MMA(0, 0, At, B0); PG8_MMA(0, 1, At, B1); PG8_BAR; PG8_SCHED;
            PG8_LDA(At, 0, 1); PG8_STAGE(PG8_SB(0, 0), b2, voffB); PG8_STAGE(PG8_SB(0, 1), b2 + hstep, voffB); PG8_STAGE(PG8_SA(0, 0), a2, voffA);
            PG8_WAIT_V(8); PG8_WAIT_L(0); PG8_BAR; PG8_MMA(1, 0, At, B0); PG8_MMA(1, 1, At, B1); PG8_BAR; PG8_SCHED;
            PG8_LDB(B0, 1, 0); PG8_LDB(B1, 1, 1); PG8_SCHED; PG8_LDA(At, 1, 0); PG8_STAGE(PG8_SA(0, 1), a2 + hstep, voffA);
            PG8_WAIT_V(8); PG8_WAIT_L(0); PG8_BAR; PG8_MMA(0, 0, At, B0); PG8_MMA(0, 1, At, B1); PG8_BAR; PG8_SCHED;
            PG8_LDA(At, 1, 1); PG8_STAGE(PG8_SB(1, 0), b3, voffB); PG8_STAGE(PG8_SB(1, 1), b3 + hstep, voffB); PG8_STAGE(PG8_SA(1, 0), a3, voffA);
            PG8_WAIT_V(8); PG8_WAIT_L(0); PG8_BAR; PG8_MMA(1, 0, At, B0); PG8_MMA(1, 1, At, B1); PG8_BAR; PG8_SCHED;
            } else {
            PG8_LDB(B0, 0, 0); PG8_SCHED; PG8_LDA(At, 0, 0); PG8_STAGE(PG8_SA(1, 1), a1 + hstep, voffA);
            PG8_WAIT_L(8); PG8_BAR; PG8_WAIT_L(0); PG8_MMA(0, 0, At, B0); PG8_BAR; PG8_SCHED;
            PG8_LDB(B1, 0, 1); PG8_STAGE(PG8_SB(0, 0), b2, voffB);
            PG8_BAR; PG8_WAIT_L(0); PG8_MMA(0, 1, At, B1); PG8_BAR;
            PG8_LDA(At, 0, 1); PG8_STAGE(PG8_SA(0, 0), a2, voffA);
            PG8_BAR; PG8_WAIT_L(0); PG8_MMA(1, 0, At, B0); PG8_BAR; PG8_SCHED;
            PG8_STAGE(PG8_SB(0, 1), b2 + hstep, voffB);
            PG8_WAIT_V(6); PG8_BAR; PG8_MMA(1, 1, At, B1); PG8_BAR;
            PG8_LDB(B0, 1, 0); PG8_SCHED; PG8_LDA(At, 1, 0); PG8_STAGE(PG8_SA(0, 1), a2 + hstep, voffA);
            PG8_WAIT_L(8); PG8_BAR; PG8_WAIT_L(0); PG8_MMA(0, 0, At, B0); PG8_BAR; PG8_SCHED;
            PG8_LDB(B1, 1, 1); PG8_STAGE(PG8_SB(1, 0), b3, voffB);
            PG8_BAR; PG8_WAIT_L(0); PG8_MMA(0, 1, At, B1); PG8_BAR;
            PG8_LDA(At, 1, 1); PG8_STAGE(PG8_SA(1, 0), a3, voffA);
            PG8_BAR; PG8_WAIT_L(0); PG8_MMA(1, 0, At, B0); PG8_BAR; PG8_SCHED;
            PG8_STAGE(PG8_SB(1, 1), b3 + hstep, voffB);
            PG8_WAIT_V(6); PG8_BAR; PG8_MMA(1, 1, At, B1); PG8_BAR;
            }
        }
        if constexpr (ALIGN_EPI) { if (wr == 0) PG8_BAR; }
        if constexpr (!Epi::AFTER_DRAIN) { E(acc, cur, wr, wc, fr, fq); S.done(cur); }
        if (!has_next) break;
#pragma unroll
        for (int a = 0; a < 2; ++a)
#pragma unroll
            for (int b = 0; b < 2; ++b)
#pragma unroll
                for (int m = 0; m < 4; ++m)
#pragma unroll
                    for (int n = 0; n < 2; ++n) acc[a][b][m][n] = (f32x4){0.f, 0.f, 0.f, 0.f};
        cur = nxt; cA = nA; cB = nB; ++ui;
        if constexpr (ALIGN_EPI) { if (wr == 1) PG8_BAR; }
    }
    PG8_WAIT_V(0);
    if constexpr (!ALIGN_EPI) { if (wr == 0) PG8_BAR; }
    PG8_BAR;
    if constexpr (Epi::AFTER_DRAIN) { E.fused(acc, cur, wr, wc, fr, fq, lds, wid, lane); S.done(cur); }
#undef PG8_SA
#undef PG8_SB
#undef PG8_STAGE
#undef PG8_LDA
#undef PG8_LDB
#undef PG8_MMA
#undef PG8_WAIT_V
#undef PG8_WAIT_L
#undef PG8_BAR
#undef PG8_SCHED
}
}
typedef unsigned short bf16_t;
typedef short bf16x8 __attribute__((ext_vector_type(8)));
typedef float f32x4 __attribute__((ext_vector_type(4)));
typedef float f32x16 __attribute__((ext_vector_type(16)));
typedef unsigned u32x4 __attribute__((ext_vector_type(4)));
typedef unsigned u32x2 __attribute__((ext_vector_type(2)));
using pg8::pk2; using pg8::pk8; using pg8::MROWS; using pg8::RMS_EPS;
constexpr int NTHR = 512, NWAVES = 8;
constexpr int MP = 16384, MT = 16640, DM = 1024, DFF = 2816;
constexpr size_t MiB = 1u << 20;
constexpr size_t WS_SSQ = 1 * MiB, WS_WSB = 2 * MiB, WS_W1 = 3 * MiB, WS_W2 = 47 * MiB, WS_EIN = 69 * MiB, WS_EOUT = 76 * MiB, WS_OIN = 78 * MiB, WS_OOUT = 82 * MiB,
                 WS_XB = 84 * MiB, WS_CAT = 117 * MiB, WS_BIG = 150 * MiB, WS_END = 248 * MiB;
constexpr size_t W1_BYTES = 11 * MiB, W2_BYTES = 5767168;
constexpr int LDS_BYTES = 147456;
constexpr size_t O_YP = 0, O_YS = 16777216, O_PK = O_YS + 131072, O_PV = O_PK + 8388608, O_PLF = O_PV + 8388608, O_PSC = O_PLF + 131072, O_PCC = O_PSC + 8192,
                 O_SK = O_PCC + 122880, O_SV = O_SK + 65536, O_SLF = O_SV + 65536, O_SSC = O_SLF + 1024, O_SCC = O_SSC + 8192, O_SGV = O_SCC + 122880, O_END = O_SGV + 65536;
constexpr float LOG2E = 1.4426950408889634f;

struct Params { const float* in[31]; float* out; unsigned char* ws; };

__device__ __forceinline__ float sum_xor32(float v) { const auto rr = __builtin_amdgcn_permlane32_swap(__float_as_uint(v), __float_as_uint(v), false, false); return __uint_as_float(rr[0]) + __uint_as_float(rr[1]); }
__device__ __forceinline__ float max_xor32(float v) { const auto rr = __builtin_amdgcn_permlane32_swap(__float_as_uint(v), __float_as_uint(v), false, false); return fmaxf(__uint_as_float(rr[0]), __uint_as_float(rr[1])); }
__device__ __forceinline__ float sum_xor16(float v) { const auto rr = __builtin_amdgcn_permlane16_swap(__float_as_uint(v), __float_as_uint(v), false, false); return __uint_as_float(rr[0]) + __uint_as_float(rr[1]); }
__device__ __forceinline__ float wave_sum(float v) {
    v += __builtin_bit_cast(float, __builtin_amdgcn_mov_dpp(__builtin_bit_cast(int, v), 0xB1, 0xF, 0xF, true));
    v += __builtin_bit_cast(float, __builtin_amdgcn_mov_dpp(__builtin_bit_cast(int, v), 0x4E, 0xF, 0xF, true));
    v += __builtin_bit_cast(float, __builtin_amdgcn_mov_dpp(__builtin_bit_cast(int, v), 0x141, 0xF, 0xF, true));
    v += __builtin_bit_cast(float, __builtin_amdgcn_mov_dpp(__builtin_bit_cast(int, v), 0x140, 0xF, 0xF, true));
    v = sum_xor16(v); v = sum_xor32(v);
    return v;
}
__device__ __forceinline__ float bf2f(unsigned short b) { return __uint_as_float((unsigned)b << 16); }
__device__ __forceinline__ float bflo(unsigned w) { return __uint_as_float(w << 16); }
__device__ __forceinline__ float bfhi(unsigned w) { return __uint_as_float(w & 0xffff0000u); }

__device__ __forceinline__ int map_row(int mode, int n0) {
    if (mode == 0) return n0;
    if (mode == 1) return (n0 >> 7) * 256 + (n0 & 127);
    if (mode == 2) return (n0 >> 7) * 256 + 128 + (n0 & 127);
    if (n0 < 1024) return n0;
    if (n0 < 1536) { const int j = n0 - 1024; return 1024 + (j >> 7) * 256 + (j & 127); }
    { const int j = n0 - 1536; return 1024 + (j >> 7) * 256 + 128 + (j & 127); }
}
__device__ __forceinline__ void tr_item(const float* __restrict__ W, const float* __restrict__ gain, int K, int Nsrc, int nblk, bf16_t* WT, int mode, float* scr, int item, int lane) {
    const int kb = item / nblk, nb = item - kb * nblk, k0 = 64 * kb, n0 = 64 * nb;
    const int kr = lane >> 4, n4 = (lane & 15) * 4; const bool nv = (n0 + n4) < Nsrc;
    f32x4 v[16];
#pragma unroll
    for (int i = 0; i < 16; ++i) v[i] = nv ? *(const f32x4*)(W + (size_t)(k0 + 4 * i + kr) * Nsrc + n0 + n4) : (f32x4){0.f, 0.f, 0.f, 0.f};
    if (gain) {
#pragma unroll
        for (int i = 0; i < 16; ++i) v[i] *= gain[k0 + 4 * i + kr]; }
#pragma unroll
    for (int i = 0; i < 16; ++i) { float* d = scr + (4 * i + kr) * 65 + n4; d[0] = v[i][0]; d[1] = v[i][1]; d[2] = v[i][2]; d[3] = v[i][3]; }
    asm volatile("s_waitcnt lgkmcnt(0)" ::: "memory");
    const int rb = map_row(mode, n0);
#pragma unroll
    for (int jj = 0; jj < 8; ++jj) { const int id = lane + 64 * jj, nn = id >> 3, c = id & 7; const float* s = scr + (8 * c) * 65 + nn;
        u32x4 o; o.x = pk2(s[0 * 65], s[1 * 65]); o.y = pk2(s[2 * 65], s[3 * 65]); o.z = pk2(s[4 * 65], s[5 * 65]); o.w = pk2(s[6 * 65], s[7 * 65]);
        *(u32x4*)(WT + (size_t)(rb + nn) * K + k0 + 8 * c) = o; }
    asm volatile("s_waitcnt lgkmcnt(0)" ::: "memory");
}

__device__ __forceinline__ int crow(int r, int hi) { return (r & 3) + 8 * (r >> 2) + 4 * hi; }
struct AttnState { float m, l; f32x16 o[2]; };
template <bool MASK> __device__ __forceinline__ void attn_tile(AttnState& st, const bf16x8 (&kf)[2][4], const bf16x8 (&vf)[2][4], const bf16x8 (&qr)[4], const float* clt, int hi, int kv_limit) {
    f32x16 p[2];
#pragma unroll
    for (int kvb = 0; kvb < 2; ++kvb) {
#pragma unroll
        for (int r4 = 0; r4 < 4; ++r4) { const f32x4 bv = *(const f32x4*)(clt + 32 * kvb + 8 * r4 + 4 * hi);
            p[kvb][4 * r4] = bv[0]; p[kvb][4 * r4 + 1] = bv[1]; p[kvb][4 * r4 + 2] = bv[2]; p[kvb][4 * r4 + 3] = bv[3]; }
#pragma unroll
        for (int d0 = 0; d0 < 4; ++d0) p[kvb] = __builtin_amdgcn_mfma_f32_32x32x16_bf16(kf[kvb][d0], qr[d0], p[kvb], 0, 0, 0); }
    float mx = -1e30f;
#pragma unroll
    for (int kvb = 0; kvb < 2; ++kvb)
#pragma unroll
        for (int r = 0; r < 16; ++r) { float s = p[kvb][r];
            if (MASK) { const int kvl = 32 * kvb + 8 * (r >> 2) + 4 * hi + (r & 3); s = (kvl > kv_limit) ? -1e30f : s; p[kvb][r] = s; }
            mx = fmaxf(mx, s); }
    mx = max_xor32(mx);
    const float mn = fmaxf(st.m, mx), alpha = __builtin_amdgcn_exp2f(st.m - mn); st.m = mn;
    float ls = 0.f;
#pragma unroll
    for (int kvb = 0; kvb < 2; ++kvb)
#pragma unroll
        for (int r = 0; r < 16; ++r) { const float e = __builtin_amdgcn_exp2f(p[kvb][r] - mn); p[kvb][r] = e; ls += e; }
    st.l = st.l * alpha + ls;
#pragma unroll
    for (int db = 0; db < 2; ++db)
#pragma unroll
        for (int r = 0; r < 16; ++r) st.o[db][r] *= alpha;
    bf16x8 pb[4];
#pragma unroll
    for (int s = 0; s < 4; ++s) { const int kvb = s >> 1, b0 = 8 * (s & 1);
        u32x4 w; w.x = pk2(p[kvb][b0 + 0], p[kvb][b0 + 1]); w.y = pk2(p[kvb][b0 + 2], p[kvb][b0 + 3]); w.z = pk2(p[kvb][b0 + 4], p[kvb][b0 + 5]); w.w = pk2(p[kvb][b0 + 6], p[kvb][b0 + 7]);
        pb[s] = __builtin_bit_cast(bf16x8, w); }
#pragma unroll
    for (int db = 0; db < 2; ++db)
#pragma unroll
        for (int s = 0; s < 4; ++s) st.o[db] = __builtin_amdgcn_mfma_f32_32x32x16_bf16(vf[db][s], pb[s], st.o[db], 0, 0, 0);
}
template <int NV, class F> __device__ __forceinline__ void block_cumsum(float* cl, float* tmp, F getv, int tid, int lane, int wid) {
    float v[NV];
#pragma unroll
    for (int e = 0; e < NV; ++e) v[e] = getv(NV * tid + e);
#pragma unroll
    for (int e = 1; e < NV; ++e) v[e] += v[e - 1];
    const float tot = v[NV - 1]; float sc = tot;
#pragma unroll
    for (int off = 1; off < 64; off <<= 1) { const float t = __shfl_up(sc, off); if (lane >= off) sc += t; }
    if (lane == 63) tmp[wid] = sc;
    __syncthreads();
    float base = 0.f;
#pragma unroll
    for (int w = 0; w < 8; ++w) base += (w < wid) ? tmp[w] : 0.f;
    const float excl = base + sc - tot;
#pragma unroll
    for (int e = 0; e < NV; ++e) cl[NV * tid + e] = -(excl + v[e]) * LOG2E;
}
constexpr int AL_KS = 0, AL_VT = 18432, AL_CL = 35840, AL_TMP = 35840 + 10240, AL_OW = 49152, AL_ML = 49152 + 65536, AL_SK = 49152;

__device__ __forceinline__ void attn_prompt_unit(unsigned char* lds, int b, int h, int qb, const bf16_t* __restrict__ ZB, const float* __restrict__ logf, bf16_t* CAT) {
    const int tid = opaque_tid(), lane = tid & 63, wid = __builtin_amdgcn_readfirstlane(tid >> 6), r32 = lane & 31, hi = lane >> 5;
    float* cl = (float*)(lds + AL_CL); float* tmp = (float*)(lds + AL_TMP);
    const int rowbase = b * 2048, q0 = qb * 256, NT = 4 * (qb + 1), nk = NT * 64;
    const bf16_t* Qp = ZB + (size_t)(rowbase + q0 + 32 * wid + r32) * 3072 + 1536 + h * 64;
    bf16x8 qr[4];
#pragma unroll
    for (int d0 = 0; d0 < 4; ++d0) qr[d0] = *(const bf16x8*)(Qp + 16 * d0 + 8 * hi);
    const int lkv = tid >> 3, lch = tid & 7;
    const bf16_t* Kg = ZB + (size_t)(rowbase + lkv) * 3072 + 2048 + h * 64 + 8 * lch;
    const bf16_t* Vg = ZB + (size_t)(rowbase + lane) * 3072 + 2560 + h * 64 + 8 * wid;
    u32x4 kreg = *(const u32x4*)Kg, vreg = *(const u32x4*)Vg;
    block_cumsum<4>(cl, tmp, [&](int k) { return (k < nk) ? logf[(size_t)(rowbase + k) * 8 + h] : 0.f; }, tid, lane, wid);
    auto stage = [&](int buf) {
        *(u32x4*)(lds + AL_KS + buf * 9216 + lkv * 144 + lch * 16) = kreg;
        unsigned short* vt = (unsigned short*)(lds + AL_VT + buf * 8704) + (8 * wid) * 68 + lane;
        vt[0 * 68] = (unsigned short)(vreg.x & 0xffff); vt[1 * 68] = (unsigned short)(vreg.x >> 16); vt[2 * 68] = (unsigned short)(vreg.y & 0xffff); vt[3 * 68] = (unsigned short)(vreg.y >> 16);
        vt[4 * 68] = (unsigned short)(vreg.z & 0xffff); vt[5 * 68] = (unsigned short)(vreg.z >> 16); vt[6 * 68] = (unsigned short)(vreg.w & 0xffff); vt[7 * 68] = (unsigned short)(vreg.w >> 16); };
    stage(0);
    __syncthreads();
    AttnState st; st.m = -1e30f; st.l = 0.f; st.o[0] = f32x16{}; st.o[1] = f32x16{};
    const int qg = q0 + 32 * wid + r32;
    for (int t = 0; t < NT; ++t) {
        if (t + 1 < NT) { kreg = *(const u32x4*)(Kg + (size_t)(t + 1) * 64 * 3072); vreg = *(const u32x4*)(Vg + (size_t)(t + 1) * 64 * 3072); }
        if (64 * t <= q0 + 32 * wid + 31) {
            const unsigned char* ks = lds + AL_KS + (t & 1) * 9216; const unsigned char* vt = lds + AL_VT + (t & 1) * 8704;
            bf16x8 kf[2][4], vf[2][4];
#pragma unroll
            for (int kvb = 0; kvb < 2; ++kvb)
#pragma unroll
                for (int d0 = 0; d0 < 4; ++d0) kf[kvb][d0] = *(const bf16x8*)(ks + (32 * kvb + r32) * 144 + (16 * d0 + 8 * hi) * 2);
#pragma unroll
            for (int db = 0; db < 2; ++db)
#pragma unroll
                for (int s = 0; s < 4; ++s) { const unsigned char* p = vt + (32 * db + r32) * 136 + (16 * s + 4 * hi) * 2; const u32x2 lo = *(const u32x2*)p, hv = *(const u32x2*)(p + 16);
                    vf[db][s] = __builtin_bit_cast(bf16x8, (u32x4){lo.x, lo.y, hv.x, hv.y}); }
            if (64 * t + 63 > q0 + 32 * wid) attn_tile<true>(st, kf, vf, qr, cl + 64 * t, hi, qg - 64 * t); else attn_tile<false>(st, kf, vf, qr, cl + 64 * t, hi, 64);
        }
        if (t + 1 < NT) stage((t + 1) & 1);
        __syncthreads();
    }
    const float lt = sum_xor32(st.l), inv = 1.0f / lt;
    bf16_t* Op = CAT + (size_t)(rowbase + qg) * 1024 + 512 + h * 64 + 4 * hi;
#pragma unroll
    for (int db = 0; db < 2; ++db)
#pragma unroll
        for (int r4 = 0; r4 < 4; ++r4) { u32x2 w; w.x = pk2(st.o[db][4 * r4] * inv, st.o[db][4 * r4 + 1] * inv); w.y = pk2(st.o[db][4 * r4 + 2] * inv, st.o[db][4 * r4 + 3] * inv);
            *(u32x2*)(Op + 32 * db + 8 * r4) = w; }
}

__device__ __forceinline__ void attn_sample_unit(unsigned char* lds, int b, int h, const bf16_t* __restrict__ ZB, const float* __restrict__ cK, const float* __restrict__ cV, const float* __restrict__ cLF,
                                                 const float* __restrict__ nK, const float* __restrict__ nV, const float* __restrict__ nLF, bf16_t* CAT) {
    const int tid = opaque_tid(), lane = tid & 63, wid = __builtin_amdgcn_readfirstlane(tid >> 6), r32 = lane & 31, hi = lane >> 5;
    float* cl = (float*)(lds + AL_CL); float* tmp = (float*)(lds + AL_TMP);
    block_cumsum<5>(cl, tmp, [&](int k) { return (k < 2048) ? cLF[(size_t)(b * 2048 + k) * 8 + h] : ((k < 2064) ? nLF[(size_t)(b * 16 + k - 2048) * 8 + h] : 0.f); }, tid, lane, wid);
    __syncthreads();
    const bf16_t* Qp = ZB + (size_t)(MP + 16 * b + r32) * 3072 + 1536 + h * 64;
    bf16x8 qr[4];
#pragma unroll
    for (int d0 = 0; d0 < 4; ++d0) qr[d0] = *(const bf16x8*)(Qp + 16 * d0 + 8 * hi);
    AttnState st; st.m = -1e30f; st.l = 0.f; st.o[0] = f32x16{}; st.o[1] = f32x16{};
    auto rowp = [&](const float* c, const float* n, int kv) -> const float* {
        return (kv < 2048) ? c + ((size_t)(b * 2048 + kv) * 8 + h) * 64 : n + ((size_t)(b * 16 + min(kv - 2048, 15)) * 8 + h) * 64; };
    for (int t = wid; t < 33; t += 8) {
        bf16x8 kf[2][4], vf[2][4];
        {
            unsigned char* kst = lds + AL_SK + wid * 9216; f32x4 kr[16], vr[16];
#pragma unroll
            for (int i = 0; i < 16; ++i) kr[i] = *(const f32x4*)(rowp(cK, nK, 64 * t + 4 * i + (lane >> 4)) + 4 * (lane & 15));
#pragma unroll
            for (int i = 0; i < 16; ++i) { u32x2 w; w.x = pk2(kr[i][0], kr[i][1]); w.y = pk2(kr[i][2], kr[i][3]); *(u32x2*)(kst + (4 * i + (lane >> 4)) * 144 + (lane & 15) * 8) = w; }
#pragma unroll
            for (int i = 0; i < 16; ++i) vr[i] = *(const f32x4*)(rowp(cV, nV, 64 * t + 4 * i + (lane >> 4)) + 4 * (lane & 15));
            asm volatile("s_waitcnt lgkmcnt(0)" ::: "memory");
#pragma unroll
            for (int kvb = 0; kvb < 2; ++kvb)
#pragma unroll
                for (int d0 = 0; d0 < 4; ++d0) kf[kvb][d0] = *(const bf16x8*)(kst + (32 * kvb + r32) * 144 + (16 * d0 + 8 * hi) * 2);
            asm volatile("s_waitcnt lgkmcnt(0)" ::: "memory");
#pragma unroll
            for (int i = 0; i < 16; ++i) { u32x2 w; w.x = pk2(vr[i][0], vr[i][1]); w.y = pk2(vr[i][2], vr[i][3]); *(u32x2*)(kst + (4 * i + (lane >> 4)) * 144 + (lane & 15) * 8) = w; }
            asm volatile("s_waitcnt lgkmcnt(0)" ::: "memory");
#pragma unroll
            for (int s = 0; s < 4; ++s)
#pragma unroll
                for (int db = 0; db < 2; ++db) { unsigned e[8];
#pragma unroll
                    for (int j = 0; j < 8; ++j) e[j] = *(const unsigned short*)(kst + (16 * s + 4 * hi + (j & 3) + 8 * (j >> 2)) * 144 + (32 * db + r32) * 2);
                    vf[db][s] = __builtin_bit_cast(bf16x8, (u32x4){e[0] | (e[1] << 16), e[2] | (e[3] << 16), e[4] | (e[5] << 16), e[6] | (e[7] << 16)}); }
            asm volatile("s_waitcnt lgkmcnt(0)" ::: "memory");
        }
        attn_tile<true>(st, kf, vf, qr, cl + 64 * t, hi, 2048 + r32 - 64 * t);
    }
    __syncthreads();
    const float lt = sum_xor32(st.l);
    float* ow = (float*)(lds + AL_OW) + wid * 2048; float* ml = (float*)(lds + AL_ML) + wid * 64;
    if (hi == 0) { ml[r32] = st.m; ml[32 + r32] = lt; }
#pragma unroll
    for (int db = 0; db < 2; ++db)
#pragma unroll
        for (int r = 0; r < 16; ++r) ow[(32 * db + crow(r, hi)) * 32 + r32] = st.o[db][r];
    __syncthreads();
#pragma unroll
    for (int e = 0; e < 2; ++e) { const int oi = tid + 512 * e, q = oi >> 6, d = oi & 63; const float* mlb = (const float*)(lds + AL_ML); const float* owb = (const float*)(lds + AL_OW);
        float M = -1e30f;
#pragma unroll
        for (int w = 0; w < 8; ++w) M = fmaxf(M, mlb[w * 64 + q]);
        float L = 0.f, O = 0.f;
#pragma unroll
        for (int w = 0; w < 8; ++w) { const float f = __builtin_amdgcn_exp2f(mlb[w * 64 + q] - M); L += mlb[w * 64 + 32 + q] * f; O += owb[w * 2048 + d * 32 + q] * f; }
        CAT[(size_t)(MP + 16 * b + q) * 1024 + 512 + h * 64 + d] = (bf16_t)(pk2(O / L, 0.f) & 0xffff); }
    __syncthreads();
}

__device__ __forceinline__ void conva_item(int item, const bf16_t* __restrict__ ZB, const float* __restrict__ cw, const float* __restrict__ st_sc, bf16_t* CAT, float* out) {
    const int tid = opaque_tid(), rb = tid >> 6, ch = (tid & 63) * 8, R0 = item * 64 + rb * 8;
    if (R0 >= MROWS) return;
    const bool samp = R0 >= MP; const bool start = samp ? (((R0 - MP) & 15) == 0) : ((R0 & 2047) == 0);
    u32x4 xa[10], gc[10], gbv[8];
#pragma unroll
    for (int i = 0; i < 10; ++i) { const int row = (start && i < 2) ? R0 : R0 - 2 + i; xa[i] = *(const u32x4*)(ZB + (size_t)row * 3072 + ch); gc[i] = *(const u32x4*)(ZB + (size_t)row * 3072 + 1024 + ch); }
#pragma unroll
    for (int i = 0; i < 8; ++i) gbv[i] = *(const u32x4*)(ZB + (size_t)(R0 + i) * 3072 + 512 + ch);
    float w0[8], w1[8], w2[8], p2[8], p1[8];
#pragma unroll
    for (int e = 0; e < 8; ++e) { w0[e] = cw[ch + e]; w1[e] = cw[512 + ch + e]; w2[e] = cw[1024 + ch + e]; }
    auto prod = [&](const u32x4 a, const u32x4 c, float* pr) {
        pr[0] = bflo(a.x) * bflo(c.x); pr[1] = bfhi(a.x) * bfhi(c.x); pr[2] = bflo(a.y) * bflo(c.y); pr[3] = bfhi(a.y) * bfhi(c.y);
        pr[4] = bflo(a.z) * bflo(c.z); pr[5] = bfhi(a.z) * bfhi(c.z); pr[6] = bflo(a.w) * bflo(c.w); pr[7] = bfhi(a.w) * bfhi(c.w); };
    if (start) {
        if (samp) { const int b = (R0 - MP) >> 4;
#pragma unroll
            for (int e = 0; e < 8; ++e) { p2[e] = st_sc[(size_t)(b * 2 + 0) * 512 + ch + e]; p1[e] = st_sc[(size_t)(b * 2 + 1) * 512 + ch + e]; } }
        else {
#pragma unroll
            for (int e = 0; e < 8; ++e) { p2[e] = 0.f; p1[e] = 0.f; } }
    } else { prod(xa[0], gc[0], p2); prod(xa[1], gc[1], p1); }
#pragma unroll
    for (int i = 0; i < 8; ++i) { const int row = R0 + i; float p0[8]; prod(xa[i + 2], gc[i + 2], p0);
        const u32x4 g = gbv[i];
        const float gf[8] = {bflo(g.x), bfhi(g.x), bflo(g.y), bfhi(g.y), bflo(g.z), bfhi(g.z), bflo(g.w), bfhi(g.w)};
        float y[8];
#pragma unroll
        for (int e = 0; e < 8; ++e) y[e] = gf[e] * (w0[e] * p2[e] + w1[e] * p1[e] + w2[e] * p0[e]);
        *(u32x4*)(CAT + (size_t)row * 1024 + ch) = pk8((f32x4){y[0], y[1], y[2], y[3]}, (f32x4){y[4], y[5], y[6], y[7]});
        int orow = -1; float* ob = nullptr;
        if (!samp) { const int tt = row & 2047; if (tt >= 2046) { orow = (row >> 11) * 2 + (tt - 2046); ob = out + O_PSC; } }
        else { const int ii = (row - MP) & 15; if (ii >= 14) { orow = ((row - MP) >> 4) * 2 + (ii - 14); ob = out + O_SSC; } }
        if (orow >= 0) { *(f32x4*)(ob + (size_t)orow * 512 + ch) = (f32x4){p0[0], p0[1], p0[2], p0[3]}; *(f32x4*)(ob + (size_t)orow * 512 + ch + 4) = (f32x4){p0[4], p0[5], p0[6], p0[7]}; }
#pragma unroll
        for (int e = 0; e < 8; ++e) { p2[e] = p1[e]; p1[e] = p0[e]; } }
}
constexpr int CL_STAT = 0, CL_VNT = 2048;
__device__ __forceinline__ void gmlp_unit(unsigned char* lds, int R0, int gh, bool samp, int sb, const bf16_t* __restrict__ ZO, const bf16_t* __restrict__ WSB, const float* __restrict__ lng, const float* __restrict__ lnb,
                                          const float* __restrict__ bs, bf16_t* CAT, float* out) {
    const int tid = opaque_tid(), lane = tid & 63, wid = __builtin_amdgcn_readfirstlane(tid >> 6), r32 = lane & 31, hi = lane >> 5;
    float* stat = (float*)(lds + CL_STAT);
    const int vs_ = tid & 127, vc0_ = 16 * (tid >> 7);
    u32x4 nx0 = *(const u32x4*)(ZO + (size_t)(R0 + vs_) * 1536 + 512 + (gh * 4) * 64 + vc0_), nx1 = *(const u32x4*)(ZO + (size_t)(R0 + vs_) * 1536 + 512 + (gh * 4) * 64 + vc0_ + 8);
    { u32x4 av[16];
#pragma unroll
      for (int i = 0; i < 16; ++i) av[i] = *(const u32x4*)(ZO + (size_t)(R0 + wid * 16 + i) * 1536 + 512 + 8 * lane);
#pragma unroll
      for (int i = 0; i < 16; ++i) { const int s = wid * 16 + i; const u32x4 a = av[i];
        const float v[8] = {bflo(a.x), bfhi(a.x), bflo(a.y), bfhi(a.y), bflo(a.z), bfhi(a.z), bflo(a.w), bfhi(a.w)};
        float sm = 0.f;
#pragma unroll
        for (int e = 0; e < 8; ++e) sm += v[e];
        const float mean = wave_sum(sm) * (1.0f / 512.0f); float q = 0.f;
#pragma unroll
        for (int e = 0; e < 8; ++e) q += (v[e] - mean) * (v[e] - mean);
        const float rstd = __builtin_amdgcn_rsqf(wave_sum(q) * (1.0f / 512.0f) + RMS_EPS);
        if (lane == 0) { stat[2 * s] = mean; stat[2 * s + 1] = rstd; }
        if (samp && gh == 0 && s < 16) { float* o = out + O_SGV + (size_t)(sb * 16 + s) * 512 + 8 * lane;
#pragma unroll
            for (int e = 0; e < 8; ++e) o[e] = (v[e] - mean) * rstd * lng[8 * lane + e] + lnb[8 * lane + e]; } } }
    __syncthreads();
    for (int gi = 0; gi < 4; ++gi) { const int g = gh * 4 + gi;
        { const int s = vs_, c0 = vc0_; const float mean = stat[2 * s], rstd = stat[2 * s + 1];
            unsigned short* vt = (unsigned short*)(lds + CL_VNT) + c0 * 136 + s;
            const u32x4 cur0 = nx0, cur1 = nx1;
            if (gi + 1 < 4) { const bf16_t* nsrc = ZO + (size_t)(R0 + s) * 1536 + 512 + (g + 1) * 64 + c0; nx0 = *(const u32x4*)nsrc; nx1 = *(const u32x4*)(nsrc + 8); }
#pragma unroll
            for (int hh = 0; hh < 2; ++hh) { const u32x4 a = hh ? cur1 : cur0; const float v[8] = {bflo(a.x), bfhi(a.x), bflo(a.y), bfhi(a.y), bflo(a.z), bfhi(a.z), bflo(a.w), bfhi(a.w)};
#pragma unroll
                for (int e = 0; e < 8; ++e) { const int c = g * 64 + c0 + 8 * hh + e; const float y = (v[e] - mean) * rstd * lng[c] + lnb[c]; vt[(8 * hh + e) * 136] = (unsigned short)(pk2(y, 0.f) & 0xffff); } } }
        __syncthreads();
        { const int cb = wid & 1, tb = wid >> 1;
          if (!samp || tb == 0) {
            f32x16 acc = f32x16{};
            const unsigned char* ap = lds + CL_VNT + (32 * cb + r32) * 272 + 16 * hi; const bf16_t* bp = WSB + (size_t)(g * 128 + 32 * tb + r32) * 128 + 8 * hi;
            bf16x8 Bf[8];
#pragma unroll
            for (int ks = 0; ks < 8; ++ks) Bf[ks] = (ks < 2 * (tb + 1)) ? *(const bf16x8*)(bp + 16 * ks) : (bf16x8){0, 0, 0, 0, 0, 0, 0, 0};
#pragma unroll
            for (int ks = 0; ks < 8; ++ks) if (ks < 2 * (tb + 1)) { const bf16x8 A = *(const bf16x8*)(ap + 32 * ks); acc = __builtin_amdgcn_mfma_f32_32x32x16_bf16(A, Bf[ks], acc, 0, 0, 0); }
            const int t = 32 * tb + r32; const float bst = bs[g * 128 + t];
            if (!samp || t < 16) {
#pragma unroll
                for (int r4 = 0; r4 < 4; ++r4) { const int c = g * 64 + 32 * cb + 8 * r4 + 4 * hi; const u32x2 uu = *(const u32x2*)(ZO + (size_t)(R0 + t) * 1536 + c);
                    u32x2 w; w.x = pk2(bflo(uu.x) * (acc[4 * r4] + bst), bfhi(uu.x) * (acc[4 * r4 + 1] + bst)); w.y = pk2(bflo(uu.y) * (acc[4 * r4 + 2] + bst), bfhi(uu.y) * (acc[4 * r4 + 3] + bst));
                    *(u32x2*)(CAT + (size_t)(R0 + t) * 1024 + c) = w; } }
          } }
        __syncthreads();
    }
}
__device__ __forceinline__ void gmlp_sample_unit(unsigned char* lds, int sb, const bf16_t* __restrict__ ZO, const bf16_t* __restrict__ WSB, const float* __restrict__ lng, const float* __restrict__ lnb,
                                                 const float* __restrict__ bs, bf16_t* CAT, float* out) {
    const int tid = opaque_tid(), lane = tid & 63, wid = __builtin_amdgcn_readfirstlane(tid >> 6), r32 = lane & 31, hi = lane >> 5;
    const int R0 = MP + 16 * sb;
    float* stat = (float*)(lds + CL_STAT); unsigned char* vn8 = lds + CL_VNT;
    { u32x4 av[2];
#pragma unroll
      for (int i = 0; i < 2; ++i) av[i] = *(const u32x4*)(ZO + (size_t)(R0 + 2 * wid + i) * 1536 + 512 + 8 * lane);
#pragma unroll
      for (int i = 0; i < 2; ++i) { const int s = 2 * wid + i; const u32x4 a = av[i];
        const float v[8] = {bflo(a.x), bfhi(a.x), bflo(a.y), bfhi(a.y), bflo(a.z), bfhi(a.z), bflo(a.w), bfhi(a.w)};
        float sm = 0.f;
#pragma unroll
        for (int e = 0; e < 8; ++e) sm += v[e];
        const float mean = wave_sum(sm) * (1.0f / 512.0f); float q = 0.f;
#pragma unroll
        for (int e = 0; e < 8; ++e) q += (v[e] - mean) * (v[e] - mean);
        const float rstd = __builtin_amdgcn_rsqf(wave_sum(q) * (1.0f / 512.0f) + RMS_EPS);
        if (lane == 0) { stat[2 * s] = mean; stat[2 * s + 1] = rstd; }
        float* o = out + O_SGV + (size_t)(sb * 16 + s) * 512 + 8 * lane;
#pragma unroll
        for (int e = 0; e < 8; ++e) o[e] = (v[e] - mean) * rstd * lng[8 * lane + e] + lnb[8 * lane + e]; } }
    __syncthreads();
    { const int s = tid >> 5, ch0 = (tid & 31) * 16; const float mean = stat[2 * s], rstd = stat[2 * s + 1];
      const bf16_t* src = ZO + (size_t)(R0 + s) * 1536 + 512 + ch0; unsigned short* vt = (unsigned short*)vn8 + (size_t)((ch0 >> 6) * 64 + (ch0 & 63)) * 40 + s;
#pragma unroll
      for (int hh = 0; hh < 2; ++hh) { const u32x4 a = *(const u32x4*)(src + 8 * hh); const float v[8] = {bflo(a.x), bfhi(a.x), bflo(a.y), bfhi(a.y), bflo(a.z), bfhi(a.z), bflo(a.w), bfhi(a.w)};
#pragma unroll
          for (int e = 0; e < 8; ++e) { const int c = ch0 + 8 * hh + e; const float y = (v[e] - mean) * rstd * lng[c] + lnb[c]; vt[(8 * hh + e) * 40] = (unsigned short)(pk2(y, 0.f) & 0xffff); vt[(8 * hh + e) * 40 + 16] = 0; } } }
    __syncthreads();
#pragma unroll
    for (int k = 0; k < 2; ++k) { const int task = wid + 8 * k, g = task >> 1, cb = task & 1;
        const unsigned char* ap = vn8 + (size_t)(g * 64 + 32 * cb + r32) * 80 + 16 * hi; const bf16_t* bp = WSB + (size_t)(g * 128 + r32) * 128 + 8 * hi;
        f32x16 acc = f32x16{};
#pragma unroll
        for (int ks = 0; ks < 2; ++ks) { const bf16x8 A = *(const bf16x8*)(ap + 32 * ks), B = *(const bf16x8*)(bp + 16 * ks); acc = __builtin_amdgcn_mfma_f32_32x32x16_bf16(A, B, acc, 0, 0, 0); }
        const int t = r32;
        if (t < 16) { const float bst = bs[g * 128 + t];
#pragma unroll
            for (int r4 = 0; r4 < 4; ++r4) { const int c = g * 64 + 32 * cb + 8 * r4 + 4 * hi; const u32x2 uu = *(const u32x2*)(ZO + (size_t)(R0 + t) * 1536 + c);
                u32x2 w; w.x = pk2(bflo(uu.x) * (acc[4 * r4] + bst), bfhi(uu.x) * (acc[4 * r4 + 1] + bst)); w.y = pk2(bflo(uu.y) * (acc[4 * r4 + 2] + bst), bfhi(uu.y) * (acc[4 * r4 + 3] + bst));
                *(u32x2*)(CAT + (size_t)(R0 + t) * 1024 + c) = w; } } }
    __syncthreads();
}
template <bool SAMP> __device__ __forceinline__ void cconv_unit(unsigned char* lds, int R0, int sb, const bf16_t* __restrict__ ZO, const float* __restrict__ dw, const float* __restrict__ dwb, const float* __restrict__ cng,
                                           const float* __restrict__ cnb, const float* __restrict__ st_cc, bf16_t* CAT) {
    typedef float f32x2 __attribute__((ext_vector_type(2)));
    const int tid = opaque_tid(), lane = tid & 63, wid = __builtin_amdgcn_readfirstlane(tid >> 6), cp = tid & 255, c = 2 * cp, h = tid >> 8;
    float* cd = (float*)lds;
    f32x2 w[31];
#pragma unroll
    for (int j = 0; j < 31; ++j) w[j] = *(const f32x2*)(dw + j * 512 + c);
    const f32x2 bias = *(const f32x2*)(dwb + c);
    const f32x4 g0 = *(const f32x4*)(cng + 4 * lane), g1 = *(const f32x4*)(cng + 256 + 4 * lane), c0 = *(const f32x4*)(cnb + 4 * lane), c1 = *(const f32x4*)(cnb + 256 + 4 * lane);
    constexpr int NSTEP = SAMP ? 1 : 2;
#pragma unroll
    for (int step = 0; step < NSTEP; ++step) { const int Rs = R0 + 32 * h + 16 * step;
        if (!SAMP || h == 0) {
            f32x2 x[46];
            if (SAMP) {
#pragma unroll
                for (int i = 0; i < 46; ++i) { if (i < 30) x[i] = *(const f32x2*)(st_cc + (size_t)(sb * 30 + i) * 512 + c); else { const unsigned v = *(const unsigned*)(ZO + (size_t)(Rs + i - 30) * 1536 + 1024 + c); x[i] = (f32x2){bflo(v), bfhi(v)}; } }
            } else { const int ts = (Rs & 2047) - 30;
#pragma unroll
                for (int i = 0; i < 46; ++i) { const unsigned v = (ts + i >= 0) ? *(const unsigned*)(ZO + (size_t)(Rs - 30 + i) * 1536 + 1024 + c) : 0u; x[i] = (f32x2){bflo(v), bfhi(v)}; } }
#pragma unroll
            for (int i = 0; i < 16; ++i) { f32x2 a = bias;
#pragma unroll
                for (int j = 0; j < 31; ++j) a += w[j] * x[i + j];
                *(f32x2*)(cd + (16 * h + i) * 512 + c) = a; }
        }
        __syncthreads();
        constexpr int RPW = SAMP ? 2 : 4;
#pragma unroll
        for (int rr = 0; rr < RPW; ++rr) { const int i = RPW * wid + rr; const f32x4 a = *(const f32x4*)(cd + i * 512 + 4 * lane), b2 = *(const f32x4*)(cd + i * 512 + 256 + 4 * lane);
            const float mean = wave_sum((a[0] + a[1]) + (a[2] + a[3]) + (b2[0] + b2[1]) + (b2[2] + b2[3])) * (1.0f / 512.0f);
            const f32x4 da = a - mean, db = b2 - mean;
            const float rstd = __builtin_amdgcn_rsqf(wave_sum((da[0] * da[0] + da[1] * da[1]) + (da[2] * da[2] + da[3] * da[3]) + (db[0] * db[0] + db[1] * db[1]) + (db[2] * db[2] + db[3] * db[3])) * (1.0f / 512.0f) + RMS_EPS);
            f32x4 y0 = da * rstd * g0 + c0, y1 = db * rstd * g1 + c1;
#pragma unroll
            for (int e = 0; e < 4; ++e) { y0[e] = pg8::siluf_(y0[e]); y1[e] = pg8::siluf_(y1[e]); }
            const int orow = R0 + 32 * (i >> 4) + 16 * step + (i & 15);
            bf16_t* op = CAT + (size_t)orow * 1024 + 512 + 4 * lane;
            u32x2 w0; w0.x = pk2(y0[0], y0[1]); w0.y = pk2(y0[2], y0[3]); *(u32x2*)op = w0;
            u32x2 w1; w1.x = pk2(y1[0], y1[1]); w1.y = pk2(y1[2], y1[3]); *(u32x2*)(op + 256) = w1; }
        __syncthreads();
    }
}

#define GAS __attribute__((address_space(1)))
#define LAS __attribute__((address_space(3)))
typedef GAS unsigned gu32;
typedef GAS unsigned long long gu64;
#define RLX_AGENT __ATOMIC_RELAXED, __HIP_MEMORY_SCOPE_AGENT
#define LDS_WAIT() asm volatile("s_waitcnt lgkmcnt(0)" ::: "memory")
#define VM_WAIT() asm volatile("s_waitcnt vmcnt(0)" ::: "memory")
__device__ __forceinline__ unsigned long long rt() { return __builtin_amdgcn_s_memrealtime(); }
#define XB_TMO      128
#define XB_XCNT(j)  (256  + 64 * (j))
#define XB_XSUB(j)  (1280 + 64 * (j))
#define XB_XGEN(j)  (2304 + 64 * (j))
#define XB_TOP      3328
#define XB_TOPGEN   3392
#define XCD_BAR_WORDS 3456
#define XB_SPIN_CAP (1u << 18)

__device__ __forceinline__ unsigned xb_ld(unsigned* p)              { return __hip_atomic_load(p, __ATOMIC_RELAXED, __HIP_MEMORY_SCOPE_AGENT); }
__device__ __forceinline__ unsigned xb_add(unsigned* p, unsigned v) { return __hip_atomic_fetch_add(p, v, __ATOMIC_RELAXED, __HIP_MEMORY_SCOPE_AGENT); }
__device__ __forceinline__ unsigned xb_xcc_id() { return (unsigned)__builtin_amdgcn_s_getreg((3 << 11) | 20) & 0xFu; }
#define XB_SPIN(cond, bar) do { unsigned _sp = 0; while (cond) { __builtin_amdgcn_s_sleep(1); \
    if ((++_sp & 255u) == 0u) { if (xb_ld(&(bar)[XB_TMO])) break; if (_sp > XB_SPIN_CAP) { atomicAdd(&(bar)[XB_TMO], 1u); break; } } } } while (0)

struct XcdBarrier {
    unsigned* bar; unsigned x;
    volatile LAS unsigned* st;
};

__device__ __forceinline__ XcdBarrier xcd_barrier_post(unsigned* bar, volatile LAS unsigned* st) {
    XcdBarrier b; b.bar = bar; b.x = xb_xcc_id(); b.st = st;
    if (threadIdx.x == 0) (void)xb_add(&bar[XB_XCNT(b.x)], 1u);
    return b;
}
__device__ __forceinline__ void xcd_barrier_complete(unsigned* bar, unsigned x, unsigned& nloc, unsigned& nx) {
    const unsigned G = gridDim.x * gridDim.y * gridDim.z;
    unsigned sum, cnt, mine, sp = 0u;
    for (;;) {
        sum = 0u; cnt = 0u; mine = 0u;
#pragma unroll
        for (unsigned j = 0; j < 16; ++j) { const unsigned c = xb_ld(&bar[XB_XCNT(j)]); sum += c; cnt += (c > 0u) ? 1u : 0u; mine = (j == x) ? c : mine; }
        if (sum == G) break;
        __builtin_amdgcn_s_sleep(1);
        if ((++sp & 255u) == 0u) { if (xb_ld(&bar[XB_TMO])) break; if (sp > XB_SPIN_CAP) { atomicAdd(&bar[XB_TMO], 1u); break; } }
    }
    nloc = mine > 0u ? mine : 1u; nx = cnt > 0u ? cnt : 1u;
}

__device__ __forceinline__ void xcd_barrier(const XcdBarrier& b) {
    asm volatile("s_waitcnt vmcnt(0)" ::: "memory");
    __syncthreads();
    if (opaque_tid() == 0) {
        unsigned* bar = b.bar; asm volatile("" : "+s"(bar)); unsigned bx = b.x; asm volatile("" : "+s"(bx));
        __builtin_amdgcn_s_waitcnt(0);
        unsigned nloc = b.st[0], nx = b.st[1];
        if (nloc == 0u) { xcd_barrier_complete(bar, bx, nloc, nx); b.st[0] = nloc; b.st[1] = nx; }
        const unsigned old = xb_add(&bar[XB_XSUB(bx)], 1u);
        const unsigned gen = old / nloc;
        if (old + 1u == (gen + 1u) * nloc) {
            __builtin_amdgcn_fence(__ATOMIC_RELEASE, "agent");
            asm volatile("s_waitcnt vmcnt(0)" ::: "memory");
            const unsigned og = xb_add(&bar[XB_TOP], 1u);
            const unsigned tg = og / nx;
            if (og + 1u == (tg + 1u) * nx) xb_add(&bar[XB_TOPGEN], 1u);
            else XB_SPIN(xb_ld(&bar[XB_TOPGEN]) == tg, bar);
            __builtin_amdgcn_fence(__ATOMIC_ACQUIRE, "agent");
            xb_add(&bar[XB_XGEN(bx)], 1u);
            asm volatile("s_waitcnt vmcnt(0)" ::: "memory");
        } else {
            XB_SPIN(xb_ld(&bar[XB_XGEN(bx)]) == gen, bar);
            __builtin_amdgcn_fence(__ATOMIC_ACQUIRE, "agent");
            asm volatile("s_waitcnt vmcnt(0)" ::: "memory");
        }
    }
    __syncthreads();
}


__device__ __forceinline__ void refresh_sample(const pg8::StaticOrder& S, const float* X, bf16_t* XBp, float* ssq) {
    bool own = false; pg8::Unit u;
    for (int i = 0; S.next(i, u); ++i) own = own || (u.pm == 64);
    if (!own) return;
    const int tid = opaque_tid(), lane = tid & 63, wid = __builtin_amdgcn_readfirstlane(tid >> 6);
    for (int hb = 0; hb < 2; ++hb) { const int r0 = MP + wid * 16 + hb * 8; f32x4 v[8][4];
#pragma unroll
        for (int i = 0; i < 8; ++i)
#pragma unroll
            for (int j = 0; j < 4; ++j) v[i][j] = ((const f32x4*)(X + (size_t)(r0 + i) * DM) + lane)[64 * j];
#pragma unroll
        for (int i = 0; i < 8; ++i) { u32x2* xb = (u32x2*)(XBp + (size_t)(r0 + i) * DM) + lane; float ss = 0.f;
#pragma unroll
            for (int j = 0; j < 4; ++j) { u32x2 w; w.x = pk2(v[i][j][0], v[i][j][1]); w.y = pk2(v[i][j][2], v[i][j][3]); xb[64 * j] = w; ss += (v[i][j][0] * v[i][j][0] + v[i][j][1] * v[i][j][1]) + (v[i][j][2] * v[i][j][2] + v[i][j][3] * v[i][j][3]); }
            ss = wave_sum(ss); if (lane == 0) ssq[r0 + i] = ss; } }
    __builtin_amdgcn_fence(__ATOMIC_RELEASE, "agent"); asm volatile("s_waitcnt vmcnt(0)" ::: "memory");
    __syncthreads();
    __builtin_amdgcn_fence(__ATOMIC_ACQUIRE, "agent"); asm volatile("s_waitcnt vmcnt(0)" ::: "memory");
    __syncthreads();
}

template <int NS> __device__ __forceinline__ void skinny_resid_unit(unsigned char* lds, const bf16_t* __restrict__ A, const bf16_t* __restrict__ Bt, int u, const float* Xs_in, float* X, bf16_t* XBp, float* ssq, float scale) {
    constexpr int K = NS * 32 * 8;
    const int tid = opaque_tid(), lane = tid & 63, wid = __builtin_amdgcn_readfirstlane(tid >> 6), fr = lane & 15, fq = lane >> 4;
    const int rb = u & 7, cb = u >> 3, k0 = wid * (K / 8);
    const bf16_t* ap = A + (size_t)(16 * rb + fr) * K + k0 + 8 * fq; const bf16_t* bp0 = Bt + (size_t)(32 * cb + fr) * K + k0 + 8 * fq; const bf16_t* bp1 = bp0 + (size_t)16 * K;
    bf16x8 a[NS], p[NS], q[NS];
#pragma unroll
    for (int i = 0; i < NS; ++i) { a[i] = *(const bf16x8*)(ap + 32 * i); p[i] = *(const bf16x8*)(bp0 + 32 * i); q[i] = *(const bf16x8*)(bp1 + 32 * i); }
    f32x4 acc0 = {0.f, 0.f, 0.f, 0.f}, acc1 = {0.f, 0.f, 0.f, 0.f};
#pragma unroll
    for (int i = 0; i < NS; ++i) { acc0 = __builtin_amdgcn_mfma_f32_16x16x32_bf16(p[i], a[i], acc0, 0, 0, 0); acc1 = __builtin_amdgcn_mfma_f32_16x16x32_bf16(q[i], a[i], acc1, 0, 0, 0); }
    float* red = (float*)lds;
#pragma unroll
    for (int e = 0; e < 4; ++e) { red[(wid * 8 + e) * 64 + lane] = acc0[e]; red[(wid * 8 + 4 + e) * 64 + lane] = acc1[e]; }
    __syncthreads();
    { const int r = tid >> 5, c = tid & 31, src = (4 * (c >> 4) + (c & 3)) * 64 + r + 16 * ((c & 15) >> 2);
      float sum = 0.f;
#pragma unroll
      for (int w = 0; w < 8; ++w) sum += red[w * 512 + src];
      const int row = MP + 16 * rb + r, col = 32 * cb + c;
      const float x = Xs_in[(size_t)(16 * rb + r) * DM + col] + scale * sum;
      X[(size_t)row * DM + col] = x; XBp[(size_t)row * DM + col] = (bf16_t)(pk2(x, 0.f) & 0xffff);
      float ss = x * x;
#pragma unroll
      for (int o = 1; o < 32; o <<= 1) ss += __shfl_xor(ss, o);
      if (c == 0) unsafeAtomicAdd(ssq + row, ss); }
    __syncthreads();
}
__global__ void __launch_bounds__(NTHR, 2) mega_fwd(Params P) {
    extern __shared__ __attribute__((aligned(16))) unsigned char lds[];
    cg::grid_group grid = cg::this_grid();
    if (gridDim.x == 0x7fffffffu) grid.sync();
    const int G = gridDim.x, bid = blockIdx.x;
    unsigned char* const ws = P.ws; float* const out = P.out;
    volatile LAS unsigned* bst = (volatile LAS unsigned*)((LAS unsigned char*)lds + LDS_BYTES - 64);
    if (threadIdx.x < 4) bst[threadIdx.x] = 0u;
    __syncthreads();
    const XcdBarrier xbar = xcd_barrier_post((unsigned*)ws, bst);
#define SSQ ((float*)(ws + WS_SSQ))
#define WSB ((bf16_t*)(ws + WS_WSB))
#define XB ((bf16_t*)(ws + WS_XB))
#define CAT ((bf16_t*)(ws + WS_CAT))
#define BIG ((bf16_t*)(ws + WS_BIG))
#define EIN ((bf16_t*)(ws + WS_EIN))
#define EOUT ((bf16_t*)(ws + WS_EOUT))
#define OIN ((bf16_t*)(ws + WS_OIN))
#define OOUT ((bf16_t*)(ws + WS_OOUT))
#define ldsa ((PG8_LAS unsigned char*)lds)
#define x_prompt P.in[0]
#define x_sample P.in[1]
#define cache_k P.in[2]
#define cache_v P.in[3]
#define cache_lf P.in[4]
#define st_sconv P.in[5]
#define st_cconv P.in[6]
#define ffn1_g P.in[7]
#define ffn1_wg P.in[8]
#define ffn1_wu P.in[9]
#define ffn1_wd P.in[10]
#define mix_g P.in[11]
#define ffn2_g P.in[12]
#define ffn2_wg P.in[13]
#define ffn2_wu P.in[14]
#define ffn2_wd P.in[15]
#define e_w_in P.in[16]
#define e_b_f P.in[17]
#define e_conv_w P.in[18]
#define e_w_out P.in[19]
#define o_w_in P.in[20]
#define o_ln_g P.in[21]
#define o_ln_b P.in[22]
#define o_ws P.in[23]
#define o_bs P.in[24]
#define o_dw P.in[25]
#define o_dw_b P.in[26]
#define o_cn_g P.in[27]
#define o_cn_b P.in[28]
#define o_w_out P.in[29]
#define final_g P.in[30]

    {
        const int tid = opaque_tid(), lane = tid & 63, wid = __builtin_amdgcn_readfirstlane(tid >> 6);
        const int gw = bid * NWAVES + wid, NGW = G * NWAVES, gt = bid * NTHR + tid, NGT = G * NTHR;
        float* scr = (float*)(lds + wid * 16640);
        int base = 0;
#define TR_JOB(SRC, GAIN, KK, NSRC, NBLK, DST, MODE) do { const int n_ = ((KK) / 64) * (NBLK); int first_ = (gw - base) % NGW; if (first_ < 0) first_ += NGW; \
        for (int it_ = first_; it_ < n_; it_ += NGW) tr_item((SRC), (GAIN), (KK), (NSRC), (NBLK), (DST), (MODE), scr, it_, lane); base += n_; } while (0)
#define FFN_JOBS(F_) do { const int f_ = (F_), l_ = f_ >> 1, second_ = f_ & 1; \
            const float* wg_ = (second_ ? ffn2_wg : ffn1_wg) + (size_t)l_ * DM * DFF; const float* wu_ = (second_ ? ffn2_wu : ffn1_wu) + (size_t)l_ * DM * DFF; const float* wd_ = (second_ ? ffn2_wd : ffn1_wd) + (size_t)l_ * DFF * DM; \
            const float* gn_ = (second_ ? ffn2_g : ffn1_g) + l_ * DM; \
            bf16_t* w1_ = (bf16_t*)(ws + WS_W1 + f_ * W1_BYTES); bf16_t* w2_ = (bf16_t*)(ws + WS_W2 + f_ * W2_BYTES); \
            TR_JOB(wg_, gn_, DM, DFF, DFF / 64, w1_, 1); TR_JOB(wu_, gn_, DM, DFF, DFF / 64, w1_, 2); TR_JOB(wd_, (const float*)nullptr, DFF, DM, DM / 64, w2_, 0); } while (0)
        FFN_JOBS(0);
        {
            const int rs_ = MP + gw; const bool has_s = rs_ < MROWS; f32x4 sv[4];
            if (has_s) { const f32x4* src = (const f32x4*)(x_sample + (size_t)(rs_ - MP) * DM) + lane;
#pragma unroll
                for (int j = 0; j < 4; ++j) sv[j] = src[64 * j]; }
            for (int r0 = gw * 4; r0 < MP; r0 += NGW * 4) { f32x4 v[4][4];
#pragma unroll
                for (int i = 0; i < 4; ++i) { const f32x4* src = (const f32x4*)(x_prompt + (size_t)(r0 + i) * DM) + lane;
#pragma unroll
                    for (int j = 0; j < 4; ++j) v[i][j] = src[64 * j]; }
#pragma unroll
                for (int i = 0; i < 4; ++i) { u32x2* xb = (u32x2*)(XB + (size_t)(r0 + i) * DM) + lane; float ss = 0.f;
#pragma unroll
                    for (int j = 0; j < 4; ++j) { u32x2 w; w.x = pk2(v[i][j][0], v[i][j][1]); w.y = pk2(v[i][j][2], v[i][j][3]); xb[64 * j] = w; ss += (v[i][j][0] * v[i][j][0] + v[i][j][1] * v[i][j][1]) + (v[i][j][2] * v[i][j][2] + v[i][j][3] * v[i][j][3]); }
                    ss = wave_sum(ss); if (lane == 0) SSQ[r0 + i] = ss; } }
            if (has_s) { u32x2* xb = (u32x2*)(XB + (size_t)rs_ * DM) + lane; float ss = 0.f;
#pragma unroll
                for (int j = 0; j < 4; ++j) { u32x2 w; w.x = pk2(sv[j][0], sv[j][1]); w.y = pk2(sv[j][2], sv[j][3]); xb[64 * j] = w; ss += (sv[j][0] * sv[j][0] + sv[j][1] * sv[j][1]) + (sv[j][2] * sv[j][2] + sv[j][3] * sv[j][3]); }
                ss = wave_sum(ss); if (lane == 0) SSQ[rs_] = ss; }
            for (int r = MP + gw + NGW; r < MROWS; r += NGW) {
                const f32x4* src = (const f32x4*)(x_sample + (size_t)(r - MP) * DM) + lane; u32x2* xb = (u32x2*)(XB + (size_t)r * DM) + lane; float ss = 0.f;
#pragma unroll
                for (int j = 0; j < 4; ++j) { const f32x4 v = src[64 * j]; u32x2 w; w.x = pk2(v[0], v[1]); w.y = pk2(v[2], v[3]); xb[64 * j] = w; ss += (v[0] * v[0] + v[1] * v[1]) + (v[2] * v[2] + v[3] * v[3]); }
                ss = wave_sum(ss); if (lane == 0) SSQ[r] = ss; }
            for (int r = MROWS + gw; r < MT; r += NGW) { u32x2* xb = (u32x2*)(XB + (size_t)r * DM) + lane;
#pragma unroll
                for (int j = 0; j < 4; ++j) xb[64 * j] = (u32x2){0u, 0u};
                if (lane == 0) SSQ[r] = 1024.f; }
        }
        for (int i = gt; i < 6 * MT; i += NGT) SSQ[MT + i] = 0.f;
        for (int i = gt; i < 8 * 128 * 128; i += NGT) { const int s = i & 127, t = (i >> 7) & 127; WSB[i] = (bf16_t)(pk2((s <= t) ? o_ws[i] : 0.f, 0.f) & 0xffff); }
    }
    xcd_barrier(xbar);

    for (int layer = 0; layer < 2; ++layer) {
        for (int f = 0; f < 2; ++f) {
            const int wi = layer * 2 + f, si = layer * 3 + (f ? 2 : 0);
            { pg8::Gemm g{XB, (const bf16_t*)(ws + WS_W1 + wi * W1_BYTES), MT, 2 * DFF, DM, DM}; pg8::StaticOrder S; S.init(MT, 2 * DFF, G, bid);
              pg8::EpiSwiglu E{SSQ + si * MT, BIG};
              pg8::gemm_phase<pg8::EpiSwiglu, pg8::StaticOrder, true, true>(ldsa, g, S, E); }
            if (wi < 3) {
                const int nheavy = (1430 > 5 * G && 1430 <= 6 * G) ? 1430 - 5 * G : 0;
                if (bid >= nheavy) {
                    const int tid = opaque_tid(), lane = tid & 63, wid = __builtin_amdgcn_readfirstlane(tid >> 6);
                    const int gw = (bid - nheavy) * NWAVES + wid, NGW = (G - nheavy) * NWAVES; float* scr = (float*)(lds + wid * 16640); int base = 0;
                    if (wi == 0) { TR_JOB(e_w_in, mix_g, DM, 3080, 3328 / 64, EIN, 0); TR_JOB(e_w_out, (const float*)nullptr, DM, DM, DM / 64, EOUT, 0); FFN_JOBS(1); }
                    else if (wi == 1) { FFN_JOBS(2); }
                    else { TR_JOB(o_w_in, mix_g + DM, DM, 2048, 2048 / 64, OIN, 3); TR_JOB(o_w_out, (const float*)nullptr, DM, DM, DM / 64, OOUT, 0); FFN_JOBS(3); }
                }
            }
            xcd_barrier(xbar);
            { pg8::Gemm g{BIG, (const bf16_t*)(ws + WS_W2 + wi * W2_BYTES), MP, DM, DFF, DFF}; pg8::StaticOrder S; S.init(MP, DM, G, bid);
              pg8::EpiResid E{(wi == 0) ? x_prompt : (const float*)out, out, XB, SSQ + (si + 1) * MT, 0.5f};
              pg8::gemm_phase<pg8::EpiResid, pg8::StaticOrder, true, true>(ldsa, g, S, E); }
            for (int u = bid; u < 256; u += G) skinny_resid_unit<11>(lds, BIG + (size_t)MP * DFF, (const bf16_t*)(ws + WS_W2 + wi * W2_BYTES), u, (wi == 0) ? x_sample : (const float*)(out + O_YS), out, XB, SSQ + (si + 1) * MT, 0.5f);
            xcd_barrier(xbar);
            if (f == 1) break;
            if (layer == 0) {
                { pg8::Gemm g{XB, EIN, MT, 3328, DM, DM}; pg8::StaticOrder S; S.init(MT, 3328, G, bid);
                  pg8::EpiEvenIn E{SSQ + 1 * MT, BIG, out + O_PK, out + O_PV, out + O_PLF, out + O_SK, out + O_SV, out + O_SLF, e_b_f};
                  pg8::gemm_phase<pg8::EpiEvenIn, pg8::StaticOrder, true, true>(ldsa, g, S, E); }
                xcd_barrier(xbar);
                #ifndef NO_CONVA
                for (int it = bid; it < 258; it += G) conva_item(it, BIG, e_conv_w, st_sconv, CAT, out);
#endif
#ifndef NO_PATTN
                for (int u = bid; u < 256; u += G) { const int bh = u >> 2, role = u & 3, ab = bh >> 3, ah = bh & 7;
                    if (role == 0) attn_sample_unit(lds, ab, ah, BIG, cache_k, cache_v, cache_lf, out + O_SK, out + O_SV, out + O_SLF, CAT);
                    const int nq = (role == 3) ? 3 : (role == 0) ? 1 : 2, qlist = (role == 0) ? 0x5 : (role == 1) ? 0x17 : (role == 2) ? 0x26 : 0x034;
                    for (int i = 0; i < nq; ++i) attn_prompt_unit(lds, ab, ah, (qlist >> (4 * i)) & 15, BIG, out + O_PLF, CAT); }
#endif
                xcd_barrier(xbar);
                { pg8::Gemm g{CAT, EOUT, MP, DM, DM, DM}; pg8::StaticOrder S; S.init(MP, DM, G, bid);
                  pg8::EpiResid E{out, out, XB, SSQ + 2 * MT, 1.0f};
                  pg8::gemm_phase<pg8::EpiResid, pg8::StaticOrder, true, true>(ldsa, g, S, E); }
                for (int u = bid; u < 256; u += G) skinny_resid_unit<4>(lds, CAT + (size_t)MP * DM, EOUT, u, out + O_YS, out, XB, SSQ + 2 * MT, 1.0f);
                xcd_barrier(xbar);
            } else {
                { pg8::Gemm g{XB, OIN, MT, 2048, DM, DM}; pg8::StaticOrder S; S.init(MT, 2048, G, bid);
                  pg8::EpiOddIn E{SSQ + 4 * MT, BIG};
                  pg8::gemm_phase<pg8::EpiOddIn, pg8::StaticOrder, true, true>(ldsa, g, S, E); }
                xcd_barrier(xbar);
#ifndef NO_CCONV
                for (int u = bid; u < 256; u += G) cconv_unit<false>(lds, 64 * u, 0, BIG, o_dw, o_dw_b, o_cn_g, o_cn_b, st_cconv, CAT);
                for (int u = bid; u < 8; u += G) cconv_unit<true>(lds, MP + 16 * u, u, BIG, o_dw, o_dw_b, o_cn_g, o_cn_b, st_cconv, CAT);
#endif
#ifndef NO_GMLP
                for (int u = bid; u < 256; u += G) gmlp_unit(lds, 128 * (u >> 1), u & 1, false, 0, BIG, WSB, o_ln_g, o_ln_b, o_bs, CAT, out);
                for (int u = bid - 8; u < 8; u += G) if (u >= 0) gmlp_sample_unit(lds, u, BIG, WSB, o_ln_g, o_ln_b, o_bs, CAT, out);
#endif
                for (int i = bid * NTHR + opaque_tid(); i < 8 * 30 * 512; i += G * NTHR) { const int c = i & 511, j = (i >> 9) % 30, b = i / (30 * 512);
                    out[O_PCC + i] = bf2f(BIG[(size_t)(b * 2048 + 2018 + j) * 1536 + 1024 + c]);
                    out[O_SCC + i] = (j < 14) ? st_cconv[(size_t)(b * 30 + 16 + j) * 512 + c] : bf2f(BIG[(size_t)(MP + 16 * b + j - 14) * 1536 + 1024 + c]); }
                xcd_barrier(xbar);
                { pg8::Gemm g{CAT, OOUT, MP, DM, DM, DM}; pg8::StaticOrder S; S.init(MP, DM, G, bid);
                  pg8::EpiResid E{out, out, XB, SSQ + 5 * MT, 1.0f};
                  pg8::gemm_phase<pg8::EpiResid, pg8::StaticOrder, true, true>(ldsa, g, S, E); }
                for (int u = bid; u < 256; u += G) skinny_resid_unit<4>(lds, CAT + (size_t)MP * DM, OOUT, u, out + O_YS, out, XB, SSQ + 5 * MT, 1.0f);
                xcd_barrier(xbar);
            }
        }
    }
    const int ftid = opaque_tid(), lane = ftid & 63;
    { const int gwf = bid * NWAVES + (ftid >> 6), NGWF = G * NWAVES; const f32x4* gp = (const f32x4*)final_g + lane;
      f32x4 gv[4];
#pragma unroll
      for (int j = 0; j < 4; ++j) gv[j] = gp[64 * j];
      const int rs_ = MP + gwf; const bool has_s = rs_ < MROWS; f32x4 sv[4];
      if (has_s) {
#pragma unroll
        for (int j = 0; j < 4; ++j) sv[j] = ((const f32x4*)(out + (size_t)rs_ * DM) + lane)[64 * j]; }
      for (int r0 = gwf * 4; r0 < MP; r0 += NGWF * 4) {
        f32x4 v[4][4];
#pragma unroll
        for (int i = 0; i < 4; ++i)
#pragma unroll
            for (int j = 0; j < 4; ++j) v[i][j] = ((const f32x4*)(out + (size_t)(r0 + i) * DM) + lane)[64 * j];
#pragma unroll
        for (int i = 0; i < 4; ++i) { float ss = 0.f;
#pragma unroll
            for (int j = 0; j < 4; ++j) ss += (v[i][j][0] * v[i][j][0] + v[i][j][1] * v[i][j][1]) + (v[i][j][2] * v[i][j][2] + v[i][j][3] * v[i][j][3]);
            const float rs = __builtin_amdgcn_rsqf(wave_sum(ss) * (1.0f / 1024.0f) + RMS_EPS);
#pragma unroll
            for (int j = 0; j < 4; ++j) ((f32x4*)(out + (size_t)(r0 + i) * DM) + lane)[64 * j] = v[i][j] * rs * gv[j]; } }
      if (has_s) { float ss = 0.f;
#pragma unroll
        for (int j = 0; j < 4; ++j) ss += (sv[j][0] * sv[j][0] + sv[j][1] * sv[j][1]) + (sv[j][2] * sv[j][2] + sv[j][3] * sv[j][3]);
        const float rs = __builtin_amdgcn_rsqf(wave_sum(ss) * (1.0f / 1024.0f) + RMS_EPS);
#pragma unroll
        for (int j = 0; j < 4; ++j) ((f32x4*)(out + (size_t)rs_ * DM) + lane)[64 * j] = sv[j] * rs * gv[j]; }
      for (int r = MP + gwf + NGWF; r < MROWS; r += NGWF) { f32x4 v[4]; float ss = 0.f;
#pragma unroll
        for (int j = 0; j < 4; ++j) { v[j] = ((const f32x4*)(out + (size_t)r * DM) + lane)[64 * j]; ss += (v[j][0] * v[j][0] + v[j][1] * v[j][1]) + (v[j][2] * v[j][2] + v[j][3] * v[j][3]); }
        const float rs = __builtin_amdgcn_rsqf(wave_sum(ss) * (1.0f / 1024.0f) + RMS_EPS);
#pragma unroll
        for (int j = 0; j < 4; ++j) ((f32x4*)(out + (size_t)r * DM) + lane)[64 * j] = v[j] * rs * gv[j]; } }
}

extern "C" void kernel_launch(void* const* d_in, const int* in_sizes, int n_in, void* d_out, int out_size, void* d_ws, size_t ws_size, hipStream_t stream) {
    static int grid = 0;
    if (grid == 0) {
        if (n_in != 31 || (size_t)out_size != O_END || ws_size < WS_END) { fprintf(stderr, "kernel_launch: unexpected sizes n_in %d out %d ws %zu\n", n_in, out_size, ws_size); grid = -1; return; }
        int dev = 0, cus = 0, per_cu = 0;
        hipGetDevice(&dev); hipDeviceGetAttribute(&cus, hipDeviceAttributeMultiprocessorCount, dev);
        if (hipFuncSetAttribute((const void*)mega_fwd, hipFuncAttributeMaxDynamicSharedMemorySize, LDS_BYTES) != hipSuccess) { fprintf(stderr, "hipFuncSetAttribute failed\n"); grid = -1; return; }
        hipOccupancyMaxActiveBlocksPerMultiprocessor(&per_cu, (const void*)mega_fwd, NTHR, LDS_BYTES);
        if (per_cu < 1) { fprintf(stderr, "occupancy query says %d blocks/CU\n", per_cu); per_cu = 1; }
        (void)hipGetLastError();
        grid = cus;
    }
    if (grid < 0) return;
    Params p{};
    for (int i = 0; i < 31; ++i) p.in[i] = (const float*)d_in[i];
    p.out = (float*)d_out; p.ws = (unsigned char*)d_ws;
    if (hipMemsetAsync(d_ws, 0, 16384, stream) != hipSuccess) { fprintf(stderr, "memset failed\n"); return; }
    void* args[] = {&p};
    hipError_t e = hipLaunchCooperativeKernel((const void*)mega_fwd, dim3(grid), dim3(NTHR), args, LDS_BYTES, stream);
    if (e != hipSuccess) fprintf(stderr, "cooperative launch failed: %s (grid %d)\n", hipGetErrorString(e), grid);
}
```

```cpp
#include <hip/hip_runtime.h>
#include <hip/hip_cooperative_groups.h>
#include <cstdio>
#include <cstdint>
namespace cg = cooperative_groups;
__device__ __forceinline__ int opaque_tid() { int t = threadIdx.x; asm volatile("" : "+v"(t)); return t; }
namespace pg8 {
#define PG8_LAS __attribute__((address_space(3)))
typedef unsigned short bf16_t;
typedef short bf16x8 __attribute__((ext_vector_type(8)));
typedef float f32x4 __attribute__((ext_vector_type(4)));
typedef unsigned u32x4 __attribute__((ext_vector_type(4)));
constexpr int BM = 256, BK = 64, HALF = 128, HTB = HALF * BK * 2  , STAGE_BYTES = 8 * HTB, NXCD = 8, WGM = 8;

__host__ __device__ __forceinline__ int lds_byte(int r, int c) { const int st = (r >> 4) * 2 + (c >> 5), rr = r & 15, cc = c & 31, ob = rr * 64 + cc * 2; return st * 1024 + (ob ^ (((ob >> 9) & 1) << 5)); }
__host__ __device__ __forceinline__ void stage_rc(int b, int& R, int& C) { const int st = b / 1024, sb = b % 1024, swz = sb ^ (((sb >> 9) & 1) << 5); R = (st >> 1) * 16 + swz / 64; C = (st & 1) * 32 + (swz % 64) / 2; }
__host__ __device__ __forceinline__ int perm32(int rho) { const int n = rho >> 4, i = rho & 15; return 8 * (i >> 2) + 4 * n + (i & 3); }

struct Unit { int pm, pn; int koff = 0; };
struct Gemm { const bf16_t* A; const bf16_t* Bt; int M, N, K; int KL; };

struct StaticOrder {
    int nM, nN, nwg, G, c;
    __host__ __device__ void init(int M, int N, int G_, int c_) { nM = M / BM; nN = N / BM; nwg = nM * nN; G = G_; c = c_; }
    __host__ __device__ bool next(int i, Unit& u) const {
        const long L = (long)i * G + c; if (L >= nwg) return false;
        int wgid = (int)L; { const int q = nwg / NXCD, r = nwg % NXCD, xcd = wgid % NXCD, off = wgid / NXCD; wgid = (xcd < r ? xcd * (q + 1) : r * (q + 1) + (xcd - r) * q) + off; }
        const int nig = WGM * nN, gid = wgid / nig, fm = gid * WGM, gsz = (nM - fm) < WGM ? (nM - fm) : WGM;
        u.pm = fm + ((wgid % nig) % gsz); u.pn = (wgid % nig) / gsz; u.koff = 0; return true;
    }
    __device__ __forceinline__ void a_ready(const Unit&) const {}
    __device__ __forceinline__ void done(const Unit&) const {}
};

typedef float f32x2 __attribute__((ext_vector_type(2)));
typedef __bf16 bf16x2_t __attribute__((ext_vector_type(2)));
__device__ __forceinline__ unsigned pk2(float lo, float hi) { f32x2 v = {lo, hi}; bf16x2_t b = __builtin_convertvector(v, bf16x2_t); return __builtin_bit_cast(unsigned, b); }
__device__ __forceinline__ u32x4 pk8(f32x4 a, f32x4 b) { u32x4 w; w.x = pk2(a[0], a[1]); w.y = pk2(a[2], a[3]); w.z = pk2(b[0], b[1]); w.w = pk2(b[2], b[3]); return w; }
__device__ __forceinline__ float fast_exp(float x) { return __builtin_amdgcn_exp2f(x * 1.4426950408889634f); }
__device__ __forceinline__ float sigmoidf_(float x) { return __builtin_amdgcn_rcpf(1.0f + fast_exp(-x)); }
__device__ __forceinline__ float siluf_(float x) { return x * sigmoidf_(x); }
__device__ __forceinline__ float gelu_tanh(float x) { const float u = 1.5957691216057308f * (x + 0.044715f * x * x * x); return x * sigmoidf_(u); }
constexpr int MROWS = 16512;
constexpr float RMS_EPS = 1e-6f;

struct EpiSwiglu {
    static constexpr bool PERM = true, AFTER_DRAIN = false;
    const float* ssq; bf16_t* O;
    __device__ __forceinline__ void operator()(const f32x4 (&acc)[2][2][4][2], const Unit& u, int wr, int wc, int fr, int fq) const {
        const int row0 = u.pm * BM + wr * 64 + fr, col0 = u.pn * 128 + wc * 32 + 8 * fq;
        float rsv[8];
#pragma unroll
        for (int i = 0; i < 8; ++i) rsv[i] = ssq[row0 + (i >> 2) * HALF + (i & 3) * 16];
#pragma unroll
        for (int i = 0; i < 8; ++i) rsv[i] = __builtin_amdgcn_rsqf(rsv[i] * (1.0f / 1024.0f) + RMS_EPS);
#pragma unroll
        for (int ai = 0; ai < 2; ++ai)
#pragma unroll
            for (int m = 0; m < 4; ++m) { const int row = row0 + ai * HALF + m * 16; const float rs = rsv[ai * 4 + m];
                f32x4 o0, o1;
#pragma unroll
                for (int e = 0; e < 4; ++e) { o0[e] = siluf_(acc[ai][0][m][0][e] * rs) * (acc[ai][1][m][0][e] * rs); o1[e] = siluf_(acc[ai][0][m][1][e] * rs) * (acc[ai][1][m][1][e] * rs); }
                *(u32x4*)(O + (size_t)row * 2816 + col0) = pk8(o0, o1); }
    }
};
struct EpiResid {
    static constexpr bool PERM = true, AFTER_DRAIN = false;
    const float* Xin; float* X; bf16_t* XB; float* ssq_out; float scale;
    __device__ __forceinline__ void operator()(const f32x4 (&acc)[2][2][4][2], const Unit& u, int wr, int wc, int fr, int fq) const {
        const int row0 = u.pm * BM + wr * 64 + fr, col0 = u.pn * BM + wc * 32 + 8 * fq;
#pragma unroll
        for (int ai = 0; ai < 2; ++ai) {
            f32x4 xv[4][2][2];
#pragma unroll
            for (int m = 0; m < 4; ++m) { const int row = row0 + ai * HALF + m * 16; const bool valid = row < MROWS;
#pragma unroll
                for (int bj = 0; bj < 2; ++bj) { const float* xi = Xin + (size_t)row * 1024 + col0 + bj * HALF;
                    xv[m][bj][0] = valid ? *(const f32x4*)xi : (f32x4){0.f, 0.f, 0.f, 0.f}; xv[m][bj][1] = valid ? *(const f32x4*)(xi + 4) : (f32x4){0.f, 0.f, 0.f, 0.f}; } }
            asm volatile("" ::: "memory");
#pragma unroll
            for (int m = 0; m < 4; ++m) { const int row = row0 + ai * HALF + m * 16; const bool valid = row < MROWS; float ss = 0.f;
#pragma unroll
                for (int bj = 0; bj < 2; ++bj) { float* xp = X + (size_t)row * 1024 + col0 + bj * HALF;
                    const f32x4 x0 = xv[m][bj][0] + acc[ai][bj][m][0] * scale, x1 = xv[m][bj][1] + acc[ai][bj][m][1] * scale;
                    if (valid) { *(f32x4*)xp = x0; *(f32x4*)(xp + 4) = x1; }
                    *(u32x4*)(XB + (size_t)row * 1024 + col0 + bj * HALF) = pk8(x0, x1);
                    ss += (x0[0] * x0[0] + x0[1] * x0[1]) + (x0[2] * x0[2] + x0[3] * x0[3]) + (x1[0] * x1[0] + x1[1] * x1[1]) + (x1[2] * x1[2] + x1[3] * x1[3]); }
                ss += __shfl_xor(ss, 16); ss += __shfl_xor(ss, 32);
                if (fq == 0) unsafeAtomicAdd(ssq_out + row, ss); }
            asm volatile("" ::: "memory");
        }
    }
};
constexpr float QSCALE = 0.125f * 1.4426950408889634f;
struct EpiEvenIn {
    static constexpr bool PERM = true, AFTER_DRAIN = false;
    const float* ssq; bf16_t* ZB; float* pk_; float* pv_; float* plf; float* sk_; float* sv_; float* slf; const float* b_f;
    __device__ __forceinline__ void operator()(const f32x4 (&acc)[2][2][4][2], const Unit& u, int wr, int wc, int fr, int fq) const {
        const int row0 = u.pm * BM + wr * 64 + fr, pn = u.pn, lc = wc * 32 + 8 * fq;
        float rsv[8];
#pragma unroll
        for (int i = 0; i < 8; ++i) rsv[i] = ssq[row0 + (i >> 2) * HALF + (i & 3) * 16];
#pragma unroll
        for (int i = 0; i < 8; ++i) rsv[i] = __builtin_amdgcn_rsqf(rsv[i] * (1.0f / 1024.0f) + RMS_EPS);
#pragma unroll
        for (int ai = 0; ai < 2; ++ai)
#pragma unroll
            for (int m = 0; m < 4; ++m) { const int row = row0 + ai * HALF + m * 16; const float rs = rsv[ai * 4 + m];
                if (pn < 12) {
                    const float sc = (pn == 6 || pn == 7) ? rs * QSCALE : rs;
#pragma unroll
                    for (int bj = 0; bj < 2; ++bj) { const int col = pn * BM + bj * HALF + lc; const f32x4 v0 = acc[ai][bj][m][0] * sc, v1 = acc[ai][bj][m][1] * sc;
                        *(u32x4*)(ZB + (size_t)row * 3072 + col) = pk8(v0, v1);
                        if (pn >= 8 && row < MROWS) { const int cc = (pn >= 10) ? col - 2560 : col - 2048;
                            float* dst = (row < 16384) ? ((pn >= 10 ? pv_ : pk_) + (size_t)row * 512 + cc) : ((pn >= 10 ? sv_ : sk_) + (size_t)(row - 16384) * 512 + cc);
                            *(f32x4*)dst = v0; *(f32x4*)(dst + 4) = v1; } }
                } else if (wc == 0 && fq == 0 && row < MROWS) {
                    float* dst = (row < 16384) ? plf + (size_t)row * 8 : slf + (size_t)(row - 16384) * 8; f32x4 o0, o1;
#pragma unroll
                    for (int e = 0; e < 4; ++e) { const float a = acc[ai][0][m][0][e] * rs + b_f[e], b = acc[ai][0][m][1][e] * rs + b_f[4 + e];
                        o0[e] = fminf(a, 0.f) - log1pf(__expf(-fabsf(a))); o1[e] = fminf(b, 0.f) - log1pf(__expf(-fabsf(b))); }
                    *(f32x4*)dst = o0; *(f32x4*)(dst + 4) = o1; }
            }
    }
};
struct EpiOddIn {
    static constexpr bool PERM = true, AFTER_DRAIN = false;
    const float* ssq; bf16_t* ZO;
    __device__ __forceinline__ void operator()(const f32x4 (&acc)[2][2][4][2], const Unit& u, int wr, int wc, int fr, int fq) const {
        const int row0 = u.pm * BM + wr * 64 + fr, pn = u.pn, lc = wc * 32 + 8 * fq;
        float rsv[8];
#pragma unroll
        for (int i = 0; i < 8; ++i) rsv[i] = ssq[row0 + (i >> 2) * HALF + (i & 3) * 16];
#pragma unroll
        for (int i = 0; i < 8; ++i) rsv[i] = __builtin_amdgcn_rsqf(rsv[i] * (1.0f / 1024.0f) + RMS_EPS);
#pragma unroll
        for (int ai = 0; ai < 2; ++ai)
#pragma unroll
            for (int m = 0; m < 4; ++m) { const int row = row0 + ai * HALF + m * 16; const float rs = rsv[ai * 4 + m];
                if (pn < 4) {
#pragma unroll
                    for (int bj = 0; bj < 2; ++bj) { f32x4 v0, v1;
#pragma unroll
                        for (int e = 0; e < 4; ++e) { v0[e] = gelu_tanh(acc[ai][bj][m][0][e] * rs); v1[e] = gelu_tanh(acc[ai][bj][m][1][e] * rs); }
                        *(u32x4*)(ZO + (size_t)row * 1536 + pn * BM + bj * HALF + lc) = pk8(v0, v1); }
                } else { f32x4 v0, v1;
#pragma unroll
                    for (int e = 0; e < 4; ++e) { v0[e] = acc[ai][0][m][0][e] * rs * sigmoidf_(acc[ai][1][m][0][e] * rs); v1[e] = acc[ai][0][m][1][e] * rs * sigmoidf_(acc[ai][1][m][1][e] * rs); }
                    *(u32x4*)(ZO + (size_t)row * 1536 + 1024 + (pn - 4) * HALF + lc) = pk8(v0, v1); }
            }
    }
};

struct ChunkOrder {
    int c, nchunk;
    __device__ __forceinline__ bool next(int i, Unit& u) const { if (i > 0 || c >= nchunk) return false; u.pm = 64; u.pn = c & 3; u.koff = (c >> 2) * 512; return true; }
    __device__ __forceinline__ void a_ready(const Unit&) const {}
    __device__ __forceinline__ void done(const Unit&) const {}
};
struct EpiAtomX {
    static constexpr bool PERM = true, AFTER_DRAIN = false;
    float* X; float scale;
    __device__ __forceinline__ void operator()(const f32x4 (&acc)[2][2][4][2], const Unit& u, int wr, int wc, int fr, int fq) const {
        const int row0 = u.pm * BM + wr * 64 + fr, col0 = u.pn * BM + wc * 32 + 8 * fq;
#pragma unroll
        for (int m = 0; m < 4; ++m) { const int row = row0 + m * 16;
#pragma unroll
            for (int bj = 0; bj < 2; ++bj) { float* xp = X + (size_t)row * 1024 + col0 + bj * HALF;
#pragma unroll
                for (int e = 0; e < 4; ++e) { unsafeAtomicAdd(xp + e, acc[0][bj][m][0][e] * scale); unsafeAtomicAdd(xp + 4 + e, acc[0][bj][m][1][e] * scale); } } }
    }
};
template <class Epi, class Sched, bool ALIGN_EPI = false, bool SP2 = false>
__device__ __forceinline__ void gemm_phase(PG8_LAS unsigned char* lds, const Gemm g, const Sched& S, const Epi& E) {
    const int tid = opaque_tid(), wid = __builtin_amdgcn_readfirstlane(tid >> 6), lane = tid & 63, wr = wid >> 2, wc = wid & 3, fr = lane & 15, fq = lane >> 4;
    const int K = g.K, nt = g.KL / BK;
    unsigned voffA[2], voffB[2];
#pragma unroll
    for (int i = 0; i < 2; ++i) { int R, C; stage_rc(tid * 16 + i * 8192, R, C); const int Rb = Epi::PERM ? ((R & ~31) + perm32(R & 31)) : R;
        voffA[i] = (unsigned)(R * K + C) * 2u; voffB[i] = (unsigned)(Rb * K + C) * 2u; }
    const size_t kstep = (size_t)(BK * 2);
    const size_t hstep = (size_t)HALF * K * 2;
    const size_t tstep = 2 * hstep;
    const unsigned ldsw = (unsigned)wid * 1024u;
    const int aoff = lds_byte(wr * 64 + fr, fq * 8), boff = lds_byte(wc * 32 + fr, fq * 8);
#define PG8_SA(b, h) (((b) * 2 + (h)) * HTB)
#define PG8_SB(b, h) ((4 + (b) * 2 + (h)) * HTB)
#define PG8_STAGE(bufoff, gbase, voff) do { _Pragma("unroll") for (int _i = 0; _i < 2; ++_i) \
        __builtin_amdgcn_global_load_lds((const unsigned*)((const char*)(gbase) + (voff)[_i]), (PG8_LAS unsigned*)(lds + (bufoff) + ldsw + _i * 8192), 16, 0, 0); } while (0)
#define PG8_LDA(dst, b, h) do { _Pragma("unroll") for (int m = 0; m < 4; ++m) _Pragma("unroll") for (int k = 0; k < 2; ++k) dst[m][k] = *(const PG8_LAS bf16x8*)(lds + PG8_SA(b, h) + aoff + m * 2048 + k * 1024); } while (0)
#define PG8_LDB(dst, b, h) do { _Pragma("unroll") for (int n = 0; n < 2; ++n) _Pragma("unroll") for (int k = 0; k < 2; ++k) dst[n][k] = *(const PG8_LAS bf16x8*)(lds + PG8_SB(b, h) + boff + n * 2048 + k * 1024); } while (0)
#define PG8_MMA(ai, bj, At, Bt) do { __builtin_amdgcn_s_setprio(1); _Pragma("unroll") for (int m = 0; m < 4; ++m) _Pragma("unroll") for (int n = 0; n < 2; ++n) _Pragma("unroll") for (int k = 0; k < 2; ++k) \
        acc[ai][bj][m][n] = __builtin_amdgcn_mfma_f32_16x16x32_bf16(Bt[n][k], At[m][k], acc[ai][bj][m][n], 0, 0, 0); __builtin_amdgcn_s_setprio(0); } while (0)
#define PG8_WAIT_V(n) asm volatile("s_waitcnt vmcnt(" #n ")" ::: "memory")
#define PG8_WAIT_L(n) asm volatile("s_waitcnt lgkmcnt(" #n ")" ::: "memory")
#define PG8_BAR __builtin_amdgcn_s_barrier()
#define PG8_SCHED __builtin_amdgcn_sched_barrier(0)
    Unit cur, nxt; int ui = 0;
    if (!S.next(0, cur)) return;
    f32x4 acc[2][2][4][2];
#pragma unroll
    for (int a = 0; a < 2; ++a)
#pragma unroll
        for (int b = 0; b < 2; ++b)
#pragma unroll
            for (int m = 0; m < 4; ++m)
#pragma unroll
                for (int n = 0; n < 2; ++n) acc[a][b][m][n] = (f32x4){0.f, 0.f, 0.f, 0.f};
    bf16x8 At[4][2], B0[2][2], B1[2][2];
    const char* cA = (const char*)g.A + (size_t)cur.pm * tstep + cur.koff; const char* cB = (const char*)g.Bt + (size_t)cur.pn * tstep + cur.koff;
    S.a_ready(cur);
    if constexpr (SP2) {
        PG8_STAGE(PG8_SB(0, 0), cB, voffB); PG8_STAGE(PG8_SB(0, 1), cB + hstep, voffB); PG8_STAGE(PG8_SA(0, 0), cA, voffA); PG8_STAGE(PG8_SA(0, 1), cA + hstep, voffA);
        if (wr == 1) PG8_BAR;
        PG8_WAIT_V(2); PG8_BAR;
        PG8_STAGE(PG8_SB(1, 0), cB + kstep, voffB); PG8_STAGE(PG8_SA(1, 0), cA + kstep, voffA); PG8_STAGE(PG8_SB(1, 1), cB + hstep + kstep, voffB);
        PG8_WAIT_V(6); PG8_BAR;
    } else {
        PG8_STAGE(PG8_SB(0, 0), cB, voffB); PG8_STAGE(PG8_SA(0, 0), cA, voffA); PG8_STAGE(PG8_SB(0, 1), cB + hstep, voffB); PG8_STAGE(PG8_SA(0, 1), cA + hstep, voffA);
        if (wr == 1) PG8_BAR;
        PG8_WAIT_V(4); PG8_BAR;
        PG8_STAGE(PG8_SB(1, 0), cB + kstep, voffB); PG8_STAGE(PG8_SA(1, 0), cA + kstep, voffA); PG8_STAGE(PG8_SB(1, 1), cB + hstep + kstep, voffB);
        PG8_WAIT_V(6); PG8_BAR;
    }
    for (;;) {
        const bool has_next = S.next(ui + 1, nxt);
        const char* nA = has_next ? (const char*)g.A + (size_t)nxt.pm * tstep + nxt.koff : cA; const char* nB = has_next ? (const char*)g.Bt + (size_t)nxt.pn * tstep + nxt.koff : cB;
        for (int t = 0; t < nt; t += 2) {
            const bool last = (t == nt - 2);
            const char* a1 = cA + (size_t)(t + 1) * kstep;
            const char* a2 = last ? nA : cA + (size_t)(t + 2) * kstep; const char* b2 = last ? nB : cB + (size_t)(t + 2) * kstep;
            const char* a3 = a2 + kstep; const char* b3 = b2 + kstep;
            if (last && has_next) S.a_ready(nxt);
            if constexpr (SP2) {
            PG8_LDB(B0, 0, 0); PG8_LDB(B1, 0, 1); PG8_SCHED; PG8_LDA(At, 0, 0); PG8_STAGE(PG8_SA(1, 1), a1 + hstep, voffA);
            PG8_WAIT_V(8); PG8_WAIT_L(0); PG8_BAR; PG8_MMA(0, 0, At, B0); PG8_MMA(0, 1, At, B1); PG8_BAR; PG8_SCHED;
            PG8_LDA(At, 0, 1); PG8_STAGE(PG8_SB(0, 0), b2, voffB); PG8_STAGE(PG8_SB(0, 1), b2 + hstep, voffB); PG8_STAGE(PG8_SA(0, 0), a2, voffA);
            PG8_WAIT_V(8); PG8_WAIT_L(0); PG8_BAR; PG8_MMA(1, 0, At, B0); PG8_MMA(1, 1, At, B1); PG8_BAR; PG8_SCHED;
            PG8_LDB(B0, 1, 0); PG8_LDB(B1, 1, 1); PG8_SCHED; PG8_LDA(At, 1, 0); PG8_STAGE(PG8_SA(0, 1), a2 + hstep, voffA);
            PG8_WAIT_V(8); PG8_WAIT_L(0); PG8_BAR; PG8_MMA(0, 0, At, B0); PG8_MMA(0, 1, At, B1); PG8_BAR; PG8_SCHED;
            PG8_LDA(At, 1, 1); PG8_STAGE(PG8_SB(1, 0), b3, voffB); PG8_STAGE(PG8_SB(1, 1), b3 + hstep, voffB); PG8_STAGE(PG8_SA(1, 0), a3, voffA);
            PG8_WAIT_V(8); PG8_WAIT_L(0); PG8_BAR; PG8_MMA(1, 0, At, B0); PG8_MMA(1, 1, At, B1); PG8_BAR; PG8_SCHED;
            } else {
            PG8_LDB(B0, 0, 0); PG8_SCHED; PG8_LDA(At, 0, 0); PG8_STAGE(PG8_SA(1, 1), a1 + hstep, voffA);
            PG8_WAIT_L(8); PG8_BAR; PG8_WAIT_L(0); PG8_MMA(0, 0, At, B0); PG8_BAR; PG8_SCHED;
            PG8_LDB(B1, 0, 1); PG8_STAGE(PG8_SB(0, 0), b2, voffB);
            PG8_BAR; PG8_WAIT_L(0); PG8_MMA(0, 1, At, B1); PG8_BAR;
            PG8_LDA(At, 0, 1); PG8_STAGE(PG8_SA(0, 0), a2, voffA);
            PG8_BAR; PG8_WAIT_L(0); PG8_MMA(1, 0, At, B0); PG8_BAR; PG8_SCHED;
            PG8_STAGE(PG8_SB(0, 1), b2 + hstep, voffB);
            PG8_WAIT_V(6); PG8_BAR; PG8_MMA(1, 1, At, B1); PG8_BAR;
            PG8_LDB(B0, 1, 0); PG8_SCHED; PG8_LDA(At, 1, 0); PG8_STAGE(PG8_SA(0, 1), a2 + hstep, voffA);
            PG8_WAIT_L(8); PG8_BAR; PG8_WAIT_L(0); PG8_MMA(0, 0, At, B0); PG8_BAR; PG8_SCHED;
            PG8_LDB(B1, 1, 1); PG8_STAGE(PG8_SB(1, 0), b3, voffB);
            PG8_BAR; PG8_WAIT_L(0); PG8_MMA(0, 1, At, B1); PG8_BAR;
            PG8_LDA(At, 1, 1); PG8_STAGE(PG8_SA(1, 0), a3, voffA);
            PG8_BAR; PG8_WAIT_L(0); PG8_MMA(1, 0, At, B0); PG8_BAR; PG8_SCHED;
            PG8_STAGE(PG8_SB(1, 1), b3 + hstep, voffB);
            PG8_WAIT_V(6); PG8_BAR; PG8_MMA(1, 1, At, B1); PG8_BAR;
            }
        }
        if constexpr (ALIGN_EPI) { if (wr == 0) PG8_BAR; }
        if constexpr (!Epi::AFTER_DRAIN) { E(acc, cur, wr, wc, fr, fq); S.done(cur); }
        if (!has_next) break;
#pragma unroll
        for (int a = 0; a < 2; ++a)
#pragma unroll
            for (int b = 0; b < 2; ++b)
#pragma unroll
                for (int m = 0; m < 4; ++m)
#pragma unroll
                    for (int n = 0; n < 2; ++n) acc[a][b][m][n] = (f32x4){0.f, 0.f, 0.f, 0.f};
        cur = nxt; cA = nA; cB = nB; ++ui;
        if constexpr (ALIGN_EPI) { if (wr == 1) PG8_BAR; }
    }
    PG8_WAIT_V(0);
    if constexpr (!ALIGN_EPI) { if (wr == 0) PG8_BAR; }
    PG8_BAR;
    if constexpr (Epi::AFTER_DRAIN) { E.fused(acc, cur, wr, wc, fr, fq, lds, wid, lane); S.done(cur); }
#undef PG8_SA
#undef PG8_SB
#undef PG8_STAGE
#undef PG8_LDA
#undef PG8_LDB
#undef PG8_MMA
#undef PG8_WAIT_V
#undef PG8_WAIT_L
#undef PG8_BAR
#undef PG8_SCHED
}
}
typedef unsigned short bf16_t;
typedef short bf16x8 __attribute__((ext_vector_type(8)));
typedef float f32x4 __attribute__((ext_vector_type(4)));
typedef float f32x16 __attribute__((ext_vector_type(16)));
typedef unsigned u32x4 __attribute__((ext_vector_type(4)));
typedef unsigned u32x2 __attribute__((ext_vector_type(2)));
using pg8::pk2; using pg8::pk8; using pg8::MROWS; using pg8::RMS_EPS;
constexpr int NTHR = 512, NWAVES = 8;
constexpr int MP = 16384, MT = 16640, DM = 1024, DFF = 2816;
constexpr size_t MiB = 1u << 20;
constexpr size_t WS_SSQ = 1 * MiB, WS_WSB = 2 * MiB, WS_W1 = 3 * MiB, WS_W2 = 47 * MiB, WS_EIN = 69 * MiB, WS_EOUT = 76 * MiB, WS_OIN = 78 * MiB, WS_OOUT = 82 * MiB,
                 WS_XB = 84 * MiB, WS_CAT = 117 * MiB, WS_BIG = 150 * MiB, WS_END = 248 * MiB;
constexpr size_t W1_BYTES = 11 * MiB, W2_BYTES = 5767168;
constexpr int LDS_BYTES = 147456;
constexpr size_t O_YP = 0, O_YS = 16777216, O_PK = O_YS + 131072, O_PV = O_PK + 8388608, O_PLF = O_PV + 8388608, O_PSC = O_PLF + 131072, O_PCC = O_PSC + 8192,
                 O_SK = O_PCC + 122880, O_SV = O_SK + 65536, O_SLF = O_SV + 65536, O_SSC = O_SLF + 1024, O_SCC = O_SSC + 8192, O_SGV = O_SCC + 122880, O_END = O_SGV + 65536;
constexpr float LOG2E = 1.4426950408889634f;

struct Params { const float* in[31]; float* out; unsigned char* ws; };

__device__ __forceinline__ float sum_xor32(float v) { const auto rr = __builtin_amdgcn_permlane32_swap(__float_as_uint(v), __float_as_uint(v), false, false); return __uint_as_float(rr[0]) + __uint_as_float(rr[1]); }
__device__ __forceinline__ float max_xor32(float v) { const auto rr = __builtin_amdgcn_permlane32_swap(__float_as_uint(v), __float_as_uint(v), false, false); return fmaxf(__uint_as_float(rr[0]), __uint_as_float(rr[1])); }
__device__ __forceinline__ float sum_xor16(float v) { const auto rr = __builtin_amdgcn_permlane16_swap(__float_as_uint(v), __float_as_uint(v), false, false); return __uint_as_float(rr[0]) + __uint_as_float(rr[1]); }
__device__ __forceinline__ float wave_sum(float v) {
    v += __builtin_bit_cast(float, __builtin_amdgcn_mov_dpp(__builtin_bit_cast(int, v), 0xB1, 0xF, 0xF, true));
    v += __builtin_bit_cast(float, __builtin_amdgcn_mov_dpp(__builtin_bit_cast(int, v), 0x4E, 0xF, 0xF, true));
    v += __builtin_bit_cast(float, __builtin_amdgcn_mov_dpp(__builtin_bit_cast(int, v), 0x141, 0xF, 0xF, true));
    v += __builtin_bit_cast(float, __builtin_amdgcn_mov_dpp(__builtin_bit_cast(int, v), 0x140, 0xF, 0xF, true));
    v = sum_xor16(v); v = sum_xor32(v);
    return v;
}
__device__ __forceinline__ float bf2f(unsigned short b) { return __uint_as_float((unsigned)b << 16); }
__device__ __forceinline__ float bflo(unsigned w) { return __uint_as_float(w << 16); }
__device__ __forceinline__ float bfhi(unsigned w) { return __uint_as_float(w & 0xffff0000u); }

__device__ __forceinline__ int map_row(int mode, int n0) {
    if (mode == 0) return n0;
    if (mode == 1) return (n0 >> 7) * 256 + (n0 & 127);
    if (mode == 2) return (n0 >> 7) * 256 + 128 + (n0 & 127);
    if (n0 < 1024) return n0;
    if (n0 < 1536) { const int j = n0 - 1024; return 1024 + (j >> 7) * 256 + (j & 127); }
    { const int j = n0 - 1536; return 1024 + (j >> 7) * 256 + 128 + (j & 127); }
}
__device__ __forceinline__ void tr_item(const float* __restrict__ W, const float* __restrict__ gain, int K, int Nsrc, int nblk, bf16_t* WT, int mode, float* scr, int item, int lane) {
    const int kb = item / nblk, nb = item - kb * nblk, k0 = 64 * kb, n0 = 64 * nb;
    const int kr = lane >> 4, n4 = (lane & 15) * 4; const bool nv = (n0 + n4) < Nsrc;
    f32x4 v[16];
#pragma unroll
    for (int i = 0; i < 16; ++i) v[i] = nv ? *(const f32x4*)(W + (size_t)(k0 + 4 * i + kr) * Nsrc + n0 + n4) : (f32x4){0.f, 0.f, 0.f, 0.f};
    if (gain) {
#pragma unroll
        for (int i = 0; i < 16; ++i) v[i] *= gain[k0 + 4 * i + kr]; }
#pragma unroll
    for (int i = 0; i < 16; ++i) { float* d = scr + (4 * i + kr) * 65 + n4; d[0] = v[i][0]; d[1] = v[i][1]; d[2] = v[i][2]; d[3] = v[i][3]; }
    asm volatile("s_waitcnt lgkmcnt(0)" ::: "memory");
    const int rb = map_row(mode, n0);
#pragma unroll
    for (int jj = 0; jj < 8; ++jj) { const int id = lane + 64 * jj, nn = id >> 3, c = id & 7; const float* s = scr + (8 * c) * 65 + nn;
        u32x4 o; o.x = pk2(s[0 * 65], s[1 * 65]); o.y = pk2(s[2 * 65], s[3 * 65]); o.z = pk2(s[4 * 65], s[5 * 65]); o.w = pk2(s[6 * 65], s[7 * 65]);
        *(u32x4*)(WT + (size_t)(rb + nn) * K + k0 + 8 * c) = o; }
    asm volatile("s_waitcnt lgkmcnt(0)" ::: "memory");
}

__device__ __forceinline__ int crow(int r, int hi) { return (r & 3) + 8 * (r >> 2) + 4 * hi; }
struct AttnState { float m, l; f32x16 o[2]; };
template <bool MASK> __device__ __forceinline__ void attn_tile(AttnState& st, const bf16x8 (&kf)[2][4], const bf16x8 (&vf)[2][4], const bf16x8 (&qr)[4], const float* clt, int hi, int kv_limit) {
    f32x16 p[2];
#pragma unroll
    for (int kvb = 0; kvb < 2; ++kvb) {
#pragma unroll
        for (int r4 = 0; r4 < 4; ++r4) { const f32x4 bv = *(const f32x4*)(clt + 32 * kvb + 8 * r4 + 4 * hi);
            p[kvb][4 * r4] = bv[0]; p[kvb][4 * r4 + 1] = bv[1]; p[kvb][4 * r4 + 2] = bv[2]; p[kvb][4 * r4 + 3] = bv[3]; }
#pragma unroll
        for (int d0 = 0; d0 < 4; ++d0) p[kvb] = __builtin_amdgcn_mfma_f32_32x32x16_bf16(kf[kvb][d0], qr[d0], p[kvb], 0, 0, 0); }
    float mx = -1e30f;
#pragma unroll
    for (int kvb = 0; kvb < 2; ++kvb)
#pragma unroll
        for (int r = 0; r < 16; ++r) { float s = p[kvb][r];
            if (MASK) { const int kvl = 32 * kvb + 8 * (r >> 2) + 4 * hi + (r & 3); s = (kvl > kv_limit) ? -1e30f : s; p[kvb][r] = s; }
            mx = fmaxf(mx, s); }
    mx = max_xor32(mx);
    const float mn = fmaxf(st.m, mx), alpha = __builtin_amdgcn_exp2f(st.m - mn); st.m = mn;
    float ls = 0.f;
#pragma unroll
    for (int kvb = 0; kvb < 2; ++kvb)
#pragma unroll
        for (int r = 0; r < 16; ++r) { const float e = __builtin_amdgcn_exp2f(p[kvb][r] - mn); p[kvb][r] = e; ls += e; }
    st.l = st.l * alpha + ls;
#pragma unroll
    for (int db = 0; db < 2; ++db)
#pragma unroll
        for (int r = 0; r < 16; ++r) st.o[db][r] *= alpha;
    bf16x8 pb[4];
#pragma unroll
    for (int s = 0; s < 4; ++s) { const int kvb = s >> 1, b0 = 8 * (s & 1);
        u32x4 w; w.x = pk2(p[kvb][b0 + 0], p[kvb][b0 + 1]); w.y = pk2(p[kvb][b0 + 2], p[kvb][b0 + 3]); w.z = pk2(p[kvb][b0 + 4], p[kvb][b0 + 5]); w.w = pk2(p[kvb][b0 + 6], p[kvb][b0 + 7]);
        pb[s] = __builtin_bit_cast(bf16x8, w); }
#pragma unroll
    for (int db = 0; db < 2; ++db)
#pragma unroll
        for (int s = 0; s < 4; ++s) st.o[db] = __builtin_amdgcn_mfma_f32_32x32x16_bf16(vf[db][s], pb[s], st.o[db], 0, 0, 0);
}
template <int NV, class F> __device__ __forceinline__ void block_cumsum(float* cl, float* tmp, F getv, int tid, int lane, int wid) {
    float v[NV];
#pragma unroll
    for (int e = 0; e < NV; ++e) v[e] = getv(NV * tid + e);
#pragma unroll
    for (int e = 1; e < NV; ++e) v[e] += v[e - 1];
    const float tot = v[NV - 1]; float sc = tot;
#pragma unroll
    for (int off = 1; off < 64; off <<= 1) { const float t = __shfl_up(sc, off); if (lane >= off) sc += t; }
    if (lane == 63) tmp[wid] = sc;
    __syncthreads();
    float base = 0.f;
#pragma unroll
    for (int w = 0; w < 8; ++w) base += (w < wid) ? tmp[w] : 0.f;
    const float excl = base + sc - tot;
#pragma unroll
    for (int e = 0; e < NV; ++e) cl[NV * tid + e] = -(excl + v[e]) * LOG2E;
}
constexpr int AL_KS = 0, AL_VT = 18432, AL_CL = 35840, AL_TMP = 35840 + 10240, AL_OW = 49152, AL_ML = 49152 + 65536, AL_SK = 49152;

__device__ __forceinline__ void attn_prompt_unit(unsigned char* lds, int b, int h, int qb, const bf16_t* __restrict__ ZB, const float* __restrict__ logf, bf16_t* CAT) {
    const int tid = opaque_tid(), lane = tid & 63, wid = __builtin_amdgcn_readfirstlane(tid >> 6), r32 = lane & 31, hi = lane >> 5;
    float* cl = (float*)(lds + AL_CL); float* tmp = (float*)(lds + AL_TMP);
    const int rowbase = b * 2048, q0 = qb * 256, NT = 4 * (qb + 1), nk = NT * 64;
    const bf16_t* Qp = ZB + (size_t)(rowbase + q0 + 32 * wid + r32) * 3072 + 1536 + h * 64;
    bf16x8 qr[4];
#pragma unroll
    for (int d0 = 0; d0 < 4; ++d0) qr[d0] = *(const bf16x8*)(Qp + 16 * d0 + 8 * hi);
    const int lkv = tid >> 3, lch = tid & 7;
    const bf16_t* Kg = ZB + (size_t)(rowbase + lkv) * 3072 + 2048 + h * 64 + 8 * lch;
    const bf16_t* Vg = ZB + (size_t)(rowbase + lane) * 3072 + 2560 + h * 64 + 8 * wid;
    u32x4 kreg = *(const u32x4*)Kg, vreg = *(const u32x4*)Vg;
    block_cumsum<4>(cl, tmp, [&](int k) { return (k < nk) ? logf[(size_t)(rowbase + k) * 8 + h] : 0.f; }, tid, lane, wid);
    auto stage = [&](int buf) {
        *(u32x4*)(lds + AL_KS + buf * 9216 + lkv * 144 + lch * 16) = kreg;
        unsigned short* vt = (unsigned short*)(lds + AL_VT + buf * 8704) + (8 * wid) * 68 + lane;
        vt[0 * 68] = (unsigned short)(vreg.x & 0xffff); vt[1 * 68] = (unsigned short)(vreg.x >> 16); vt[2 * 68] = (unsigned short)(vreg.y & 0xffff); vt[3 * 68] = (unsigned short)(vreg.y >> 16);
        vt[4 * 68] = (unsigned short)(vreg.z & 0xffff); vt[5 * 68] = (unsigned short)(vreg.z >> 16); vt[6 * 68] = (unsigned short)(vreg.w & 0xffff); vt[7 * 68] = (unsigned short)(vreg.w >> 16); };
    stage(0);
    __syncthreads();
    AttnState st; st.m = -1e30f; st.l = 0.f; st.o[0] = f32x16{}; st.o[1] = f32x16{};
    const int qg = q0 + 32 * wid + r32;
    for (int t = 0; t < NT; ++t) {
        if (t + 1 < NT) { kreg = *(const u32x4*)(Kg + (size_t)(t + 1) * 64 * 3072); vreg = *(const u32x4*)(Vg + (size_t)(t + 1) * 64 * 3072); }
        if (64 * t <= q0 + 32 * wid + 31) {
            const unsigned char* ks = lds + AL_KS + (t & 1) * 9216; const unsigned char* vt = lds + AL_VT + (t & 1) * 8704;
            bf16x8 kf[2][4], vf[2][4];
#pragma unroll
            for (int kvb = 0; kvb < 2; ++kvb)
#pragma unroll
                for (int d0 = 0; d0 < 4; ++d0) kf[kvb][d0] = *(const bf16x8*)(ks + (32 * kvb + r32) * 144 + (16 * d0 + 8 * hi) * 2);
#pragma unroll
            for (int db = 0; db < 2; ++db)
#pragma unroll
                for (int s = 0; s < 4; ++s) { const unsigned char* p = vt + (32 * db + r32) * 136 + (16 * s + 4 * hi) * 2; const u32x2 lo = *(const u32x2*)p, hv = *(const u32x2*)(p + 16);
                    vf[db][s] = __builtin_bit_cast(bf16x8, (u32x4){lo.x, lo.y, hv.x, hv.y}); }
            if (64 * t + 63 > q0 + 32 * wid) attn_tile<true>(st, kf, vf, qr, cl + 64 * t, hi, qg - 64 * t); else attn_tile<false>(st, kf, vf, qr, cl + 64 * t, hi, 64);
        }
        if (t + 1 < NT) stage((t + 1) & 1);
        __syncthreads();
    }
    const float lt = sum_xor32(st.l), inv = 1.0f / lt;
    bf16_t* Op = CAT + (size_t)(rowbase + qg) * 1024 + 512 + h * 64 + 4 * hi;
#pragma unroll
    for (int db = 0; db < 2; ++db)
#pragma unroll
        for (int r4 = 0; r4 < 4; ++r4) { u32x2 w; w.x = pk2(st.o[db][4 * r4] * inv, st.o[db][4 * r4 + 1] * inv); w.y = pk2(st.o[db][4 * r4 + 2] * inv, st.o[db][4 * r4 + 3] * inv);
            *(u32x2*)(Op + 32 * db + 8 * r4) = w; }
}

__device__ __forceinline__ void attn_sample_unit(unsigned char* lds, int b, int h, const bf16_t* __restrict__ ZB, const float* __restrict__ cK, const float* __restrict__ cV, const float* __restrict__ cLF,
                                                 const float* __restrict__ nK, const float* __restrict__ nV, const float* __restrict__ nLF, bf16_t* CAT) {
    const int tid = opaque_tid(), lane = tid & 63, wid = __builtin_amdgcn_readfirstlane(tid >> 6), r32 = lane & 31, hi = lane >> 5;
    float* cl = (float*)(lds + AL_CL); float* tmp = (float*)(lds + AL_TMP);
    block_cumsum<5>(cl, tmp, [&](int k) { return (k < 2048) ? cLF[(size_t)(b * 2048 + k) * 8 + h] : ((k < 2064) ? nLF[(size_t)(b * 16 + k - 2048) * 8 + h] : 0.f); }, tid, lane, wid);
    __syncthreads();
    const bf16_t* Qp = ZB + (size_t)(MP + 16 * b + r32) * 3072 + 1536 + h * 64;
    bf16x8 qr[4];
#pragma unroll
    for (int d0 = 0; d0 < 4; ++d0) qr[d0] = *(const bf16x8*)(Qp + 16 * d0 + 8 * hi);
    AttnState st; st.m = -1e30f; st.l = 0.f; st.o[0] = f32x16{}; st.o[1] = f32x16{};
    auto rowp = [&](const float* c, const float* n, int kv) -> const float* {
        return (kv < 2048) ? c + ((size_t)(b * 2048 + kv) * 8 + h) * 64 : n + ((size_t)(b * 16 + min(kv - 2048, 15)) * 8 + h) * 64; };
    for (int t = wid; t < 33; t += 8) {
        bf16x8 kf[2][4], vf[2][4];
        {
            unsigned char* kst = lds + AL_SK + wid * 9216; f32x4 kr[16], vr[16];
#pragma unroll
            for (int i = 0; i < 16; ++i) kr[i] = *(const f32x4*)(rowp(cK, nK, 64 * t + 4 * i + (lane >> 4)) + 4 * (lane & 15));
#pragma unroll
            for (int i = 0; i < 16; ++i) { u32x2 w; w.x = pk2(kr[i][0], kr[i][1]); w.y = pk2(kr[i][2], kr[i][3]); *(u32x2*)(kst + (4 * i + (lane >> 4)) * 144 + (lane & 15) * 8) = w; }
#pragma unroll
            for (int i = 0; i < 16; ++i) vr[i] = *(const f32x4*)(rowp(cV, nV, 64 * t + 4 * i + (lane >> 4)) + 4 * (lane & 15));
            asm volatile("s_waitcnt lgkmcnt(0)" ::: "memory");
#pragma unroll
            for (int kvb = 0; kvb < 2; ++kvb)
#pragma unroll
                for (int d0 = 0; d0 < 4; ++d0) kf[kvb][d0] = *(const bf16x8*)(kst + (32 * kvb + r32) * 144 + (16 * d0 + 8 * hi) * 2);
            asm volatile("s_waitcnt lgkmcnt(0)" ::: "memory");
#pragma unroll
            for (int i = 0; i < 16; ++i) { u32x2 w; w.x = pk2(vr[i][0], vr[i][1]); w.y = pk2(vr[i][2], vr[i][3]); *(u32x2*)(kst + (4 * i + (lane >> 4)) * 144 + (lane & 15) * 8) = w; }
            asm volatile("s_waitcnt lgkmcnt(0)" ::: "memory");
#pragma unroll
            for (int s = 0; s < 4; ++s)
#pragma unroll
                for (int db = 0; db < 2; ++db) { unsigned e[8];
#pragma unroll
                    for (int j = 0; j < 8; ++j) e[j] = *(const unsigned short*)(kst + (16 * s + 4 * hi + (j & 3) + 8 * (j >> 2)) * 144 + (32 * db + r32) * 2);
                    vf[db][s] = __builtin_bit_cast(bf16x8, (u32x4){e[0] | (e[1] << 16), e[2] | (e[3] << 16), e[4] | (e[5] << 16), e[6] | (e[7] << 16)}); }
            asm volatile("s_waitcnt lgkmcnt(0)" ::: "memory");
        }
        attn_tile<true>(st, kf, vf, qr, cl + 64 * t, hi, 2048 + r32 - 64 * t);
    }
    __syncthreads();
    const float lt = sum_xor32(st.l);
    float* ow = (float*)(lds + AL_OW) + wid * 2048; float* ml = (float*)(lds + AL_ML) + wid * 64;
    if (hi == 0) { ml[r32] = st.m; ml[32 + r32] = lt; }
#pragma unroll
    for (int db = 0; db < 2; ++db)
#pragma unroll
        for (int r = 0; r < 16; ++r) ow[(32 * db + crow(r, hi)) * 32 + r32] = st.o[db][r];
    __syncthreads();
#pragma unroll
    for (int e = 0; e < 2; ++e) { const int oi = tid + 512 * e, q = oi >> 6, d = oi & 63; const float* mlb = (const float*)(lds + AL_ML); const float* owb = (const float*)(lds + AL_OW);
        float M = -1e30f;
#pragma unroll
        for (int w = 0; w < 8; ++w) M = fmaxf(M, mlb[w * 64 + q]);
        float L = 0.f, O = 0.f;
#pragma unroll
        for (int w = 0; w < 8; ++w) { const float f = __builtin_amdgcn_exp2f(mlb[w * 64 + q] - M); L += mlb[w * 64 + 32 + q] * f; O += owb[w * 2048 + d * 32 + q] * f; }
        CAT[(size_t)(MP + 16 * b + q) * 1024 + 512 + h * 64 + d] = (bf16_t)(pk2(O / L, 0.f) & 0xffff); }
    __syncthreads();
}

__device__ __forceinline__ void conva_item(int item, const bf16_t* __restrict__ ZB, const float* __restrict__ cw, const float* __restrict__ st_sc, bf16_t* CAT, float* out) {
    const int tid = opaque_tid(), rb = tid >> 6, ch = (tid & 63) * 8, R0 = item * 64 + rb * 8;
    if (R0 >= MROWS) return;
    const bool samp = R0 >= MP; const bool start = samp ? (((R0 - MP) & 15) == 0) : ((R0 & 2047) == 0);
    u32x4 xa[10], gc[10], gbv[8];
#pragma unroll
    for (int i = 0; i < 10; ++i) { const int row = (start && i < 2) ? R0 : R0 - 2 + i; xa[i] = *(const u32x4*)(ZB + (size_t)row * 3072 + ch); gc[i] = *(const u32x4*)(ZB + (size_t)row * 3072 + 1024 + ch); }
#pragma unroll
    for (int i = 0; i < 8; ++i) gbv[i] = *(const u32x4*)(ZB + (size_t)(R0 + i) * 3072 + 512 + ch);
    float w0[8], w1[8], w2[8], p2[8], p1[8];
#pragma unroll
    for (int e = 0; e < 8; ++e) { w0[e] = cw[ch + e]; w1[e] = cw[512 + ch + e]; w2[e] = cw[1024 + ch + e]; }
    auto prod = [&](const u32x4 a, const u32x4 c, float* pr) {
        pr[0] = bflo(a.x) * bflo(c.x); pr[1] = bfhi(a.x) * bfhi(c.x); pr[2] = bflo(a.y) * bflo(c.y); pr[3] = bfhi(a.y) * bfhi(c.y);
        pr[4] = bflo(a.z) * bflo(c.z); pr[5] = bfhi(a.z) * bfhi(c.z); pr[6] = bflo(a.w) * bflo(c.w); pr[7] = bfhi(a.w) * bfhi(c.w); };
    if (start) {
        if (samp) { const int b = (R0 - MP) >> 4;
#pragma unroll
            for (int e = 0; e < 8; ++e) { p2[e] = st_sc[(size_t)(b * 2 + 0) * 512 + ch + e]; p1[e] = st_sc[(size_t)(b * 2 + 1) * 512 + ch + e]; } }
        else {
#pragma unroll
            for (int e = 0; e < 8; ++e) { p2[e] = 0.f; p1[e] = 0.f; } }
    } else { prod(xa[0], gc[0], p2); prod(xa[1], gc[1], p1); }
#pragma unroll
    for (int i = 0; i < 8; ++i) { const int row = R0 + i; float p0[8]; prod(xa[i + 2], gc[i + 2], p0);
        const u32x4 g = gbv[i];
        const float gf[8] = {bflo(g.x), bfhi(g.x), bflo(g.y), bfhi(g.y), bflo(g.z), bfhi(g.z), bflo(g.w), bfhi(g.w)};
        float y[8];
#pragma unroll
        for (int e = 0; e < 8; ++e) y[e] = gf[e] * (w0[e] * p2[e] + w1[e] * p1[e] + w2[e] * p0[e]);
        *(u32x4*)(CAT + (size_t)row * 1024 + ch) = pk8((f32x4){y[0], y[1], y[2], y[3]}, (f32x4){y[4], y[5], y[6], y[7]});
        int orow = -1; float* ob = nullptr;
        if (!samp) { const int tt = row & 2047; if (tt >= 2046) { orow = (row >> 11) * 2 + (tt - 2046); ob = out + O_PSC; } }
        else { const int ii = (row - MP) & 15; if (ii >= 14) { orow = ((row - MP) >> 4) * 2 + (ii - 14); ob = out + O_SSC; } }
        if (orow >= 0) { *(f32x4*)(ob + (size_t)orow * 512 + ch) = (f32x4){p0[0], p0[1], p0[2], p0[3]}; *(f32x4*)(ob + (size_t)orow * 512 + ch + 4) = (f32x4){p0[4], p0[5], p0[6], p0[7]}; }
#pragma unroll
        for (int e = 0; e < 8; ++e) { p2[e] = p1[e]; p1[e] = p0[e]; } }
}
constexpr int CL_STAT = 0, CL_VNT = 2048;
__device__ __forceinline__ void gmlp_unit(unsigned char* lds, int R0, int gh, bool samp, int sb, const bf16_t* __restrict__ ZO, const bf16_t* __restrict__ WSB, const float* __restrict__ lng, const float* __restrict__ lnb,
                                          const float* __restrict__ bs, bf16_t* CAT, float* out) {
    const int tid = opaque_tid(), lane = tid & 63, wid = __builtin_amdgcn_readfirstlane(tid >> 6), r32 = lane & 31, hi = lane >> 5;
    float* stat = (float*)(lds + CL_STAT);
    const int vs_ = tid & 127, vc0_ = 16 * (tid >> 7);
    u32x4 nx0 = *(const u32x4*)(ZO + (size_t)(R0 + vs_) * 1536 + 512 + (gh * 4) * 64 + vc0_), nx1 = *(const u32x4*)(ZO + (size_t)(R0 + vs_) * 1536 + 512 + (gh * 4) * 64 + vc0_ + 8);
    { u32x4 av[16];
#pragma unroll
      for (int i = 0; i < 16; ++i) av[i] = *(const u32x4*)(ZO + (size_t)(R0 + wid * 16 + i) * 1536 + 512 + 8 * lane);
#pragma unroll
      for (int i = 0; i < 16; ++i) { const int s = wid * 16 + i; const u32x4 a = av[i];
        const float v[8] = {bflo(a.x), bfhi(a.x), bflo(a.y), bfhi(a.y), bflo(a.z), bfhi(a.z), bflo(a.w), bfhi(a.w)};
        float sm = 0.f;
#pragma unroll
        for (int e = 0; e < 8; ++e) sm += v[e];
        const float mean = wave_sum(sm) * (1.0f / 512.0f); float q = 0.f;
#pragma unroll
        for (int e = 0; e < 8; ++e) q += (v[e] - mean) * (v[e] - mean);
        const float rstd = __builtin_amdgcn_rsqf(wave_sum(q) * (1.0f / 512.0f) + RMS_EPS);
        if (lane == 0) { stat[2 * s] = mean; stat[2 * s + 1] = rstd; }
        if (samp && gh == 0 && s < 16) { float* o = out + O_SGV + (size_t)(sb * 16 + s) * 512 + 8 * lane;
#pragma unroll
            for (int e = 0; e < 8; ++e) o[e] = (v[e] - mean) * rstd * lng[8 * lane + e] + lnb[8 * lane + e]; } } }
    __syncthreads();
    for (int gi = 0; gi < 4; ++gi) { const int g = gh * 4 + gi;
        { const int s = vs_, c0 = vc0_; const float mean = stat[2 * s], rstd = stat[2 * s + 1];
            unsigned short* vt = (unsigned short*)(lds + CL_VNT) + c0 * 136 + s;
            const u32x4 cur0 = nx0, cur1 = nx1;
            if (gi + 1 < 4) { const bf16_t* nsrc = ZO + (size_t)(R0 + s) * 1536 + 512 + (g + 1) * 64 + c0; nx0 = *(const u32x4*)nsrc; nx1 = *(const u32x4*)(nsrc + 8); }
#pragma unroll
            for (int hh = 0; hh < 2; ++hh) { const u32x4 a = hh ? cur1 : cur0; const float v[8] = {bflo(a.x), bfhi(a.x), bflo(a.y), bfhi(a.y), bflo(a.z), bfhi(a.z), bflo(a.w), bfhi(a.w)};
#pragma unroll
                for (int e = 0; e < 8; ++e) { const int c = g * 64 + c0 + 8 * hh + e; const float y = (v[e] - mean) * rstd * lng[c] + lnb[c]; vt[(8 * hh + e) * 136] = (unsigned short)(pk2(y, 0.f) & 0xffff); } } }
        __syncthreads();
        { const int cb = wid & 1, tb = wid >> 1;
          if (!samp || tb == 0) {
            f32x16 acc = f32x16{};
            const unsigned char* ap = lds + CL_VNT + (32 * cb + r32) * 272 + 16 * hi; const bf16_t* bp = WSB + (size_t)(g * 128 + 32 * tb + r32) * 128 + 8 * hi;
            bf16x8 Bf[8];
#pragma unroll
            for (int ks = 0; ks < 8; ++ks) Bf[ks] = (ks < 2 * (tb + 1)) ? *(const bf16x8*)(bp + 16 * ks) : (bf16x8){0, 0, 0, 0, 0, 0, 0, 0};
#pragma unroll
            for (int ks = 0; ks < 8; ++ks) if (ks < 2 * (tb + 1)) { const bf16x8 A = *(const bf16x8*)(ap + 32 * ks); acc = __builtin_amdgcn_mfma_f32_32x32x16_bf16(A, Bf[ks], acc, 0, 0, 0); }
            const int t = 32 * tb + r32; const float bst = bs[g * 128 + t];
            if (!samp || t < 16) {
#pragma unroll
                for (int r4 = 0; r4 < 4; ++r4) { const int c = g * 64 + 32 * cb + 8 * r4 + 4 * hi; const u32x2 uu = *(const u32x2*)(ZO + (size_t)(R0 + t) * 1536 + c);
                    u32x2 w; w.x = pk2(bflo(uu.x) * (acc[4 * r4] + bst), bfhi(uu.x) * (acc[4 * r4 + 1] + bst)); w.y = pk2(bflo(uu.y) * (acc[4 * r4 + 2] + bst), bfhi(uu.y) * (acc[4 * r4 + 3] + bst));
                    *(u32x2*)(CAT + (size_t)(R0 + t) * 1024 + c) = w; } }
          } }
        __syncthreads();
    }
}
__device__ __forceinline__ void gmlp_sample_unit(unsigned char* lds, int sb, const bf16_t* __restrict__ ZO, const bf16_t* __restrict__ WSB, const float* __restrict__ lng, const float* __restrict__ lnb,
                                                 const float* __restrict__ bs, bf16_t* CAT, float* out) {
    const int tid = opaque_tid(), lane = tid & 63, wid = __builtin_amdgcn_readfirstlane(tid >> 6), r32 = lane & 31, hi = lane >> 5;
    const int R0 = MP + 16 * sb;
    float* stat = (float*)(lds + CL_STAT); unsigned char* vn8 = lds + CL_VNT;
    { u32x4 av[2];
#pragma unroll
      for (int i = 0; i < 2; ++i) av[i] = *(const u32x4*)(ZO + (size_t)(R0 + 2 * wid + i) * 1536 + 512 + 8 * lane);
#pragma unroll
      for (int i = 0; i < 2; ++i) { const int s = 2 * wid + i; const u32x4 a = av[i];
        const float v[8] = {bflo(a.x), bfhi(a.x), bflo(a.y), bfhi(a.y), bflo(a.z), bfhi(a.z), bflo(a.w), bfhi(a.w)};
        float sm = 0.f;
#pragma unroll
        for (int e = 0; e < 8; ++e) sm += v[e];
        const float mean = wave_sum(sm) * (1.0f / 512.0f); float q = 0.f;
#pragma unroll
        for (int e = 0; e < 8; ++e) q += (v[e] - mean) * (v[e] - mean);
        const float rstd = __builtin_amdgcn_rsqf(wave_sum(q) * (1.0f / 512.0f) + RMS_EPS);
        if (lane == 0) { stat[2 * s] = mean; stat[2 * s + 1] = rstd; }
        float* o = out + O_SGV + (size_t)(sb * 16 + s) * 512 + 8 * lane;
#pragma unroll
        for (int e = 0; e < 8; ++e) o[e] = (v[e] - mean) * rstd * lng[8 * lane + e] + lnb[8 * lane + e]; } }
    __syncthreads();
    { const int s = tid >> 5, ch0 = (tid & 31) * 16; const float mean = stat[2 * s], rstd = stat[2 * s + 1];
      const bf16_t* src = ZO + (size_t)(R0 + s) * 1536 + 512 + ch0; unsigned short* vt = (unsigned short*)vn8 + (size_t)((ch0 >> 6) * 64 + (ch0 & 63)) * 40 + s;
#pragma unroll
      for (int hh = 0; hh < 2; ++hh) { const u32x4 a = *(const u32x4*)(src + 8 * hh); const float v[8] = {bflo(a.x), bfhi(a.x), bflo(a.y), bfhi(a.y), bflo(a.z), bfhi(a.z), bflo(a.w), bfhi(a.w)};
#pragma unroll
          for (int e = 0; e < 8; ++e) { const int c = ch0 + 8 * hh + e; const float y = (v[e] - mean) * rstd * lng[c] + lnb[c]; vt[(8 * hh + e) * 40] = (unsigned short)(pk2(y, 0.f) & 0xffff); vt[(8 * hh + e) * 40 + 16] = 0; } } }
    __syncthreads();
#pragma unroll
    for (int k = 0; k < 2; ++k) { const int task = wid + 8 * k, g = task >> 1, cb = task & 1;
        const unsigned char* ap = vn8 + (size_t)(g * 64 + 32 * cb + r32) * 80 + 16 * hi; const bf16_t* bp = WSB + (size_t)(g * 128 + r32) * 128 + 8 * hi;
        f32x16 acc = f32x16{};
#pragma unroll
        for (int ks = 0; ks < 2; ++ks) { const bf16x8 A = *(const bf16x8*)(ap + 32 * ks), B = *(const bf16x8*)(bp + 16 * ks); acc = __builtin_amdgcn_mfma_f32_32x32x16_bf16(A, B, acc, 0, 0, 0); }
        const int t = r32;
        if (t < 16) { const float bst = bs[g * 128 + t];
#pragma unroll
            for (int r4 = 0; r4 < 4; ++r4) { const int c = g * 64 + 32 * cb + 8 * r4 + 4 * hi; const u32x2 uu = *(const u32x2*)(ZO + (size_t)(R0 + t) * 1536 + c);
                u32x2 w; w.x = pk2(bflo(uu.x) * (acc[4 * r4] + bst), bfhi(uu.x) * (acc[4 * r4 + 1] + bst)); w.y = pk2(bflo(uu.y) * (acc[4 * r4 + 2] + bst), bfhi(uu.y) * (acc[4 * r4 + 3] + bst));
                *(u32x2*)(CAT + (size_t)(R0 + t) * 1024 + c) = w; } } }
    __syncthreads();
}
template <bool SAMP> __device__ __forceinline__ void cconv_unit(unsigned char* lds, int R0, int sb, const bf16_t* __restrict__ ZO, const float* __restrict__ dw, const float* __restrict__ dwb, const float* __restrict__ cng,
                                           const float* __restrict__ cnb, const float* __restrict__ st_cc, bf16_t* CAT) {
    typedef float f32x2 __attribute__((ext_vector_type(2)));
    const int tid = opaque_tid(), lane = tid & 63, wid = __builtin_amdgcn_readfirstlane(tid >> 6), cp = tid & 255, c = 2 * cp, h = tid >> 8;
    float* cd = (float*)lds;
    f32x2 w[31];
#pragma unroll
    for (int j = 0; j < 31; ++j) w[j] = *(const f32x2*)(dw + j * 512 + c);
    const f32x2 bias = *(const f32x2*)(dwb + c);
    const f32x4 g0 = *(const f32x4*)(cng + 4 * lane), g1 = *(const f32x4*)(cng + 256 + 4 * lane), c0 = *(const f32x4*)(cnb + 4 * lane), c1 = *(const f32x4*)(cnb + 256 + 4 * lane);
    constexpr int NSTEP = SAMP ? 1 : 2;
    unsigned xraw[46];
    auto load_raw = [&](int step) { const int Rs = R0 + 32 * h + 16 * step;
        if (SAMP) {
#pragma unroll
            for (int i = 30; i < 46; ++i) xraw[i] = *(const unsigned*)(ZO + (size_t)(Rs + i - 30) * 1536 + 1024 + c);
        } else { const int ts = (Rs & 2047) - 30;
#pragma unroll
            for (int i = 0; i < 46; ++i) xraw[i] = (ts + i >= 0) ? *(const unsigned*)(ZO + (size_t)(Rs - 30 + i) * 1536 + 1024 + c) : 0u; } };
    if (!SAMP || h == 0) load_raw(0);
#pragma unroll
    for (int step = 0; step < NSTEP; ++step) { const int Rs = R0 + 32 * h + 16 * step;
        if (!SAMP || h == 0) {
            f32x2 x[46];
#pragma unroll
            for (int i = 0; i < 46; ++i) { if (SAMP && i < 30) x[i] = *(const f32x2*)(st_cc + (size_t)(sb * 30 + i) * 512 + c); else x[i] = (f32x2){bflo(xraw[i]), bfhi(xraw[i])}; }
            if (step + 1 < NSTEP) load_raw(step + 1);
#pragma unroll
            for (int i = 0; i < 16; ++i) { f32x2 a = bias;
#pragma unroll
                for (int j = 0; j < 31; ++j) a += w[j] * x[i + j];
                *(f32x2*)(cd + (16 * h + i) * 512 + c) = a; }
        }
        __syncthreads();
        constexpr int RPW = SAMP ? 2 : 4;
#pragma unroll
        for (int rr = 0; rr < RPW; ++rr) { const int i = RPW * wid + rr; const f32x4 a = *(const f32x4*)(cd + i * 512 + 4 * lane), b2 = *(const f32x4*)(cd + i * 512 + 256 + 4 * lane);
            const float mean = wave_sum((a[0] + a[1]) + (a[2] + a[3]) + (b2[0] + b2[1]) + (b2[2] + b2[3])) * (1.0f / 512.0f);
            const f32x4 da = a - mean, db = b2 - mean;
            const float rstd = __builtin_amdgcn_rsqf(wave_sum((da[0] * da[0] + da[1] * da[1]) + (da[2] * da[2] + da[3] * da[3]) + (db[0] * db[0] + db[1] * db[1]) + (db[2] * db[2] + db[3] * db[3])) * (1.0f / 512.0f) + RMS_EPS);
            f32x4 y0 = da * rstd * g0 + c0, y1 = db * rstd * g1 + c1;
#pragma unroll
            for (int e = 0; e < 4; ++e) { y0[e] = pg8::siluf_(y0[e]); y1[e] = pg8::siluf_(y1[e]); }
            const int orow = R0 + 32 * (i >> 4) + 16 * step + (i & 15);
            bf16_t* op = CAT + (size_t)orow * 1024 + 512 + 4 * lane;
            u32x2 w0; w0.x = pk2(y0[0], y0[1]); w0.y = pk2(y0[2], y0[3]); *(u32x2*)op = w0;
            u32x2 w1; w1.x = pk2(y1[0], y1[1]); w1.y = pk2(y1[2], y1[3]); *(u32x2*)(op + 256) = w1; }
        __syncthreads();
    }
}

#define GAS __attribute__((address_space(1)))
#define LAS __attribute__((address_space(3)))
typedef GAS unsigned gu32;
typedef GAS unsigned long long gu64;
#define RLX_AGENT __ATOMIC_RELAXED, __HIP_MEMORY_SCOPE_AGENT
#define LDS_WAIT() asm volatile("s_waitcnt lgkmcnt(0)" ::: "memory")
#define VM_WAIT() asm volatile("s_waitcnt vmcnt(0)" ::: "memory")
__device__ __forceinline__ unsigned long long rt() { return __builtin_amdgcn_s_memrealtime(); }
#define XB_TMO      128
#define XB_XCNT(j)  (256  + 64 * (j))
#define XB_XSUB(j)  (1280 + 64 * (j))
#define XB_XGEN(j)  (2304 + 64 * (j))
#define XB_TOP      3328
#define XB_TOPGEN   3392
#define XCD_BAR_WORDS 3456
#define XB_SPIN_CAP (1u << 18)

__device__ __forceinline__ unsigned xb_ld(unsigned* p)              { return __hip_atomic_load(p, __ATOMIC_RELAXED, __HIP_MEMORY_SCOPE_AGENT); }
__device__ __forceinline__ unsigned xb_add(unsigned* p, unsigned v) { return __hip_atomic_fetch_add(p, v, __ATOMIC_RELAXED, __HIP_MEMORY_SCOPE_AGENT); }
__device__ __forceinline__ unsigned xb_xcc_id() { return (unsigned)__builtin_amdgcn_s_getreg((3 << 11) | 20) & 0xFu; }
#define XB_SPIN(cond, bar) do { unsigned _sp = 0; while (cond) { __builtin_amdgcn_s_sleep(1); \
    if ((++_sp & 255u) == 0u) { if (xb_ld(&(bar)[XB_TMO])) break; if (_sp > XB_SPIN_CAP) { atomicAdd(&(bar)[XB_TMO], 1u); break; } } } } while (0)

struct XcdBarrier {
    unsigned* bar; unsigned x;
    volatile LAS unsigned* st;
};

__device__ __forceinline__ XcdBarrier xcd_barrier_post(unsigned* bar, volatile LAS unsigned* st) {
    XcdBarrier b; b.bar = bar; b.x = xb_xcc_id(); b.st = st;
    if (threadIdx.x == 0) (void)xb_add(&bar[XB_XCNT(b.x)], 1u);
    return b;
}
__device__ __forceinline__ void xcd_barrier_complete(unsigned* bar, unsigned x, unsigned& nloc, unsigned& nx) {
    const unsigned G = gridDim.x * gridDim.y * gridDim.z;
    unsigned sum, cnt, mine, sp = 0u;
    for (;;) {
        sum = 0u; cnt = 0u; mine = 0u;
#pragma unroll
        for (unsigned j = 0; j < 16; ++j) { const unsigned c = xb_ld(&bar[XB_XCNT(j)]); sum += c; cnt += (c > 0u) ? 1u : 0u; mine = (j == x) ? c : mine; }
        if (sum == G) break;
        __builtin_amdgcn_s_sleep(1);
        if ((++sp & 255u) == 0u) { if (xb_ld(&bar[XB_TMO])) break; if (sp > XB_SPIN_CAP) { atomicAdd(&bar[XB_TMO], 1u); break; } }
    }
    nloc = mine > 0u ? mine : 1u; nx = cnt > 0u ? cnt : 1u;
}

__device__ __forceinline__ void xcd_barrier(const XcdBarrier& b) {
    asm volatile("s_waitcnt vmcnt(0)" ::: "memory");
    __syncthreads();
    if (opaque_tid() == 0) {
        unsigned* bar = b.bar; asm volatile("" : "+s"(bar)); unsigned bx = b.x; asm volatile("" : "+s"(bx));
        __builtin_amdgcn_s_waitcnt(0);
        unsigned nloc = b.st[0], nx = b.st[1];
        if (nloc == 0u) { xcd_barrier_complete(bar, bx, nloc, nx); b.st[0] = nloc; b.st[1] = nx; }
        const unsigned old = xb_add(&bar[XB_XSUB(bx)], 1u);
        const unsigned gen = old / nloc;
        if (old + 1u == (gen + 1u) * nloc) {
            __builtin_amdgcn_fence(__ATOMIC_RELEASE, "agent");
            asm volatile("s_waitcnt vmcnt(0)" ::: "memory");
            const unsigned og = xb_add(&bar[XB_TOP], 1u);
            const unsigned tg = og / nx;
            if (og + 1u == (tg + 1u) * nx) xb_add(&bar[XB_TOPGEN], 1u);
            else XB_SPIN(xb_ld(&bar[XB_TOPGEN]) == tg, bar);
            __builtin_amdgcn_fence(__ATOMIC_ACQUIRE, "agent");
            xb_add(&bar[XB_XGEN(bx)], 1u);
            asm volatile("s_waitcnt vmcnt(0)" ::: "memory");
        } else {
            XB_SPIN(xb_ld(&bar[XB_XGEN(bx)]) == gen, bar);
            __builtin_amdgcn_fence(__ATOMIC_ACQUIRE, "agent");
            asm volatile("s_waitcnt vmcnt(0)" ::: "memory");
        }
    }
    __syncthreads();
}


__device__ __forceinline__ void refresh_sample(const pg8::StaticOrder& S, const float* X, bf16_t* XBp, float* ssq) {
    bool own = false; pg8::Unit u;
    for (int i = 0; S.next(i, u); ++i) own = own || (u.pm == 64);
    if (!own) return;
    const int tid = opaque_tid(), lane = tid & 63, wid = __builtin_amdgcn_readfirstlane(tid >> 6);
    for (int hb = 0; hb < 2; ++hb) { const int r0 = MP + wid * 16 + hb * 8; f32x4 v[8][4];
#pragma unroll
        for (int i = 0; i < 8; ++i)
#pragma unroll
            for (int j = 0; j < 4; ++j) v[i][j] = ((const f32x4*)(X + (size_t)(r0 + i) * DM) + lane)[64 * j];
#pragma unroll
        for (int i = 0; i < 8; ++i) { u32x2* xb = (u32x2*)(XBp + (size_t)(r0 + i) * DM) + lane; float ss = 0.f;
#pragma unroll
            for (int j = 0; j < 4; ++j) { u32x2 w; w.x = pk2(v[i][j][0], v[i][j][1]); w.y = pk2(v[i][j][2], v[i][j][3]); xb[64 * j] = w; ss += (v[i][j][0] * v[i][j][0] + v[i][j][1] * v[i][j][1]) + (v[i][j][2] * v[i][j][2] + v[i][j][3] * v[i][j][3]); }
            ss = wave_sum(ss); if (lane == 0) ssq[r0 + i] = ss; } }
    __builtin_amdgcn_fence(__ATOMIC_RELEASE, "agent"); asm volatile("s_waitcnt vmcnt(0)" ::: "memory");
    __syncthreads();
    __builtin_amdgcn_fence(__ATOMIC_ACQUIRE, "agent"); asm volatile("s_waitcnt vmcnt(0)" ::: "memory");
    __syncthreads();
}

template <int NS> __device__ __forceinline__ void skinny_resid_unit(unsigned char* lds, const bf16_t* __restrict__ A, const bf16_t* __restrict__ Bt, int u, const float* Xs_in, float* X, bf16_t* XBp, float* ssq, float scale) {
    constexpr int K = NS * 32 * 8;
    const int tid = opaque_tid(), lane = tid & 63, wid = __builtin_amdgcn_readfirstlane(tid >> 6), fr = lane & 15, fq = lane >> 4;
    const int rb = u & 7, cb = u >> 3, k0 = wid * (K / 8);
    const bf16_t* ap = A + (size_t)(16 * rb + fr) * K + k0 + 8 * fq; const bf16_t* bp0 = Bt + (size_t)(32 * cb + fr) * K + k0 + 8 * fq; const bf16_t* bp1 = bp0 + (size_t)16 * K;
    bf16x8 a[NS], p[NS], q[NS];
#pragma unroll
    for (int i = 0; i < NS; ++i) { a[i] = *(const bf16x8*)(ap + 32 * i); p[i] = *(const bf16x8*)(bp0 + 32 * i); q[i] = *(const bf16x8*)(bp1 + 32 * i); }
    f32x4 acc0 = {0.f, 0.f, 0.f, 0.f}, acc1 = {0.f, 0.f, 0.f, 0.f};
#pragma unroll
    for (int i = 0; i < NS; ++i) { acc0 = __builtin_amdgcn_mfma_f32_16x16x32_bf16(p[i], a[i], acc0, 0, 0, 0); acc1 = __builtin_amdgcn_mfma_f32_16x16x32_bf16(q[i], a[i], acc1, 0, 0, 0); }
    float* red = (float*)lds;
#pragma unroll
    for (int e = 0; e < 4; ++e) { red[(wid * 8 + e) * 64 + lane] = acc0[e]; red[(wid * 8 + 4 + e) * 64 + lane] = acc1[e]; }
    __syncthreads();
    { const int r = tid >> 5, c = tid & 31, src = (4 * (c >> 4) + (c & 3)) * 64 + r + 16 * ((c & 15) >> 2);
      float sum = 0.f;
#pragma unroll
      for (int w = 0; w < 8; ++w) sum += red[w * 512 + src];
      const int row = MP + 16 * rb + r, col = 32 * cb + c;
      const float x = Xs_in[(size_t)(16 * rb + r) * DM + col] + scale * sum;
      X[(size_t)row * DM + col] = x; XBp[(size_t)row * DM + col] = (bf16_t)(pk2(x, 0.f) & 0xffff);
      float ss = x * x;
#pragma unroll
      for (int o = 1; o < 32; o <<= 1) ss += __shfl_xor(ss, o);
      if (c == 0) unsafeAtomicAdd(ssq + row, ss); }
    __syncthreads();
}
__global__ void __launch_bounds__(NTHR, 2) mega_fwd(Params P) {
    extern __shared__ __attribute__((aligned(16))) unsigned char lds[];
    cg::grid_group grid = cg::this_grid();
    if (gridDim.x == 0x7fffffffu) grid.sync();
    const int G = gridDim.x, bid = blockIdx.x;
    unsigned char* const ws = P.ws; float* const out = P.out;
    volatile LAS unsigned* bst = (volatile LAS unsigned*)((LAS unsigned char*)lds + LDS_BYTES - 64);
    if (threadIdx.x < 4) bst[threadIdx.x] = 0u;
    __syncthreads();
    const XcdBarrier xbar = xcd_barrier_post((unsigned*)ws, bst);
#define SSQ ((float*)(ws + WS_SSQ))
#define WSB ((bf16_t*)(ws + WS_WSB))
#define XB ((bf16_t*)(ws + WS_XB))
#define CAT ((bf16_t*)(ws + WS_CAT))
#define BIG ((bf16_t*)(ws + WS_BIG))
#define EIN ((bf16_t*)(ws + WS_EIN))
#define EOUT ((bf16_t*)(ws + WS_EOUT))
#define OIN ((bf16_t*)(ws + WS_OIN))
#define OOUT ((bf16_t*)(ws + WS_OOUT))
#define ldsa ((PG8_LAS unsigned char*)lds)
#define x_prompt P.in[0]
#define x_sample P.in[1]
#define cache_k P.in[2]
#define cache_v P.in[3]
#define cache_lf P.in[4]
#define st_sconv P.in[5]
#define st_cconv P.in[6]
#define ffn1_g P.in[7]
#define ffn1_wg P.in[8]
#define ffn1_wu P.in[9]
#define ffn1_wd P.in[10]
#define mix_g P.in[11]
#define ffn2_g P.in[12]
#define ffn2_wg P.in[13]
#define ffn2_wu P.in[14]
#define ffn2_wd P.in[15]
#define e_w_in P.in[16]
#define e_b_f P.in[17]
#define e_conv_w P.in[18]
#define e_w_out P.in[19]
#define o_w_in P.in[20]
#define o_ln_g P.in[21]
#define o_ln_b P.in[22]
#define o_ws P.in[23]
#define o_bs P.in[24]
#define o_dw P.in[25]
#define o_dw_b P.in[26]
#define o_cn_g P.in[27]
#define o_cn_b P.in[28]
#define o_w_out P.in[29]
#define final_g P.in[30]

    {
        const int tid = opaque_tid(), lane = tid & 63, wid = __builtin_amdgcn_readfirstlane(tid >> 6);
        const int gw = bid * NWAVES + wid, NGW = G * NWAVES, gt = bid * NTHR + tid, NGT = G * NTHR;
        float* scr = (float*)(lds + wid * 16640);
        int base = 0;
#define TR_JOB(SRC, GAIN, KK, NSRC, NBLK, DST, MODE) do { const int n_ = ((KK) / 64) * (NBLK); int first_ = (gw - base) % NGW; if (first_ < 0) first_ += NGW; \
        for (int it_ = first_; it_ < n_; it_ += NGW) tr_item((SRC), (GAIN), (KK), (NSRC), (NBLK), (DST), (MODE), scr, it_, lane); base += n_; } while (0)
#define FFN_JOBS(F_) do { const int f_ = (F_), l_ = f_ >> 1, second_ = f_ & 1; \
            const float* wg_ = (second_ ? ffn2_wg : ffn1_wg) + (size_t)l_ * DM * DFF; const float* wu_ = (second_ ? ffn2_wu : ffn1_wu) + (size_t)l_ * DM * DFF; const float* wd_ = (second_ ? ffn2_wd : ffn1_wd) + (size_t)l_ * DFF * DM; \
            const float* gn_ = (second_ ? ffn2_g : ffn1_g) + l_ * DM; \
            bf16_t* w1_ = (bf16_t*)(ws + WS_W1 + f_ * W1_BYTES); bf16_t* w2_ = (bf16_t*)(ws + WS_W2 + f_ * W2_BYTES); \
            TR_JOB(wg_, gn_, DM, DFF, DFF / 64, w1_, 1); TR_JOB(wu_, gn_, DM, DFF, DFF / 64, w1_, 2); TR_JOB(wd_, (const float*)nullptr, DFF, DM, DM / 64, w2_, 0); } while (0)
        FFN_JOBS(0);
        {
            const int rs_ = MP + gw; const bool has_s = rs_ < MROWS; f32x4 sv[4];
            if (has_s) { const f32x4* src = (const f32x4*)(x_sample + (size_t)(rs_ - MP) * DM) + lane;
#pragma unroll
                for (int j = 0; j < 4; ++j) sv[j] = src[64 * j]; }
            for (int r0 = gw * 4; r0 < MP; r0 += NGW * 4) { f32x4 v[4][4];
#pragma unroll
                for (int i = 0; i < 4; ++i) { const f32x4* src = (const f32x4*)(x_prompt + (size_t)(r0 + i) * DM) + lane;
#pragma unroll
                    for (int j = 0; j < 4; ++j) v[i][j] = src[64 * j]; }
#pragma unroll
                for (int i = 0; i < 4; ++i) { u32x2* xb = (u32x2*)(XB + (size_t)(r0 + i) * DM) + lane; float ss = 0.f;
#pragma unroll
                    for (int j = 0; j < 4; ++j) { u32x2 w; w.x = pk2(v[i][j][0], v[i][j][1]); w.y = pk2(v[i][j][2], v[i][j][3]); xb[64 * j] = w; ss += (v[i][j][0] * v[i][j][0] + v[i][j][1] * v[i][j][1]) + (v[i][j][2] * v[i][j][2] + v[i][j][3] * v[i][j][3]); }
                    ss = wave_sum(ss); if (lane == 0) SSQ[r0 + i] = ss; } }
            if (has_s) { u32x2* xb = (u32x2*)(XB + (size_t)rs_ * DM) + lane; float ss = 0.f;
#pragma unroll
                for (int j = 0; j < 4; ++j) { u32x2 w; w.x = pk2(sv[j][0], sv[j][1]); w.y = pk2(sv[j][2], sv[j][3]); xb[64 * j] = w; ss += (sv[j][0] * sv[j][0] + sv[j][1] * sv[j][1]) + (sv[j][2] * sv[j][2] + sv[j][3] * sv[j][3]); }
                ss = wave_sum(ss); if (lane == 0) SSQ[rs_] = ss; }
            for (int r = MP + gw + NGW; r < MROWS; r += NGW) {
                const f32x4* src = (const f32x4*)(x_sample + (size_t)(r - MP) * DM) + lane; u32x2* xb = (u32x2*)(XB + (size_t)r * DM) + lane; float ss = 0.f;
#pragma unroll
                for (int j = 0; j < 4; ++j) { const f32x4 v = src[64 * j]; u32x2 w; w.x = pk2(v[0], v[1]); w.y = pk2(v[2], v[3]); xb[64 * j] = w; ss += (v[0] * v[0] + v[1] * v[1]) + (v[2] * v[2] + v[3] * v[3]); }
                ss = wave_sum(ss); if (lane == 0) SSQ[r] = ss; }
            for (int r = MROWS + gw; r < MT; r += NGW) { u32x2* xb = (u32x2*)(XB + (size_t)r * DM) + lane;
#pragma unroll
                for (int j = 0; j < 4; ++j) xb[64 * j] = (u32x2){0u, 0u};
                if (lane == 0) SSQ[r] = 1024.f; }
        }
        for (int i = gt; i < 6 * MT; i += NGT) SSQ[MT + i] = 0.f;
        for (int i = gt; i < 8 * 128 * 128; i += NGT) { const int s = i & 127, t = (i >> 7) & 127; WSB[i] = (bf16_t)(pk2((s <= t) ? o_ws[i] : 0.f, 0.f) & 0xffff); }
    }
    xcd_barrier(xbar);

    for (int layer = 0; layer < 2; ++layer) {
        for (int f = 0; f < 2; ++f) {
            const int wi = layer * 2 + f, si = layer * 3 + (f ? 2 : 0);
            { pg8::Gemm g{XB, (const bf16_t*)(ws + WS_W1 + wi * W1_BYTES), MT, 2 * DFF, DM, DM}; pg8::StaticOrder S; S.init(MT, 2 * DFF, G, bid);
              pg8::EpiSwiglu E{SSQ + si * MT, BIG};
              pg8::gemm_phase<pg8::EpiSwiglu, pg8::StaticOrder, true, true>(ldsa, g, S, E); }
            if (wi < 3) {
                const int nheavy = (1430 > 5 * G && 1430 <= 6 * G) ? 1430 - 5 * G : 0;
                if (bid >= nheavy) {
                    const int tid = opaque_tid(), lane = tid & 63, wid = __builtin_amdgcn_readfirstlane(tid >> 6);
                    const int gw = (bid - nheavy) * NWAVES + wid, NGW = (G - nheavy) * NWAVES; float* scr = (float*)(lds + wid * 16640); int base = 0;
                    if (wi == 0) { TR_JOB(e_w_in, mix_g, DM, 3080, 3328 / 64, EIN, 0); TR_JOB(e_w_out, (const float*)nullptr, DM, DM, DM / 64, EOUT, 0); FFN_JOBS(1); }
                    else if (wi == 1) { FFN_JOBS(2); }
                    else { TR_JOB(o_w_in, mix_g + DM, DM, 2048, 2048 / 64, OIN, 3); TR_JOB(o_w_out, (const float*)nullptr, DM, DM, DM / 64, OOUT, 0); FFN_JOBS(3); }
                }
            }
            xcd_barrier(xbar);
            { pg8::Gemm g{BIG, (const bf16_t*)(ws + WS_W2 + wi * W2_BYTES), MP, DM, DFF, DFF}; pg8::StaticOrder S; S.init(MP, DM, G, bid);
              pg8::EpiResid E{(wi == 0) ? x_prompt : (const float*)out, out, XB, SSQ + (si + 1) * MT, 0.5f};
              pg8::gemm_phase<pg8::EpiResid, pg8::StaticOrder, true, true>(ldsa, g, S, E); }
            for (int u = bid; u < 256; u += G) skinny_resid_unit<11>(lds, BIG + (size_t)MP * DFF, (const bf16_t*)(ws + WS_W2 + wi * W2_BYTES), u, (wi == 0) ? x_sample : (const float*)(out + O_YS), out, XB, SSQ + (si + 1) * MT, 0.5f);
            xcd_barrier(xbar);
            if (f == 1) break;
            if (layer == 0) {
                { pg8::Gemm g{XB, EIN, MT, 3328, DM, DM}; pg8::StaticOrder S; S.init(MT, 3328, G, bid);
                  pg8::EpiEvenIn E{SSQ + 1 * MT, BIG, out + O_PK, out + O_PV, out + O_PLF, out + O_SK, out + O_SV, out + O_SLF, e_b_f};
                  pg8::gemm_phase<pg8::EpiEvenIn, pg8::StaticOrder, true, true>(ldsa, g, S, E); }
                xcd_barrier(xbar);
                #ifndef NO_CONVA
                for (int it = bid; it < 258; it += G) conva_item(it, BIG, e_conv_w, st_sconv, CAT, out);
#endif
#ifndef NO_PATTN
                for (int u = bid; u < 256; u += G) { const int bh = u >> 2, role = u & 3, ab = bh >> 3, ah = bh & 7;
                    if (role == 0) attn_sample_unit(lds, ab, ah, BIG, cache_k, cache_v, cache_lf, out + O_SK, out + O_SV, out + O_SLF, CAT);
                    const int nq = (role == 3) ? 3 : (role == 0) ? 1 : 2, qlist = (role == 0) ? 0x5 : (role == 1) ? 0x17 : (role == 2) ? 0x26 : 0x034;
                    for (int i = 0; i < nq; ++i) attn_prompt_unit(lds, ab, ah, (qlist >> (4 * i)) & 15, BIG, out + O_PLF, CAT); }
#endif
                xcd_barrier(xbar);
                { pg8::Gemm g{CAT, EOUT, MP, DM, DM, DM}; pg8::StaticOrder S; S.init(MP, DM, G, bid);
                  pg8::EpiResid E{out, out, XB, SSQ + 2 * MT, 1.0f};
                  pg8::gemm_phase<pg8::EpiResid, pg8::StaticOrder, true, true>(ldsa, g, S, E); }
                for (int u = bid; u < 256; u += G) skinny_resid_unit<4>(lds, CAT + (size_t)MP * DM, EOUT, u, out + O_YS, out, XB, SSQ + 2 * MT, 1.0f);
                xcd_barrier(xbar);
            } else {
                { pg8::Gemm g{XB, OIN, MT, 2048, DM, DM}; pg8::StaticOrder S; S.init(MT, 2048, G, bid);
                  pg8::EpiOddIn E{SSQ + 4 * MT, BIG};
                  pg8::gemm_phase<pg8::EpiOddIn, pg8::StaticOrder, true, true>(ldsa, g, S, E); }
                xcd_barrier(xbar);
#ifndef NO_CCONV
                for (int u = bid; u < 256; u += G) cconv_unit<false>(lds, 64 * u, 0, BIG, o_dw, o_dw_b, o_cn_g, o_cn_b, st_cconv, CAT);
                for (int u = bid; u < 8; u += G) cconv_unit<true>(lds, MP + 16 * u, u, BIG, o_dw, o_dw_b, o_cn_g, o_cn_b, st_cconv, CAT);
#endif
#ifndef NO_GMLP
                for (int u = bid; u < 256; u += G) gmlp_unit(lds, 128 * (u >> 1), u & 1, false, 0, BIG, WSB, o_ln_g, o_ln_b, o_bs, CAT, out);
                for (int u = bid - 8; u < 8; u += G) if (u >= 0) gmlp_sample_unit(lds, u, BIG, WSB, o_ln_g, o_ln_b, o_bs, CAT, out);
#endif
                for (int i = bid * NTHR + opaque_tid(); i < 8 * 30 * 512; i += G * NTHR) { const int c = i & 511, j = (i >> 9) % 30, b = i / (30 * 512);
                    out[O_PCC + i] = bf2f(BIG[(size_t)(b * 2048 + 2018 + j) * 1536 + 1024 + c]);
                    out[O_SCC + i] = (j < 14) ? st_cconv[(size_t)(b * 30 + 16 + j) * 512 + c] : bf2f(BIG[(size_t)(MP + 16 * b + j - 14) * 1536 + 1024 + c]); }
                xcd_barrier(xbar);
                { pg8::Gemm g{CAT, OOUT, MP, DM, DM, DM}; pg8::StaticOrder S; S.init(MP, DM, G, bid);
                  pg8::EpiResid E{out, out, XB, SSQ + 5 * MT, 1.0f};
                  pg8::gemm_phase<pg8::EpiResid, pg8::StaticOrder, true, true>(ldsa, g, S, E); }
                for (int u = bid; u < 256; u += G) skinny_resid_unit<4>(lds, CAT + (size_t)MP * DM, OOUT, u, out + O_YS, out, XB, SSQ + 5 * MT, 1.0f);
                xcd_barrier(xbar);
            }
        }
    }
    const int ftid = opaque_tid(), lane = ftid & 63;
    { const int gwf = bid * NWAVES + (ftid >> 6), NGWF = G * NWAVES; const f32x4* gp = (const f32x4*)final_g + lane;
      f32x4 gv[4];
#pragma unroll
      for (int j = 0; j < 4; ++j) gv[j] = gp[64 * j];
      const int rs_ = MP + gwf; const bool has_s = rs_ < MROWS; f32x4 sv[4];
      if (has_s) {
#pragma unroll
        for (int j = 0; j < 4; ++j) sv[j] = ((const f32x4*)(out + (size_t)rs_ * DM) + lane)[64 * j]; }
      for (int r0 = gwf * 4; r0 < MP; r0 += NGWF * 4) {
        f32x4 v[4][4];
#pragma unroll
        for (int i = 0; i < 4; ++i)
#pragma unroll
            for (int j = 0; j < 4; ++j) v[i][j] = ((const f32x4*)(out + (size_t)(r0 + i) * DM) + lane)[64 * j];
#pragma unroll
        for (int i = 0; i < 4; ++i) { float ss = 0.f;
#pragma unroll
            for (int j = 0; j < 4; ++j) ss += (v[i][j][0] * v[i][j][0] + v[i][j][1] * v[i][j][1]) + (v[i][j][2] * v[i][j][2] + v[i][j][3] * v[i][j][3]);
            const float rs = __builtin_amdgcn_rsqf(wave_sum(ss) * (1.0f / 1024.0f) + RMS_EPS);
#pragma unroll
            for (int j = 0; j < 4; ++j) ((f32x4*)(out + (size_t)(r0 + i) * DM) + lane)[64 * j] = v[i][j] * rs * gv[j]; } }
      if (has_s) { float ss = 0.f;
#pragma unroll
        for (int j = 0; j < 4; ++j) ss += (sv[j][0] * sv[j][0] + sv[j][1] * sv[j][1]) + (sv[j][2] * sv[j][2] + sv[j][3] * sv[j][3]);
        const float rs = __builtin_amdgcn_rsqf(wave_sum(ss) * (1.0f / 1024.0f) + RMS_EPS);
#pragma unroll
        for (int j = 0; j < 4; ++j) ((f32x4*)(out + (size_t)rs_ * DM) + lane)[64 * j] = sv[j] * rs * gv[j]; }
      for (int r = MP + gwf + NGWF; r < MROWS; r += NGWF) { f32x4 v[4]; float ss = 0.f;
#pragma unroll
        for (int j = 0; j < 4; ++j) { v[j] = ((const f32x4*)(out + (size_t)r * DM) + lane)[64 * j]; ss += (v[j][0] * v[j][0] + v[j][1] * v[j][1]) + (v[j][2] * v[j][2] + v[j][3] * v[j][3]); }
        const float rs = __builtin_amdgcn_rsqf(wave_sum(ss) * (1.0f / 1024.0f) + RMS_EPS);
#pragma unroll
        for (int j = 0; j < 4; ++j) ((f32x4*)(out + (size_t)r * DM) + lane)[64 * j] = v[j] * rs * gv[j]; } }
}

extern "C" void kernel_launch(void* const* d_in, const int* in_sizes, int n_in, void* d_out, int out_size, void* d_ws, size_t ws_size, hipStream_t stream) {
    static int grid = 0;
    if (grid == 0) {
        if (n_in != 31 || (size_t)out_size != O_END || ws_size < WS_END) { fprintf(stderr, "kernel_launch: unexpected sizes n_in %d out %d ws %zu\n", n_in, out_size, ws_size); grid = -1; return; }
        int dev = 0, cus = 0, per_cu = 0;
        hipGetDevice(&dev); hipDeviceGetAttribute(&cus, hipDeviceAttributeMultiprocessorCount, dev);
        if (hipFuncSetAttribute((const void*)mega_fwd, hipFuncAttributeMaxDynamicSharedMemorySize, LDS_BYTES) != hipSuccess) { fprintf(stderr, "hipFuncSetAttribute failed\n"); grid = -1; return; }
        hipOccupancyMaxActiveBlocksPerMultiprocessor(&per_cu, (const void*)mega_fwd, NTHR, LDS_BYTES);
        if (per_cu < 1) { fprintf(stderr, "occupancy query says %d blocks/CU\n", per_cu); per_cu = 1; }
        (void)hipGetLastError();
        grid = cus;
    }
    if (grid < 0) return;
    Params p{};
    for (int i = 0; i < 31; ++i) p.in[i] = (const float*)d_in[i];
    p.out = (float*)d_out; p.ws = (unsigned char*)d_ws;
    if (hipMemsetAsync(d_ws, 0, 16384, stream) != hipSuccess) { fprintf(stderr, "memset failed\n"); return; }
    void* args[] = {&p};
    hipError_t e = hipLaunchCooperativeKernel((const void*)mega_fwd, dim3(grid), dim3(NTHR), args, LDS_BYTES, stream);
    if (e != hipSuccess) fprintf(stderr, "cooperative launch failed: %s (grid %d)\n", hipGetErrorString(e), grid);
}
```
